# Optimizing an MI355X kernel written in HIP

```python
import jax
import jax.numpy as jnp
from jax import lax
import numpy as np

D_MODEL = 1024
BATCH = 4
SEQ = 8192
DEPTH = 2
DEC_BATCH = 16
DEC_SEQ = 64
PAST_LEN = 4096

CHUNK = 64
D_CONV = D_MODEL // 4
D_GMLP = D_MODEL // 4
D_ATT = D_MODEL // 2
D_MIX = D_CONV + D_GMLP + D_ATT
CONV_WIDTH = 31
CONV_PAD = CONV_WIDTH - 1
GM_HEAD_DIM = 64
GM_HEADS = D_GMLP // GM_HEAD_DIM
GM_CHUNK = 128
HEAD_DIM = 64
ATT_HEADS = D_ATT // HEAD_DIM
BAND_CHUNKS = 8
BAND_PAST = BAND_CHUNKS * CHUNK
BAND_LEN = BAND_PAST + CHUNK
REL_CLIP = 128
N_REL = 2 * REL_CLIP + 1
D_IN = 2 * D_CONV + 2 * D_GMLP + 3 * D_ATT
D_FF = ((8 * D_MODEL // 3 + 127) // 128) * 128
EPS = 1e-6

kernel_name = 'hybrid_streaming_encoder_step'


def rms_norm(x, g):
    xf = x.astype(jnp.float32)
    y = xf * lax.rsqrt(jnp.mean(xf * xf, axis=-1, keepdims=True) + EPS)
    return (y * g.astype(jnp.float32)).astype(x.dtype)


def layer_norm(x, g, b):
    xf = x.astype(jnp.float32)
    mu = jnp.mean(xf, axis=-1, keepdims=True)
    var = jnp.mean(jnp.square(xf - mu), axis=-1, keepdims=True)
    y = (xf - mu) * lax.rsqrt(var + EPS)
    return (y * g.astype(jnp.float32) + b.astype(jnp.float32)).astype(x.dtype)


def swiglu_ffn(x, g, w_gate, w_up, w_down):
    h = rms_norm(x, g)
    return (jax.nn.silu(h @ w_gate) * (h @ w_up)) @ w_down


def begin_mixing(x, p):
    B, T, _ = x.shape
    x = x + 0.5 * swiglu_ffn(x, p['ffn1_norm'], p['ffn1_w_gate'], p['ffn1_w_up'], p['ffn1_w_down'])
    z = rms_norm(x, p['mix_norm']) @ p['w_in']
    o1 = 2 * D_CONV
    o2 = o1 + 2 * D_GMLP
    o3 = o2 + D_ATT
    o4 = o3 + D_ATT
    zc, zg = z[..., :o1], z[..., o1:o2]
    zq, zk, zv = z[..., o2:o3], z[..., o3:o4], z[..., o4:]
    glu = zc[..., :D_CONV] * jax.nn.sigmoid(zc[..., D_CONV:])
    uv = jax.nn.gelu(zg)
    u = uv[..., :D_GMLP].reshape(B, T, GM_HEADS, GM_HEAD_DIM)
    vg = layer_norm(uv[..., D_GMLP:], p['gmlp_ln_g'], p['gmlp_ln_b']).reshape(B, T, GM_HEADS, GM_HEAD_DIM)
    q = rms_norm(zq.reshape(B, T, ATT_HEADS, HEAD_DIM), p['q_norm'])
    k = rms_norm(zk.reshape(B, T, ATT_HEADS, HEAD_DIM), p['k_norm'])
    v = zv.reshape(B, T, ATT_HEADS, HEAD_DIM)
    return x, glu, u, vg, q, k, v


def conv_branch(glu_padded, p):
    y = lax.conv_general_dilated(glu_padded, p['conv_w'][:, None, :], (1,), 'VALID',
                                 dimension_numbers=('NWC', 'WIO', 'NWC'),
                                 feature_group_count=D_CONV) + p['conv_b']
    return jax.nn.silu(layer_norm(y, p['conv_ln_g'], p['conv_ln_b']))


def gmlp_spatial(v, ws, bs):
    tc = v.shape[2]
    w = jnp.tril(ws[:, :tc, :tc])
    return jnp.einsum('hts,bnshd->bnthd', w, v) + bs[:, :tc].T[None, None, :, :, None]


def band_attention(q, k, v, q_pos, k_pos, rel_bias):
    rel = q_pos[:, None] - k_pos[None, :]
    bias = rel_bias[:, jnp.clip(rel, -REL_CLIP, REL_CLIP) + REL_CLIP].astype(jnp.float32)
    qc = q_pos[:, None] // CHUNK
    kc = k_pos[None, :] // CHUNK
    allowed = (k_pos[None, :] >= 0) & (kc <= qc) & (kc >= qc - BAND_CHUNKS)
    s = jnp.einsum('bqhd,bkhd->bhqk', q, k).astype(jnp.float32) * (HEAD_DIM ** -0.5) + bias
    s = jnp.where(allowed, s, -1e30)
    pr = jax.nn.softmax(s, axis=-1)
    return jnp.einsum('bhqk,bkhd->bqhd', pr.astype(v.dtype), v)


def prompt_band_attention(q, k, v, rel_bias):
    B, S, H, Dh = q.shape
    n_chunks = S // CHUNK
    pad = ((0, 0), (BAND_PAST, 0), (0, 0), (0, 0))
    kp = jnp.pad(k, pad)
    vp = jnp.pad(v, pad)

    def one_chunk(c):
        start = c * CHUNK
        qs = lax.dynamic_slice_in_dim(q, start, CHUNK, axis=1)
        ks = lax.dynamic_slice_in_dim(kp, start, BAND_LEN, axis=1)
        vs = lax.dynamic_slice_in_dim(vp, start, BAND_LEN, axis=1)
        q_pos = start + jnp.arange(CHUNK)
        k_pos = start - BAND_PAST + jnp.arange(BAND_LEN)
        return band_attention(qs, ks, vs, q_pos, k_pos, rel_bias)

    out = lax.map(one_chunk, jnp.arange(n_chunks))
    return out.transpose(1, 0, 2, 3, 4).reshape(B, S, H, Dh)


def finish_layer(x, conv_out, gm_out, att_out, p):
    B, T, _ = x.shape
    mixed = jnp.concatenate([conv_out, gm_out.reshape(B, T, D_GMLP), att_out.reshape(B, T, D_ATT)], axis=-1)
    x = x + mixed @ p['w_out']
    return x + 0.5 * swiglu_ffn(x, p['ffn2_norm'], p['ffn2_w_gate'], p['ffn2_w_up'], p['ffn2_w_down'])


def prompt_layer(x, p):
    B, S, _ = x.shape
    x, glu, u, vg, q, k, v = begin_mixing(x, p)
    conv_out = conv_branch(jnp.pad(glu, ((0, 0), (CONV_PAD, 0), (0, 0))), p)
    s = gmlp_spatial(vg.reshape(B, S // GM_CHUNK, GM_CHUNK, GM_HEADS, GM_HEAD_DIM), p['gmlp_ws'], p['gmlp_b'])
    gm_out = u * s.reshape(B, S, GM_HEADS, GM_HEAD_DIM)
    att_out = prompt_band_attention(q, k, v, p['rel_bias'])
    x = finish_layer(x, conv_out, gm_out, att_out, p)
    keep = min(BAND_PAST, S)
    return x, glu[:, -CONV_PAD:], k[:, -keep:], v[:, -keep:]


def sample_layer(x, conv_buf, k_cache, v_cache, p):
    B, T, _ = x.shape
    L = k_cache.shape[1]
    x, glu, u, vg, q, k, v = begin_mixing(x, p)
    conv_in = jnp.concatenate([conv_buf.astype(glu.dtype), glu], axis=1)
    conv_out = conv_branch(conv_in, p)
    gm_out = u * gmlp_spatial(vg[:, None], p['gmlp_ws'], p['gmlp_b'])[:, 0]
    q_pos = PAST_LEN + jnp.arange(T)
    k_pos = PAST_LEN + jnp.arange(-L, T)
    k_all = jnp.concatenate([k_cache.astype(k.dtype), k], axis=1)
    v_all = jnp.concatenate([v_cache.astype(v.dtype), v], axis=1)
    att_out = band_attention(q, k_all, v_all, q_pos, k_pos, p['rel_bias'])
    x = finish_layer(x, conv_out, gm_out, att_out, p)
    return x, conv_in[:, -CONV_PAD:], k, v, vg


def setup_inputs(seed: int = 0) -> dict:
    key = jax.random.key(seed)
    ks = jax.random.split(key, 32)
    att_cache = min(BAND_PAST, PAST_LEN)

    def nrm(k, shape, scale):
        return jax.random.normal(k, shape, jnp.float32) * scale

    return {
        'x_prompt': nrm(ks[0], (BATCH, SEQ, D_MODEL), 1.0),
        'x_sample': nrm(ks[1], (DEC_BATCH, DEC_SEQ, D_MODEL), 1.0),
        'cache_conv': nrm(ks[2], (DEPTH, DEC_BATCH, CONV_PAD, D_CONV), 0.5),
        'cache_k': nrm(ks[3], (DEPTH, DEC_BATCH, att_cache, ATT_HEADS, HEAD_DIM), 1.0),
        'cache_v': nrm(ks[4], (DEPTH, DEC_BATCH, att_cache, ATT_HEADS, HEAD_DIM), 1.0),
        'ffn1_norm': 1.0 + nrm(ks[5], (DEPTH, D_MODEL), 0.01),
        'ffn1_w_gate': nrm(ks[6], (DEPTH, D_MODEL, D_FF), D_MODEL ** -0.5),
        'ffn1_w_up': nrm(ks[7], (DEPTH, D_MODEL, D_FF), D_MODEL ** -0.5),
        'ffn1_w_down': nrm(ks[8], (DEPTH, D_FF, D_MODEL), D_FF ** -0.5),
        'mix_norm': 1.0 + nrm(ks[9], (DEPTH, D_MODEL), 0.01),
        'w_in': nrm(ks[10], (DEPTH, D_MODEL, D_IN), D_MODEL ** -0.5),
        'conv_w': nrm(ks[11], (DEPTH, CONV_WIDTH, D_CONV), CONV_WIDTH ** -0.5),
        'conv_b': nrm(ks[12], (DEPTH, D_CONV), 0.01),
        'conv_ln_g': 1.0 + nrm(ks[13], (DEPTH, D_CONV), 0.01),
        'conv_ln_b': nrm(ks[14], (DEPTH, D_CONV), 0.01),
        'gmlp_ln_g': 1.0 + nrm(ks[15], (DEPTH, D_GMLP), 0.01),
        'gmlp_ln_b': nrm(ks[16], (DEPTH, D_GMLP), 0.01),
        'gmlp_ws': nrm(ks[17], (DEPTH, GM_HEADS, GM_CHUNK, GM_CHUNK), GM_CHUNK ** -0.5),
        'gmlp_b': 1.0 + nrm(ks[18], (DEPTH, GM_HEADS, GM_CHUNK), 0.1),
        'q_norm': 1.0 + nrm(ks[19], (DEPTH, HEAD_DIM), 0.01),
        'k_norm': 1.0 + nrm(ks[20], (DEPTH, HEAD_DIM), 0.01),
        'rel_bias': nrm(ks[21], (DEPTH, ATT_HEADS, N_REL), 0.1),
        'w_out': nrm(ks[22], (DEPTH, D_MIX, D_MODEL), D_MIX ** -0.5),
        'ffn2_norm': 1.0 + nrm(ks[23], (DEPTH, D_MODEL), 0.01),
        'ffn2_w_gate': nrm(ks[24], (DEPTH, D_MODEL, D_FF), D_MODEL ** -0.5),
        'ffn2_w_up': nrm(ks[25], (DEPTH, D_MODEL, D_FF), D_MODEL ** -0.5),
        'ffn2_w_down': nrm(ks[26], (DEPTH, D_FF, D_MODEL), D_FF ** -0.5),
    }


def reference(x_prompt, x_sample, cache_conv, cache_k, cache_v,
              ffn1_norm, ffn1_w_gate, ffn1_w_up, ffn1_w_down,
              mix_norm, w_in, conv_w, conv_b, conv_ln_g, conv_ln_b,
              gmlp_ln_g, gmlp_ln_b, gmlp_ws, gmlp_b,
              q_norm, k_norm, rel_bias, w_out,
              ffn2_norm, ffn2_w_gate, ffn2_w_up, ffn2_w_down):
    xp = x_prompt
    xs = x_sample
    p_conv, p_k, p_v = [], [], []
    s_conv, s_k, s_v, s_gv = [], [], [], []
    for l in range(DEPTH):
        p = {
            'ffn1_norm': ffn1_norm[l], 'ffn1_w_gate': ffn1_w_gate[l], 'ffn1_w_up': ffn1_w_up[l],
            'ffn1_w_down': ffn1_w_down[l], 'mix_norm': mix_norm[l], 'w_in': w_in[l],
            'conv_w': conv_w[l], 'conv_b': conv_b[l], 'conv_ln_g': conv_ln_g[l], 'conv_ln_b': conv_ln_b[l],
            'gmlp_ln_g': gmlp_ln_g[l], 'gmlp_ln_b': gmlp_ln_b[l], 'gmlp_ws': gmlp_ws[l], 'gmlp_b': gmlp_b[l],
            'q_norm': q_norm[l], 'k_norm': k_norm[l], 'rel_bias': rel_bias[l], 'w_out': w_out[l],
            'ffn2_norm': ffn2_norm[l], 'ffn2_w_gate': ffn2_w_gate[l], 'ffn2_w_up': ffn2_w_up[l],
            'ffn2_w_down': ffn2_w_down[l],
        }
        xp, pc, pk, pv = prompt_layer(xp, p)
        xs, sc, sk, sv, sg = sample_layer(xs, cache_conv[l], cache_k[l], cache_v[l], p)
        p_conv.append(pc)
        p_k.append(pk)
        p_v.append(pv)
        s_conv.append(sc)
        s_k.append(sk)
        s_v.append(sv)
        s_gv.append(sg)
    prompt_conv_state = jnp.stack(p_conv)
    prompt_k = jnp.stack(p_k)
    prompt_v = jnp.stack(p_v)
    sample_conv_state = jnp.stack(s_conv)
    sample_k_new = jnp.stack(s_k)
    sample_v_new = jnp.stack(s_v)
    sample_gmlp_v = jnp.stack(s_gv)
    return (xp, xs, prompt_conv_state, prompt_k, prompt_v, sample_conv_state, sample_k_new, sample_v_new, sample_gmlp_v)
```

```cpp
#include <hip/hip_runtime.h>
#include <hip/hip_cooperative_groups.h>
#include <cstdio>
#include <cstdint>
namespace cg = cooperative_groups;
namespace pg8 {
#define PG8_LAS __attribute__((address_space(3)))
typedef unsigned short bf16_t;
typedef short bf16x8 __attribute__((ext_vector_type(8)));
typedef float f32x4 __attribute__((ext_vector_type(4)));
typedef unsigned u32x4 __attribute__((ext_vector_type(4)));
constexpr int BM = 256, BK = 64, HALF = 128, HTB = HALF * BK * 2  , STAGE_BYTES = 8 * HTB, NXCD = 8, WGM = 8;

__host__ __device__ __forceinline__ int lds_byte(int r, int c) { const int st = (r >> 4) * 2 + (c >> 5), rr = r & 15, cc = c & 31, ob = rr * 64 + cc * 2; return st * 1024 + (ob ^ (((ob >> 9) & 1) << 5)); }
__host__ __device__ __forceinline__ void stage_rc(int b, int& R, int& C) { const int st = b / 1024, sb = b % 1024, swz = sb ^ (((sb >> 9) & 1) << 5); R = (st >> 1) * 16 + swz / 64; C = (st & 1) * 32 + (swz % 64) / 2; }
__host__ __device__ __forceinline__ int perm32(int rho) { const int n = rho >> 4, i = rho & 15; return 8 * (i >> 2) + 4 * n + (i & 3); }

struct Unit { int pm, pn, idx; };
struct Gemm { const bf16_t* A; const bf16_t* Bt; int M, N, K; };

struct StaticOrder {
    int nM, nN, nwg, G, c;
    __host__ __device__ void init(int M, int N, int G_, int c_) { nM = M / BM; nN = N / BM; nwg = nM * nN; G = G_; c = c_; }
    __host__ __device__ bool next(int i, Unit& u) const {
        const int L = i * G + c; if (L >= nwg) return false;
        int wgid = (int)L; { const int q = nwg / NXCD, r = nwg % NXCD, xcd = wgid % NXCD, off = wgid / NXCD; wgid = (xcd < r ? xcd * (q + 1) : r * (q + 1) + (xcd - r) * q) + off; }
        const int nig = WGM * nN, gid = wgid / nig, fm = gid * WGM, gsz = (nM - fm) < WGM ? (nM - fm) : WGM;
        u.pm = fm + ((wgid % nig) % gsz); u.pn = (wgid % nig) / gsz; u.idx = i; return true;
    }
    __device__ __forceinline__ void a_ready(const Unit&) const {}
    __device__ __forceinline__ void done(const Unit&) const {}
};

__device__ __forceinline__ unsigned cvt_pk_bf16(float lo, float hi) { unsigned r; asm volatile("v_cvt_pk_bf16_f32 %0, %1, %2" : "=v"(r) : "v"(lo), "v"(hi)); return r; }
typedef float f32x2 __attribute__((ext_vector_type(2)));
__device__ __forceinline__ f32x2 gelu_pk(f32x2 v) {
    const f32x2 av = __builtin_elementwise_abs(v), d = av * 0.2316418882f + 1.0f;
    f32x2 t; t.x = __builtin_amdgcn_rcpf(d.x); t.y = __builtin_amdgcn_rcpf(d.y);
    f32x2 q = t * 0.5307027145f + (-0.7265760135f); q = q * t + 0.7107068705f; q = q * t + (-0.142248368f); q = q * t + 0.127414796f; q = q * t;
    const f32x2 s = (v * v) * (-0.72134752044f);
    f32x2 e; e.x = __builtin_amdgcn_exp2f(s.x); e.y = __builtin_amdgcn_exp2f(s.y);
    const f32x2 m = v * (q * e), r = v - m;
    f32x2 o; o.x = v.x < 0.f ? m.x : r.x; o.y = v.y < 0.f ? m.y : r.y; return o;
}

template <int ACT  > struct EpiBf16 {
    static constexpr bool PERM = true, AFTER_DRAIN = false; static_assert(ACT == 0 || ACT == 1, "EpiBf16: ACT is 0 (none) or 1 (gelu_pk)");
    bf16_t* O; int ldc; const float* bias; int split_cols; size_t split_stride; float scale0;
    __device__ __forceinline__ void operator()(const f32x4 (&acc)[2][2][4][2], const Unit& u, int wr, int wc, int fr, int fq) const {
        const int row0 = u.pm * BM + wr * 64 + fr; int colt = u.pn * BM; bf16_t* base = O;
        float sc = 1.f; if (split_cols) { const int t = colt / split_cols; base += (size_t)t * split_stride; colt -= t * split_cols; if (t == 0) sc = scale0; }
        const int col0 = colt + wc * 32 + 8 * fq, bcol0 = u.pn * BM + wc * 32 + 8 * fq;
        f32x4 bv[2][2];
#pragma unroll
        for (int bj = 0; bj < 2; ++bj)
#pragma unroll
            for (int n = 0; n < 2; ++n) bv[bj][n] = bias ? *(const f32x4*)(bias + bcol0 + bj * HALF + 4 * n) : (f32x4){0.f, 0.f, 0.f, 0.f};
#pragma unroll
        for (int ai = 0; ai < 2; ++ai)
#pragma unroll
            for (int m = 0; m < 4; ++m) { bf16_t* rowp = base + (size_t)(row0 + ai * HALF + m * 16) * ldc + col0;
#pragma unroll
                for (int bj = 0; bj < 2; ++bj) { f32x4 v0 = acc[ai][bj][m][0] + bv[bj][0], v1 = acc[ai][bj][m][1] + bv[bj][1];
                    if (ACT == 1) { f32x2 a = gelu_pk((f32x2){v0[0], v0[1]}), b = gelu_pk((f32x2){v0[2], v0[3]}), c = gelu_pk((f32x2){v1[0], v1[1]}), d = gelu_pk((f32x2){v1[2], v1[3]});
                        v0 = (f32x4){a.x, a.y, b.x, b.y}; v1 = (f32x4){c.x, c.y, d.x, d.y}; }
                    v0 = v0 * sc; v1 = v1 * sc; u32x4 w; w.x = cvt_pk_bf16(v0[0], v0[1]); w.y = cvt_pk_bf16(v0[2], v0[3]); w.z = cvt_pk_bf16(v1[0], v1[1]); w.w = cvt_pk_bf16(v1[2], v1[3]);
                    *(u32x4*)(rowp + bj * HALF) = w; } }
    }
};
template <class Epi, class Sched, bool ALIGN_EPI = false, bool SP2 = false>
__device__ __forceinline__ void gemm_phase(PG8_LAS unsigned char* lds, const Gemm g, const Sched& S, const Epi& E) {
    int tid_ = threadIdx.x; asm volatile("" : "+v"(tid_));
    const int tid = tid_, wid = __builtin_amdgcn_readfirstlane(tid >> 6), lane = tid & 63, wr = wid >> 2, wc = wid & 3, fr = lane & 15, fq = lane >> 4;
    const int K = g.K, nt = K / BK;
    unsigned voffA[2], voffB[2];
#pragma unroll
    for (int i = 0; i < 2; ++i) { int R, C; stage_rc(tid * 16 + i * 8192, R, C); const int Rb = Epi::PERM ? ((R & ~31) + perm32(R & 31)) : R;
        voffA[i] = (unsigned)(R * K + C) * 2u; voffB[i] = (unsigned)(Rb * K + C) * 2u; }
    const size_t kstep = (size_t)(BK * 2);
    const size_t hstep = (size_t)HALF * K * 2;
    const size_t tstep = 2 * hstep;
    const unsigned ldsw = (unsigned)wid * 1024u;
    const int aoff = lds_byte(wr * 64 + fr, fq * 8), boff = lds_byte(wc * 32 + fr, fq * 8);
#define PG8_SA(b, h) (((b) * 2 + (h)) * HTB)
#define PG8_SB(b, h) ((4 + (b) * 2 + (h)) * HTB)
#define PG8_STAGE(bufoff, gbase, voff) do { _Pragma("unroll") for (int _i = 0; _i < 2; ++_i) \
        __builtin_amdgcn_global_load_lds((const unsigned*)((const char*)(gbase) + (voff)[_i]), (PG8_LAS unsigned*)(lds + (bufoff) + ldsw + _i * 8192), 16, 0, 0); } while (0)
#define PG8_LDA(dst, b, h) do { _Pragma("unroll") for (int m = 0; m < 4; ++m) _Pragma("unroll") for (int k = 0; k < 2; ++k) dst[m][k] = *(const PG8_LAS bf16x8*)(lds + PG8_SA(b, h) + aoff + m * 2048 + k * 1024); } while (0)
#define PG8_LDB(dst, b, h) do { _Pragma("unroll") for (int n = 0; n < 2; ++n) _Pragma("unroll") for (int k = 0; k < 2; ++k) dst[n][k] = *(const PG8_LAS bf16x8*)(lds + PG8_SB(b, h) + boff + n * 2048 + k * 1024); } while (0)
#define PG8_MMA(ai, bj, At, Bt) do { __builtin_amdgcn_s_setprio(1); _Pragma("unroll") for (int m = 0; m < 4; ++m) _Pragma("unroll") for (int n = 0; n < 2; ++n) _Pragma("unroll") for (int k = 0; k < 2; ++k) \
        acc[ai][bj][m][n] = __builtin_amdgcn_mfma_f32_16x16x32_bf16(Bt[n][k], At[m][k], acc[ai][bj][m][n], 0, 0, 0); __builtin_amdgcn_s_setprio(0); } while (0)
#define PG8_WAIT_V(n) asm volatile("s_waitcnt vmcnt(" #n ")" ::: "memory")
#define PG8_WAIT_L(n) asm volatile("s_waitcnt lgkmcnt(" #n ")" ::: "memory")
#define PG8_BAR __builtin_amdgcn_s_barrier()
#define PG8_SCHED __builtin_amdgcn_sched_barrier(0)
    Unit cur, nxt; int ui = 0;
    if (!S.next(0, cur)) return;
    f32x4 acc[2][2][4][2];
#pragma unroll
    for (int a = 0; a < 2; ++a)
#pragma unroll
        for (int b = 0; b < 2; ++b)
#pragma unroll
            for (int m = 0; m < 4; ++m)
#pragma unroll
                for (int n = 0; n < 2; ++n) acc[a][b][m][n] = (f32x4){0.f, 0.f, 0.f, 0.f};
    bf16x8 At[4][2], B0[2][2], B1[2][2];
    const char* cA = (const char*)g.A + (size_t)cur.pm * tstep; const char* cB = (const char*)g.Bt + (size_t)cur.pn * tstep;
    S.a_ready(cur);
    if constexpr (SP2) {
        PG8_STAGE(PG8_SB(0, 0), cB, voffB); PG8_STAGE(PG8_SB(0, 1), cB + hstep, voffB); PG8_STAGE(PG8_SA(0, 0), cA, voffA); PG8_STAGE(PG8_SA(0, 1), cA + hstep, voffA);
        if (wr == 1) PG8_BAR;
        PG8_WAIT_V(2); PG8_BAR;
        PG8_STAGE(PG8_SB(1, 0), cB + kstep, voffB); PG8_STAGE(PG8_SA(1, 0), cA + kstep, voffA); PG8_STAGE(PG8_SB(1, 1), cB + hstep + kstep, voffB);
        PG8_WAIT_V(6); PG8_BAR;
    } else {
        PG8_STAGE(PG8_SB(0, 0), cB, voffB); PG8_STAGE(PG8_SA(0, 0), cA, voffA); PG8_STAGE(PG8_SB(0, 1), cB + hstep, voffB); PG8_STAGE(PG8_SA(0, 1), cA + hstep, voffA);
        if (wr == 1) PG8_BAR;
        PG8_WAIT_V(4); PG8_BAR;
        PG8_STAGE(PG8_SB(1, 0), cB + kstep, voffB); PG8_STAGE(PG8_SA(1, 0), cA + kstep, voffA); PG8_STAGE(PG8_SB(1, 1), cB + hstep + kstep, voffB);
        PG8_WAIT_V(6); PG8_BAR;
    }
    for (;;) {
        const bool has_next = S.next(ui + 1, nxt);
        const char* nA = has_next ? (const char*)g.A + (size_t)nxt.pm * tstep : cA; const char* nB = has_next ? (const char*)g.Bt + (size_t)nxt.pn * tstep : cB;
        for (int t = 0; t < nt; t += 2) {
            const bool last = (t == nt - 2);
            const char* a1 = cA + (size_t)(t + 1) * kstep;
            const char* a2 = last ? nA : cA + (size_t)(t + 2) * kstep; const char* b2 = last ? nB : cB + (size_t)(t + 2) * kstep;
            const char* a3 = a2 + kstep; const char* b3 = b2 + kstep;
            if (last && has_next) S.a_ready(nxt);
            if constexpr (SP2) {
            PG8_LDB(B0, 0, 0); PG8_LDB(B1, 0, 1); PG8_SCHED; PG8_LDA(At, 0, 0); PG8_STAGE(PG8_SA(1, 1), a1 + hstep, voffA);
            PG8_WAIT_V(8); PG8_WAIT_L(0); PG8_BAR; PG8_MMA(0, 0, At, B0); PG8_MMA(0, 1, At, B1); PG8_BAR; PG8_SCHED;
            PG8_LDA(At, 0, 1); PG8_STAGE(PG8_SB(0, 0), b2, voffB); PG8_STAGE(PG8_SB(0, 1), b2 + hstep, voffB); PG8_STAGE(PG8_SA(0, 0), a2, voffA);
            PG8_WAIT_V(8); PG8_WAIT_L(0); PG8_BAR; PG8_MMA(1, 0, At, B0); PG8_MMA(1, 1, At, B1); PG8_BAR; PG8_SCHED;
            PG8_LDB(B0, 1, 0); PG8_LDB(B1, 1, 1); PG8_SCHED; PG8_LDA(At, 1, 0); PG8_STAGE(PG8_SA(0, 1), a2 + hstep, voffA);
            PG8_WAIT_V(8); PG8_WAIT_L(0); PG8_BAR; PG8_MMA(0, 0, At, B0); PG8_MMA(0, 1, At, B1); PG8_BAR; PG8_SCHED;
            PG8_LDA(At, 1, 1); PG8_STAGE(PG8_SB(1, 0), b3, voffB); PG8_STAGE(PG8_SB(1, 1), b3 + hstep, voffB); PG8_STAGE(PG8_SA(1, 0), a3, voffA);
            PG8_WAIT_V(8); PG8_WAIT_L(0); PG8_BAR; PG8_MMA(1, 0, At, B0); PG8_MMA(1, 1, At, B1); PG8_BAR; PG8_SCHED;
            } else {
            PG8_LDB(B0, 0, 0); PG8_SCHED; PG8_LDA(At, 0, 0); PG8_STAGE(PG8_SA(1, 1), a1 + hstep, voffA);
            PG8_WAIT_L(8); PG8_BAR; PG8_WAIT_L(0); PG8_MMA(0, 0, At, B0); PG8_BAR; PG8_SCHED;
            PG8_LDB(B1, 0, 1); PG8_STAGE(PG8_SB(0, 0), b2, voffB);
            PG8_BAR; PG8_WAIT_L(0); PG8_MMA(0, 1, At, B1); PG8_BAR;
            PG8_LDA(At, 0, 1); PG8_STAGE(PG8_SA(0, 0), a2, voffA);
            PG8_BAR; PG8_WAIT_L(0); PG8_MMA(1, 0, At, B0); PG8_BAR; PG8_SCHED;
            PG8_STAGE(PG8_SB(0, 1), b2 + hstep, voffB);
            PG8_WAIT_V(6); PG8_BAR; PG8_MMA(1, 1, At, B1); PG8_BAR;
            PG8_LDB(B0, 1, 0); PG8_SCHED; PG8_LDA(At, 1, 0); PG8_STAGE(PG8_SA(0, 1), a2 + hstep, voffA);
            PG8_WAIT_L(8); PG8_BAR; PG8_WAIT_L(0); PG8_MMA(0, 0, At, B0); PG8_BAR; PG8_SCHED;
            PG8_LDB(B1, 1, 1); PG8_STAGE(PG8_SB(1, 0), b3, voffB);
            PG8_BAR; PG8_WAIT_L(0); PG8_MMA(0, 1, At, B1); PG8_BAR;
            PG8_LDA(At, 1, 1); PG8_STAGE(PG8_SA(1, 0), a3, voffA);
            PG8_BAR; PG8_WAIT_L(0); PG8_MMA(1, 0, At, B0); PG8_BAR; PG8_SCHED;
            PG8_STAGE(PG8_SB(1, 1), b3 + hstep, voffB);
            PG8_WAIT_V(6); PG8_BAR; PG8_MMA(1, 1, At, B1); PG8_BAR;
            }
        }
        if constexpr (ALIGN_EPI) { if (wr == 0) PG8_BAR; }
        if constexpr (!Epi::AFTER_DRAIN) { E(acc, cur, wr, wc, fr, fq); S.done(cur); }
        if (!has_next) break;
#pragma unroll
        for (int a = 0; a < 2; ++a)
#pragma unroll
            for (int b = 0; b < 2; ++b)
#pragma unroll
                for (int m = 0; m < 4; ++m)
#pragma unroll
                    for (int n = 0; n < 2; ++n) acc[a][b][m][n] = (f32x4){0.f, 0.f, 0.f, 0.f};
        cur = nxt; cA = nA; cB = nB; ++ui;
        if constexpr (ALIGN_EPI) { if (wr == 1) PG8_BAR; }
    }
    PG8_WAIT_V(0);
    if constexpr (!ALIGN_EPI) { if (wr == 0) PG8_BAR; }
    PG8_BAR;
    if constexpr (Epi::AFTER_DRAIN) { E.fused(acc, cur, wr, wc, fr, fq, lds, wid, lane); S.done(cur); }
#undef PG8_SA
#undef PG8_SB
#undef PG8_STAGE
#undef PG8_LDA
#undef PG8_LDB
#undef PG8_MMA
#undef PG8_WAIT_V
#undef PG8_WAIT_L
#undef PG8_BAR
#undef PG8_SCHED
}
}
#define LAS __attribute__((address_space(3)))
#define XB_TMO      128
#define XB_XCNT(j)  (256  + 64 * (j))
#define XB_XSUB(j)  (1280 + 64 * (j))
#define XB_XGEN(j)  (2304 + 64 * (j))
#define XB_TOP      3328
#define XB_TOPGEN   3392
#define XCD_BAR_WORDS 3456
#define XB_SPIN_CAP (1u << 18)

__device__ __forceinline__ unsigned xb_ld(unsigned* p)              { return __hip_atomic_load(p, __ATOMIC_RELAXED, __HIP_MEMORY_SCOPE_AGENT); }
__device__ __forceinline__ unsigned xb_add(unsigned* p, unsigned v) { return __hip_atomic_fetch_add(p, v, __ATOMIC_RELAXED, __HIP_MEMORY_SCOPE_AGENT); }
__device__ __forceinline__ unsigned xb_xcc_id() { return (unsigned)__builtin_amdgcn_s_getreg((3 << 11) | 20) & 0xFu; }
#define XB_SPIN(cond, bar) do { unsigned _sp = 0; while (cond) { __builtin_amdgcn_s_sleep(1); \
    if ((++_sp & 255u) == 0u) { if (xb_ld(&(bar)[XB_TMO])) break; if (_sp > XB_SPIN_CAP) { atomicAdd(&(bar)[XB_TMO], 1u); break; } } } } while (0)

struct XcdBarrier {
    unsigned* bar; unsigned x;
    volatile LAS unsigned* st;
};

__device__ __forceinline__ XcdBarrier xcd_barrier_post(unsigned* bar, volatile LAS unsigned* st) {
    XcdBarrier b; b.bar = bar; b.x = xb_xcc_id(); b.st = st;
    if (threadIdx.x == 0) (void)xb_add(&bar[XB_XCNT(b.x)], 1u);
    return b;
}
__device__ __forceinline__ void xcd_barrier_complete(unsigned* bar, unsigned x, unsigned& nloc, unsigned& nx) {
    const unsigned G = gridDim.x * gridDim.y * gridDim.z;
    unsigned sum, cnt, mine, sp = 0u;
    for (;;) {
        sum = 0u; cnt = 0u; mine = 0u;
#pragma unroll
        for (unsigned j = 0; j < 16; ++j) { const unsigned c = xb_ld(&bar[XB_XCNT(j)]); sum += c; cnt += (c > 0u) ? 1u : 0u; mine = (j == x) ? c : mine; }
        if (sum == G) break;
        __builtin_amdgcn_s_sleep(1);
        if ((++sp & 255u) == 0u) { if (xb_ld(&bar[XB_TMO])) break; if (sp > XB_SPIN_CAP) { atomicAdd(&bar[XB_TMO], 1u); break; } }
    }
    nloc = mine > 0u ? mine : 1u; nx = cnt > 0u ? cnt : 1u;
}

__device__ __forceinline__ void xcd_barrier(const XcdBarrier& b) {
    asm volatile("s_waitcnt vmcnt(0)" ::: "memory");
    __syncthreads();
    if (threadIdx.x == 0) {
        unsigned* bar = b.bar; const unsigned bx_ = xb_xcc_id();
        __builtin_amdgcn_s_waitcnt(0);
        unsigned nloc = b.st[0], nx = b.st[1];
        if (nloc == 0u) { xcd_barrier_complete(bar, bx_, nloc, nx); b.st[0] = nloc; b.st[1] = nx; }
        const unsigned old = xb_add(&bar[XB_XSUB(bx_)], 1u);
        const unsigned gen = old / nloc;
        if (old + 1u == (gen + 1u) * nloc) {
            __builtin_amdgcn_fence(__ATOMIC_RELEASE, "agent");
            asm volatile("s_waitcnt vmcnt(0)" ::: "memory");
            const unsigned og = xb_add(&bar[XB_TOP], 1u);
            const unsigned tg = og / nx;
            if (og + 1u == (tg + 1u) * nx) xb_add(&bar[XB_TOPGEN], 1u);
            else XB_SPIN(xb_ld(&bar[XB_TOPGEN]) == tg, bar);
            __builtin_amdgcn_fence(__ATOMIC_ACQUIRE, "agent");
            xb_add(&bar[XB_XGEN(bx_)], 1u);
            asm volatile("s_waitcnt vmcnt(0)" ::: "memory");
        } else {
            XB_SPIN(xb_ld(&bar[XB_XGEN(bx_)]) == gen, bar);
            __builtin_amdgcn_fence(__ATOMIC_ACQUIRE, "agent");
            asm volatile("s_waitcnt vmcnt(0)" ::: "memory");
        }
    }
    __syncthreads();
}

#define GAS __attribute__((address_space(1)))
#define LAS __attribute__((address_space(3)))
typedef unsigned short bf16;
typedef float f32x4 __attribute__((ext_vector_type(4)));
typedef float f32x16 __attribute__((ext_vector_type(16)));
typedef short bf16x8 __attribute__((ext_vector_type(8)));
typedef short s16x4 __attribute__((ext_vector_type(4)));
typedef unsigned u32x4 __attribute__((ext_vector_type(4)));
typedef unsigned u32x2 __attribute__((ext_vector_type(2)));

#ifndef REP_MIX
#define REP_MIX 1
#endif
#ifndef REP_PRO
#define REP_PRO 1
#endif
#ifndef REP_SYNC
#define REP_SYNC 1
#endif
constexpr int NWAVES = 8;
constexpr int GRID_WG = 256;
constexpr int DM = 1024, NP = 32768, NS = 1024, MROWS = NP + NS, SEQ = 8192, DFF = 2816, DIN = 2560, NL = 2;
constexpr float EPS = 1e-6f;
constexpr float LOG2E = 1.4426950408889634f;
constexpr size_t MiB = 1u << 20;
constexpr size_t WS_W = 0;
constexpr size_t W_LAYER = 40 * MiB, W_GU1 = 0, W_D1 = 11 * MiB, W_IN = 16 * MiB + 512 * 1024, W_OUT = 21 * MiB + 512 * 1024, W_GU2 = 23 * MiB + 512 * 1024, W_D2 = 34 * MiB + 512 * 1024;
constexpr size_t WS_WTRIL = 80 * MiB;
constexpr size_t WS_BAR = 80 * MiB + 512 * 1024;
constexpr size_t WS_CNT = WS_BAR + 16384;
constexpr size_t WS_SSQ = 81 * MiB;
constexpr size_t WS_SK = 84 * MiB;
constexpr size_t WS_SVT = 102 * MiB;
constexpr size_t WS_XB = 120 * MiB;
constexpr size_t WS_MIX = 186 * MiB;
constexpr size_t WS_A = 252 * MiB;
constexpr size_t WS_GLU = WS_A, WS_U = WS_A + 17 * MiB, WS_VG = WS_A + 34 * MiB, WS_Q = WS_A + 51 * MiB, WS_PK = WS_A + 84 * MiB, WS_PVT = WS_A + 116 * MiB;
constexpr size_t WS_END = WS_A + 182 * MiB;
static_assert(WS_PVT + 32 * MiB <= WS_END, "overlay");
constexpr size_t O_YP = 0, O_YS = 33554432, O_PCS = O_YS + 1048576, O_PK = O_PCS + 61440, O_PV = O_PK + 2097152, O_SCS = O_PV + 2097152,
                 O_SK = O_SCS + 245760, O_SV = O_SK + 1048576, O_SG = O_SV + 1048576, O_END = O_SG + 524288;
constexpr int GLU_PB = SEQ + 30, GLU_SROW0 = 4 * GLU_PB;
constexpr int RING_BYTES = 131072, BIAS_OFF = RING_BYTES, RS_OFF = RING_BYTES + 8448, RS_UNITS = 12, XB_OFF = RS_OFF + RS_UNITS * 1024, VSCR_OFF = XB_OFF + 32, LDS_BYTES = 160256;

struct Params {
    const float* in[27];
    float* out; unsigned char* ws;
};
typedef const __attribute__((address_space(4))) Params* CPP;
__device__ __forceinline__ CPP kparams() { CPP q = (CPP)__builtin_amdgcn_kernarg_segment_ptr(); asm volatile("" : "+s"(q)); return q; }

__device__ __forceinline__ unsigned f2bf(float f) { unsigned u = __builtin_bit_cast(unsigned, f); return (u + 0x7fffu + ((u >> 16) & 1u)) >> 16; }
typedef __bf16 bf16x2_t __attribute__((ext_vector_type(2)));
typedef float f32x2_t __attribute__((ext_vector_type(2)));
__device__ __forceinline__ unsigned pk2(float lo, float hi) { const f32x2_t f = {lo, hi}; const bf16x2_t h = __builtin_convertvector(f, bf16x2_t); return __builtin_bit_cast(unsigned, h); }
__device__ __forceinline__ float bf2f(unsigned short b) { return __builtin_bit_cast(float, (unsigned)b << 16); }
__device__ __forceinline__ unsigned cvtpk(float lo, float hi) { return pk2(lo, hi); }
__device__ __forceinline__ float wave_sum(float v) {
#pragma unroll
    for (int o = 1; o < 64; o <<= 1) v += __shfl_xor(v, o);
    return v;
}
__device__ __forceinline__ float fast_exp2(float x) { return __builtin_amdgcn_exp2f(x); }
__device__ __forceinline__ float fast_rcp(float x) { return __builtin_amdgcn_rcpf(x); }
__device__ __forceinline__ float sigmoidf_(float x) { return fast_rcp(1.f + fast_exp2(-LOG2E * x)); }
__device__ __forceinline__ float siluf_(float x) { return x * sigmoidf_(x); }
__device__ __forceinline__ float gelu_tanh(float x) { const float t = 0.7978845608028654f * (x + 0.044715f * x * x * x); return x * sigmoidf_(2.f * t); }
__device__ __forceinline__ float row_rs(const float* ssq, int row) {
    const f32x4* p = (const f32x4*)(ssq + (size_t)row * 16);
    const f32x4 a = p[0], b = p[1], c = p[2], d = p[3];
    const f32x4 s = (a + b) + (c + d);
    return __builtin_amdgcn_rsqf(((s[0] + s[1]) + (s[2] + s[3])) * (1.f / 1024.f) + EPS);
}

struct RsOrder : pg8::StaticOrder {
    const float* ssq; LAS float* rsbuf;
    __device__ __forceinline__ void a_ready(const pg8::Unit&) const {}
};
template <class Sched>
__device__ __forceinline__ void rs_fill(const Sched& S, const float* ssq, LAS float* rsbuf, int tid) {
    int pms[RS_UNITS]; int nu = 0;
#pragma unroll
    for (int i = 0; i < RS_UNITS; ++i) { pg8::Unit u; const bool ok = S.next(i, u); pms[i] = ok ? u.pm : 0; nu += ok ? 1 : 0; }
    const int half = tid >> 8, rr = tid & 255;
#pragma unroll
    for (int b = 0; b < RS_UNITS / 2; b += 6) {
        f32x4 v[6][4];
#pragma unroll
        for (int k = 0; k < 6; ++k) { const int ui = 2 * (b + k) + half; const int pm = half ? pms[2 * (b + k) + 1] : pms[2 * (b + k)];
            const f32x4* p = (const f32x4*)(ssq + ((size_t)pm * 256 + rr) * 16);
            if (ui < nu) { v[k][0] = p[0]; v[k][1] = p[1]; v[k][2] = p[2]; v[k][3] = p[3]; } }
#pragma unroll
        for (int k = 0; k < 6; ++k) { const int ui = 2 * (b + k) + half;
            if (ui < nu) { const f32x4 s4 = (v[k][0] + v[k][1]) + (v[k][2] + v[k][3]); rsbuf[ui * 256 + rr] = __builtin_amdgcn_rsqf(((s4[0] + s4[1]) + (s4[2] + s4[3])) * (1.f / 1024.f) + EPS); } }
    }
    __syncthreads();
}
struct GuOrder : RsOrder {
    unsigned* cnt;
    const unsigned* wait_cnt;
    int samp_i;
    __device__ __forceinline__ bool next(int i, pg8::Unit& u) const {
        int L;
        if (c < 240) { L = i * 240 + c; if (L >= 2760) return false; }
        else { if (i >= 9) return false; L = 2760 + (c - 240) + 16 * i; }
        u.idx = i;
        const int s0 = 240 * samp_i;
        if (L >= s0 && L < s0 + 88) { const int q = L - s0; u.pm = 128 + q / 22; u.pn = q % 22; return true; }
        int wgid = (L < s0) ? L : L - 88; { const int xcd = wgid % 8, off = wgid / 8; wgid = xcd * 352 + off; }
        const int gid = wgid / 176, rem = wgid % 176;
        u.pm = gid * 8 + (rem % 8); u.pn = rem / 8; return true;
    }
    __device__ __forceinline__ void a_ready(const pg8::Unit& u) const {
        if (wait_cnt != nullptr && u.pm >= 128) {
            if (threadIdx.x < 64) { unsigned sp = 0; while ((unsigned)__builtin_amdgcn_readfirstlane(__hip_atomic_load(wait_cnt, __ATOMIC_RELAXED, __HIP_MEMORY_SCOPE_AGENT)) < 16u && ++sp < (1u << 22)) __builtin_amdgcn_s_sleep(2);
                __builtin_amdgcn_fence(__ATOMIC_ACQUIRE, "agent"); }
            asm volatile("s_waitcnt vmcnt(0)" ::: "memory");
            __builtin_amdgcn_s_barrier();
            if (threadIdx.x < 256) rsbuf[u.idx * 256 + threadIdx.x] = row_rs(ssq, u.pm * 256 + threadIdx.x);
        }
    }
    __device__ __forceinline__ void done(const pg8::Unit& u) const {
        if (u.pm >= 128) {
            asm volatile("s_waitcnt vmcnt(0)" ::: "memory");
            __builtin_amdgcn_s_barrier();
            if (threadIdx.x == 0) { __builtin_amdgcn_fence(__ATOMIC_RELEASE, "agent"); asm volatile("s_waitcnt vmcnt(0)" ::: "memory");
                __hip_atomic_fetch_add(cnt, 1u, __ATOMIC_RELAXED, __HIP_MEMORY_SCOPE_AGENT); }
        }
    }
};
struct RangeOrder : pg8::StaticOrder {
    int pm0; unsigned* pub;
    __device__ __forceinline__ bool next(int i, pg8::Unit& u) const { if (c < 0) return false; if (!pg8::StaticOrder::next(i, u)) return false; u.pm += pm0; return true; }
    __device__ __forceinline__ void done(const pg8::Unit&) const {
        if (pub != nullptr) {
            asm volatile("s_waitcnt vmcnt(0)" ::: "memory");
            __builtin_amdgcn_s_barrier();
            if (threadIdx.x == 0) { __builtin_amdgcn_fence(__ATOMIC_RELEASE, "agent"); asm volatile("s_waitcnt vmcnt(0)" ::: "memory");
                __hip_atomic_fetch_add(pub, 1u, __ATOMIC_RELAXED, __HIP_MEMORY_SCOPE_AGENT); }
        }
    }
};
struct EpiSwiGLU {
    static constexpr bool PERM = true, AFTER_DRAIN = false;
    bf16* O; const LAS float* rsbuf;
    __device__ __forceinline__ void operator()(const pg8::f32x4 (&acc)[2][2][4][2], const pg8::Unit& u, int wr, int wc, int fr, int fq) const {
        const int row0 = u.pm * 256 + wr * 64 + fr, col0 = u.pn * 128 + wc * 32 + 8 * fq;
#pragma unroll
        for (int ai = 0; ai < 2; ++ai)
#pragma unroll
            for (int m = 0; m < 4; ++m) {
                const int row = row0 + ai * 128 + m * 16;
                const float rs = rsbuf[u.idx * 256 + (row & 255)];
                float h[8];
#pragma unroll
                for (int n = 0; n < 2; ++n)
#pragma unroll
                    for (int e = 0; e < 4; ++e) { const float g = acc[ai][0][m][n][e] * rs, up = acc[ai][1][m][n][e] * rs; h[4 * n + e] = siluf_(g) * up; }
                u32x4 w; w.x = cvtpk(h[0], h[1]); w.y = cvtpk(h[2], h[3]); w.z = cvtpk(h[4], h[5]); w.w = cvtpk(h[6], h[7]);
                *(u32x4*)(O + (size_t)row * DFF + col0) = w;
            }
    }
};
struct EpiResid {
    static constexpr bool PERM = true, AFTER_DRAIN = false;
    const float* bp; const float* bs; float* X; const bf16* XBr; bf16* XB; float* ssq; float alpha;
    __device__ __forceinline__ void operator()(const pg8::f32x4 (&acc)[2][2][4][2], const pg8::Unit& u, int wr, int wc, int fr, int fq) const {
        const int row0 = u.pm * 256 + wr * 64 + fr, col0 = u.pn * 256 + wc * 32 + 8 * fq;
        const float* base = (u.pm * 256 < NP) ? bp : (bs - (size_t)NP * DM);
        if (bp == nullptr) {
            u32x4 q[2][4][2];
#pragma unroll
            for (int ai = 0; ai < 2; ++ai)
#pragma unroll
                for (int m = 0; m < 4; ++m)
#pragma unroll
                    for (int bj = 0; bj < 2; ++bj) q[ai][m][bj] = *(const u32x4*)(XBr + (size_t)(row0 + ai * 128 + m * 16) * DM + col0 + bj * 128);
#pragma unroll
            for (int ai = 0; ai < 2; ++ai)
#pragma unroll
                for (int m = 0; m < 4; ++m) {
                    const int row = row0 + ai * 128 + m * 16;
                    float ss = 0.f;
#pragma unroll
                    for (int bj = 0; bj < 2; ++bj) {
                        const size_t off = (size_t)row * DM + col0 + bj * 128;
                        const u32x4 qq = q[ai][m][bj];
                        const f32x4 b0 = (f32x4){__builtin_bit_cast(float, qq.x << 16), __builtin_bit_cast(float, qq.x & 0xffff0000u), __builtin_bit_cast(float, qq.y << 16), __builtin_bit_cast(float, qq.y & 0xffff0000u)};
                        const f32x4 b1 = (f32x4){__builtin_bit_cast(float, qq.z << 16), __builtin_bit_cast(float, qq.z & 0xffff0000u), __builtin_bit_cast(float, qq.w << 16), __builtin_bit_cast(float, qq.w & 0xffff0000u)};
                        const f32x4 v0 = b0 + acc[ai][bj][m][0] * alpha, v1 = b1 + acc[ai][bj][m][1] * alpha;
                        if (X != nullptr) { *(f32x4*)(X + off) = v0; *(f32x4*)(X + off + 4) = v1; }
                        if (XB != nullptr) {
                            u32x4 w; w.x = cvtpk(v0[0], v0[1]); w.y = cvtpk(v0[2], v0[3]); w.z = cvtpk(v1[0], v1[1]); w.w = cvtpk(v1[2], v1[3]);
                            *(u32x4*)(XB + off) = w;
                            ss += (v0[0] * v0[0] + v0[1] * v0[1]) + (v0[2] * v0[2] + v0[3] * v0[3]) + (v1[0] * v1[0] + v1[1] * v1[1]) + (v1[2] * v1[2] + v1[3] * v1[3]); }
                    }
                    if (XB != nullptr) { ss += __shfl_xor(ss, 16); ss += __shfl_xor(ss, 32);
                        if (fq == 0) ssq[(size_t)row * 16 + 4 * u.pn + wc] = ss; }
                }
            return;
        }
#pragma unroll
        for (int ai = 0; ai < 2; ++ai) {
            f32x4 fb[4][2][2];
#pragma unroll
            for (int m = 0; m < 4; ++m)
#pragma unroll
                for (int bj = 0; bj < 2; ++bj) { const float* p = base + (size_t)(row0 + ai * 128 + m * 16) * DM + col0 + bj * 128; fb[m][bj][0] = *(const f32x4*)p; fb[m][bj][1] = *(const f32x4*)(p + 4); }
#pragma unroll
            for (int m = 0; m < 4; ++m) {
                const int row = row0 + ai * 128 + m * 16;
                float ss = 0.f;
#pragma unroll
                for (int bj = 0; bj < 2; ++bj) {
                    const size_t off = (size_t)row * DM + col0 + bj * 128;
                    const f32x4 v0 = fb[m][bj][0] + acc[ai][bj][m][0] * alpha, v1 = fb[m][bj][1] + acc[ai][bj][m][1] * alpha;
                    u32x4 w; w.x = cvtpk(v0[0], v0[1]); w.y = cvtpk(v0[2], v0[3]); w.z = cvtpk(v1[0], v1[1]); w.w = cvtpk(v1[2], v1[3]);
                    *(u32x4*)(XB + off) = w;
                    ss += (v0[0] * v0[0] + v0[1] * v0[1]) + (v0[2] * v0[2] + v0[3] * v0[3]) + (v1[0] * v1[0] + v1[1] * v1[1]) + (v1[2] * v1[2] + v1[3] * v1[3]);
                }
                ss += __shfl_xor(ss, 16); ss += __shfl_xor(ss, 32);
                if (fq == 0) ssq[(size_t)row * 16 + 4 * u.pn + wc] = ss;
            }
        }
    }
};
struct EpiMix {
    static constexpr bool PERM = true, AFTER_DRAIN = false;
    const LAS float* rsbuf; const float* qg; const float* kg; unsigned char* ws; float* out; int l; LAS unsigned char* vscr;
    __device__ __forceinline__ void operator()(const pg8::f32x4 (&acc)[2][2][4][2], const pg8::Unit& u, int wr, int wc, int fr, int fq) const {
        bf16* const GLU = (bf16*)(ws + WS_GLU); bf16* const U = (bf16*)(ws + WS_U); bf16* const VG = (bf16*)(ws + WS_VG); bf16* const Q = (bf16*)(ws + WS_Q);
        bf16* const PK = (bf16*)(ws + WS_PK); bf16* const PVT = (bf16*)(ws + WS_PVT);
        bf16* const SK = (bf16*)(ws + WS_SK) + (size_t)l * 16 * 576 * 512; bf16* const SVT = (bf16*)(ws + WS_SVT) + (size_t)l * 16 * 512 * 576;
        float* const o_pcs = out + O_PCS + (size_t)l * 4 * 30 * 256; float* const o_pk = out + O_PK + (size_t)l * 4 * 512 * 512; float* const o_pv = out + O_PV + (size_t)l * 4 * 512 * 512;
        float* const o_scs = out + O_SCS + (size_t)l * 16 * 30 * 256; float* const o_sk = out + O_SK + (size_t)l * 16 * 64 * 512; float* const o_sv = out + O_SV + (size_t)l * 16 * 64 * 512;
        const int row0 = u.pm * 256 + wr * 64 + fr, pn = u.pn;
        const bool samp = (u.pm * 256 >= NP);
        if (pn < 2) {
            const int ch0 = pn * 128 + wc * 32 + 8 * fq;
#pragma unroll
            for (int ai = 0; ai < 2; ++ai)
#pragma unroll
                for (int m = 0; m < 4; ++m) {
                    const int row = row0 + ai * 128 + m * 16; const float rs = rsbuf[u.idx * 256 + (row & 255)];
                    float h[8];
#pragma unroll
                    for (int n = 0; n < 2; ++n)
#pragma unroll
                        for (int e = 0; e < 4; ++e) h[4 * n + e] = (acc[ai][0][m][n][e] * rs) * sigmoidf_(acc[ai][1][m][n][e] * rs);
                    u32x4 w; w.x = cvtpk(h[0], h[1]); w.y = cvtpk(h[2], h[3]); w.z = cvtpk(h[4], h[5]); w.w = cvtpk(h[6], h[7]);
                    { const int grow = samp ? (GLU_SROW0 + ((row - NP) >> 6) * 94 + 30 + ((row - NP) & 63)) : ((row >> 13) * GLU_PB + 30 + (row & 8191));
                      *(u32x4*)(GLU + (size_t)grow * 256 + ch0) = w; }
                    float* dst = nullptr;
                    if (!samp) { const int b = row >> 13, t = row & 8191; if (t >= SEQ - 30) dst = o_pcs + ((size_t)(b * 30 + (t - (SEQ - 30)))) * 256 + ch0; }
                    else { const int rr = row - NP, b = rr >> 6, t = rr & 63; if (t >= 34) dst = o_scs + ((size_t)(b * 30 + (t - 34))) * 256 + ch0; }
                    if (dst) { *(f32x4*)dst = (f32x4){h[0], h[1], h[2], h[3]}; *(f32x4*)(dst + 4) = (f32x4){h[4], h[5], h[6], h[7]}; }
                }
        } else if (pn < 4) {
            bf16* O = (pn == 2) ? U : VG;
#pragma unroll
            for (int ai = 0; ai < 2; ++ai)
#pragma unroll
                for (int m = 0; m < 4; ++m) {
                    const int row = row0 + ai * 128 + m * 16; const float rs = rsbuf[u.idx * 256 + (row & 255)];
#pragma unroll
                    for (int bj = 0; bj < 2; ++bj) {
                        float h[8];
#pragma unroll
                        for (int n = 0; n < 2; ++n)
#pragma unroll
                            for (int e = 0; e < 4; ++e) h[4 * n + e] = gelu_tanh(acc[ai][bj][m][n][e] * rs);
                        u32x4 w; w.x = cvtpk(h[0], h[1]); w.y = cvtpk(h[2], h[3]); w.z = cvtpk(h[4], h[5]); w.w = cvtpk(h[6], h[7]);
                        *(u32x4*)(O + (size_t)row * 256 + bj * 128 + wc * 32 + 8 * fq) = w;
                    }
                }
        } else if (pn < 8) {
            const bool isq = pn < 6;
            const int head = 4 * ((pn - 4) & 1) + wc;
            const float* gp = isq ? qg : kg;
            const float sc = isq ? 0.125f * LOG2E : 1.f;
            float gn[2][8];
#pragma unroll
            for (int bj = 0; bj < 2; ++bj) { const f32x4 ga = *(const f32x4*)(gp + 32 * bj + 8 * fq) * sc, gb = *(const f32x4*)(gp + 32 * bj + 8 * fq + 4) * sc;
#pragma unroll
                for (int j = 0; j < 4; ++j) { gn[bj][j] = ga[j]; gn[bj][4 + j] = gb[j]; } }
#pragma unroll
            for (int ai = 0; ai < 2; ++ai)
#pragma unroll
                for (int m = 0; m < 4; ++m) {
                    const int row = row0 + ai * 128 + m * 16; const float rs = rsbuf[u.idx * 256 + (row & 255)];
                    float z[2][8]; float ss = 0.f;
#pragma unroll
                    for (int bj = 0; bj < 2; ++bj)
#pragma unroll
                        for (int n = 0; n < 2; ++n)
#pragma unroll
                            for (int e = 0; e < 4; ++e) { const float v = acc[ai][bj][m][n][e] * rs; z[bj][4 * n + e] = v; ss += v * v; }
                    ss += __shfl_xor(ss, 16); ss += __shfl_xor(ss, 32);
                    const float inv = __builtin_amdgcn_rsqf(ss * (1.f / 64.f) + EPS);
#pragma unroll
                    for (int bj = 0; bj < 2; ++bj)
#pragma unroll
                        for (int j = 0; j < 8; ++j) z[bj][j] = z[bj][j] * inv * gn[bj][j];
                    bf16* dstb; float* dstf = nullptr;
                    if (isq) dstb = Q + (size_t)row * 512 + head * 64;
                    else if (!samp) { dstb = PK + ((size_t)(head * 1024 + (row >> 5)) * 256 + (row & 31)) * 8; const int b = row >> 13, t = row & 8191; if (t >= SEQ - 512) dstf = o_pk + ((size_t)(b * 512 + (t - (SEQ - 512))) * 8 + head) * 64; }
                    else { const int rr = row - NP, b = rr >> 6, t = rr & 63; dstb = SK + (size_t)b * 294912 + ((size_t)(head * 18 + 16 + (t >> 5)) * 256 + (t & 31)) * 8; dstf = o_sk + ((size_t)(b * 64 + t) * 8 + head) * 64; }
#pragma unroll
                    for (int bj = 0; bj < 2; ++bj) {
                        u32x4 w; w.x = cvtpk(z[bj][0], z[bj][1]); w.y = cvtpk(z[bj][2], z[bj][3]); w.z = cvtpk(z[bj][4], z[bj][5]); w.w = cvtpk(z[bj][6], z[bj][7]);
                        *(u32x4*)(dstb + (isq ? 32 * bj + 8 * fq : ((2 * bj + (fq >> 1)) * 2 + (fq & 1)) * 256)) = w;
                        if (dstf) { *(f32x4*)(dstf + 32 * bj + 8 * fq) = (f32x4){z[bj][0], z[bj][1], z[bj][2], z[bj][3]}; *(f32x4*)(dstf + 32 * bj + 8 * fq + 4) = (f32x4){z[bj][4], z[bj][5], z[bj][6], z[bj][7]}; }
                    }
                }
        } else {
#pragma unroll
            for (int ai = 0; ai < 2; ++ai)
#pragma unroll
                for (int m = 0; m < 4; ++m) {
                    const int row = row0 + ai * 128 + m * 16; const float rs = rsbuf[u.idx * 256 + (row & 255)];
                    bf16* dstb; float* dstf = nullptr;
                    const int rowg = row - fr;
                    if (!samp) { dstb = PVT + (size_t)(rowg >> 5) * 2048 + ((rowg >> 4) & 1) * 512; const int b = row >> 13, t = row & 8191; if (t >= SEQ - 512) dstf = o_pv + (size_t)(b * 512 + (t - (SEQ - 512))) * 512; }
                    else { const int rr = rowg - NP, b = rr >> 6, t0 = rr & 63, t = (row - NP) & 63; dstb = SVT + (size_t)b * 294912 + (size_t)(16 + (t0 >> 5)) * 2048 + ((t0 >> 4) & 1) * 512; dstf = o_sv + (size_t)(b * 64 + t) * 512; }
                    const size_t hstride = samp ? (size_t)18 * 2048 : (size_t)1024 * 2048;
                    LAS unsigned short* sc = (LAS unsigned short*)(vscr + (wr * 4 + wc) * 1024);
                    const int ln = fq * 16 + fr;
#pragma unroll
                    for (int bj = 0; bj < 2; ++bj) {
                        const int c0 = (pn - 8) * 256 + bj * 128 + wc * 32 + 8 * fq;
                        float z[8];
#pragma unroll
                        for (int n = 0; n < 2; ++n)
#pragma unroll
                            for (int e = 0; e < 4; ++e) z[4 * n + e] = acc[ai][bj][m][n][e] * rs;
#pragma unroll
                        for (int j = 0; j < 8; j += 2) { const unsigned p = pk2(z[j], z[j + 1]); sc[(8 * fq + j) * 16 + fr] = (unsigned short)(p & 0xffffu); sc[(8 * fq + j + 1) * 16 + fr] = (unsigned short)(p >> 16); }
                        asm volatile("s_waitcnt lgkmcnt(0)" ::: "memory");
                        { const int ch = ln & 31, hx = ln >> 5;
                          const u32x2 lo = *(const LAS u32x2*)(sc + ch * 16 + 4 * hx), hh = *(const LAS u32x2*)(sc + ch * 16 + 8 + 4 * hx);
                          const int cw0 = (pn - 8) * 256 + bj * 128 + wc * 32;
                          u32x4 w; w.x = lo.x; w.y = lo.y; w.z = hh.x; w.w = hh.y;
                          *(u32x4*)(dstb + (size_t)(cw0 >> 6) * hstride + ((cw0 >> 5) & 1) * 1024 + hx * 256 + ch * 8) = w; }
                        asm volatile("s_waitcnt lgkmcnt(0)" ::: "memory");
                        if (dstf) { *(f32x4*)(dstf + c0) = (f32x4){z[0], z[1], z[2], z[3]}; *(f32x4*)(dstf + c0 + 4) = (f32x4){z[4], z[5], z[6], z[7]}; }
                    }
                }
        }
    }
};

struct TItem { const float* W; const float* gain; bf16* WT; int N, pitch, drow, k0, n0; };
__device__ __forceinline__ int win_dst_row(int n0) {
    if (n0 < 256) return 256 * (n0 >> 7) + (n0 & 127);
    if (n0 < 512) { const int ch = n0 - 256; return 256 * (ch >> 7) + 128 + (ch & 127); }
    if (n0 < 1024) return n0;
    if (n0 < 2048) { const int k = (n0 >= 1536); const int c = n0 - 1024 - 512 * k, head = c >> 6, d = c & 63; return 256 * (4 + 2 * k + (head >> 2)) + 128 * (d >> 5) + 32 * (head & 3) + (d & 31); }
    return n0;
}
constexpr int PER_LAYER = 10240, NW_ITEMS = NL * PER_LAYER, NV_ITEMS = 0, NT_ITEMS = NW_ITEMS + NV_ITEMS;
__device__ __forceinline__ TItem decode_item(CPP P, int it) {
    TItem d; unsigned char* ws = P->ws;
    if (it < NW_ITEMS) {
        const int l = it / PER_LAYER, r = it % PER_LAYER;
        unsigned char* wl = ws + WS_W + (size_t)l * W_LAYER;
        if (r < 8448) {
            const int mi = r / 1408, rr = r % 1408, ffn = mi / 3, kind = mi % 3;
            if (kind < 2) {
                const int nb = rr % 88, kb = rr / 88; d.n0 = 32 * nb; d.k0 = 64 * kb;
                d.W = P->in[(ffn ? 24 : 6) + kind] + (size_t)l * DM * DFF; d.gain = P->in[ffn ? 23 : 5] + l * DM; d.N = DFF;
                d.WT = (bf16*)(wl + (ffn ? W_GU2 : W_GU1)); d.pitch = DM; d.drow = 256 * (d.n0 >> 7) + 128 * kind + (d.n0 & 127);
            } else {
                const int nb = rr % 32, kb = rr / 32; d.n0 = 32 * nb; d.k0 = 64 * kb;
                d.W = P->in[ffn ? 26 : 8] + (size_t)l * DFF * DM; d.gain = nullptr; d.N = DM;
                d.WT = (bf16*)(wl + (ffn ? W_D2 : W_D1)); d.pitch = DFF; d.drow = d.n0;
            }
        } else if (r < 8448 + 1280) {
            const int rr = r - 8448, nb = rr % 80, kb = rr / 80; d.n0 = 32 * nb; d.k0 = 64 * kb;
            d.W = P->in[10] + (size_t)l * DM * DIN; d.gain = P->in[9] + l * DM; d.N = DIN; d.WT = (bf16*)(wl + W_IN); d.pitch = DM; d.drow = win_dst_row(d.n0);
        } else {
            const int rr = r - 8448 - 1280, nb = rr % 32, kb = rr / 32; d.n0 = 32 * nb; d.k0 = 64 * kb;
            d.W = P->in[22] + (size_t)l * DM * DM; d.gain = nullptr; d.N = DM; d.WT = (bf16*)(wl + W_OUT); d.pitch = DM; d.drow = d.n0;
        }
    } else {
        const int r = it - NW_ITEMS, lb = r >> 7, rr = r & 127, nb = rr & 15, kb = rr >> 4;
        d.n0 = 32 * nb; d.k0 = 64 * kb; d.W = P->in[4] + (size_t)lb * 512 * 512; d.gain = nullptr; d.N = 512;
        d.WT = (bf16*)(ws + WS_SVT) + (size_t)lb * 512 * 576; d.pitch = 576; d.drow = d.n0;
    }
    return d;
}
__device__ __forceinline__ void item_load(const TItem& d, int lane, float (&v)[32]) {
    const float* p = d.W + (size_t)(d.k0 + (lane >> 5)) * d.N + d.n0 + (lane & 31);
#pragma unroll
    for (int i = 0; i < 32; ++i) v[i] = p[(size_t)(2 * i) * d.N];
}
__device__ __forceinline__ void item_store(const TItem& d, int lane, const float (&v)[32], LAS float* scr) {
#pragma unroll
    for (int i = 0; i < 32; ++i) scr[(2 * i + (lane >> 5)) * 33 + (lane & 31)] = v[i];
    asm volatile("s_waitcnt lgkmcnt(0)" ::: "memory");
    const int c = lane & 7;
    f32x4 g0 = (f32x4){1.f, 1.f, 1.f, 1.f}, g1 = g0;
    if (d.gain) { g0 = *(const f32x4*)(d.gain + d.k0 + 8 * c); g1 = *(const f32x4*)(d.gain + d.k0 + 8 * c + 4); }
#pragma unroll
    for (int j = 0; j < 4; ++j) { const int n = (lane >> 3) + 8 * j; const LAS float* s = scr + (8 * c) * 33 + n;
        u32x4 o; o.x = pk2(s[0 * 33] * g0[0], s[1 * 33] * g0[1]); o.y = pk2(s[2 * 33] * g0[2], s[3 * 33] * g0[3]); o.z = pk2(s[4 * 33] * g1[0], s[5 * 33] * g1[1]); o.w = pk2(s[6 * 33] * g1[2], s[7 * 33] * g1[3]);
        *(u32x4*)(d.WT + (size_t)(d.drow + n) * d.pitch + d.k0 + 8 * c) = o; }
    asm volatile("s_waitcnt lgkmcnt(0)" ::: "memory");
}
__device__ __forceinline__ void convert_caches(CPP P, int l, int gt, int NGT) {
    unsigned char* ws = P->ws;
    bf16* SK = (bf16*)(ws + WS_SK); bf16* SV = (bf16*)(ws + WS_SVT);
    for (int i0 = gt; i0 < 16 * 512 * 64; i0 += 4 * NGT) {
        f32x4 a[4], b[4];
#pragma unroll
        for (int q = 0; q < 4; ++q) { const int i = i0 + q * NGT; const int ii = i < 16 * 512 * 64 ? i : i0; const int c8 = ii & 63, s_ = (ii >> 6) & 511, lb = l * 16 + (ii >> 15);
            const f32x4* srck = (const f32x4*)(P->in[3] + ((size_t)(lb * 512 + s_)) * 512 + 8 * c8); a[q] = srck[0]; b[q] = srck[1]; }
#pragma unroll
        for (int q = 0; q < 4; ++q) { const int i = i0 + q * NGT;
            if (i < 16 * 512 * 64) { const int c8 = i & 63, s_ = (i >> 6) & 511, lb = l * 16 + (i >> 15), head = c8 >> 3, d0 = (c8 & 7) * 8;
                u32x4 w; w.x = pk2(a[q][0], a[q][1]); w.y = pk2(a[q][2], a[q][3]); w.z = pk2(b[q][0], b[q][1]); w.w = pk2(b[q][2], b[q][3]);
                *(u32x4*)(SK + (size_t)lb * 294912 + (size_t)(head * 18 + (s_ >> 5)) * 2048 + ((((d0 >> 4) * 2 + ((d0 >> 3) & 1)) * 32) + (s_ & 31)) * 8) = w; } }
    }
    for (int i0 = gt; i0 < 16 * 64 * 512; i0 += 2 * NGT) {
        float v[2][8];
#pragma unroll
        for (int q = 0; q < 2; ++q) { const int i = i0 + q * NGT; const int ii = i < 16 * 64 * 512 ? i : i0; const int ch = ii & 511, kg = (ii >> 9) & 63, lb = l * 16 + (ii >> 15), kb = kg >> 2, sx = (kg >> 1) & 1, hx = kg & 1;
            const float* src = P->in[4] + ((size_t)(lb * 512 + 32 * kb + 16 * sx + 4 * hx)) * 512 + ch;
#pragma unroll
            for (int j = 0; j < 8; ++j) v[q][j] = src[(size_t)(8 * (j >> 2) + (j & 3)) * 512]; }
#pragma unroll
        for (int q = 0; q < 2; ++q) { const int i = i0 + q * NGT;
            if (i < 16 * 64 * 512) { const int ch = i & 511, kg = (i >> 9) & 63, lb = l * 16 + (i >> 15), kb = kg >> 2, sx = (kg >> 1) & 1, hx = kg & 1, head = ch >> 6, d = ch & 63;
                u32x4 w; w.x = pk2(v[q][0], v[q][1]); w.y = pk2(v[q][2], v[q][3]); w.z = pk2(v[q][4], v[q][5]); w.w = pk2(v[q][6], v[q][7]);
                *(u32x4*)(SV + (size_t)lb * 294912 + (size_t)(head * 18 + kb) * 2048 + (((((d >> 5) * 2 + sx) * 2 + hx) * 32) + (d & 31)) * 8) = w; } }
    }
}
__device__ __forceinline__ void convert_items(CPP P, LAS unsigned char* lds, int it0, int it1, int worker, int nworkers, int wave, int lane) {
    LAS float* scr = (LAS float*)(lds + wave * 16384);
    const int gw = it0 + worker * NWAVES + wave, NGW = nworkers * NWAVES;
    if (gw < it1) {
        TItem cur = decode_item(P, gw); float v[32]; item_load(cur, lane, v);
#pragma unroll 1
        for (int it = gw; it < it1; it += NGW) {
            const int nx = it + NGW; const bool has = nx < it1;
            TItem nd = decode_item(P, has ? nx : it); float vn[32];
            if (has) item_load(nd, lane, vn);
            item_store(cur, lane, v, scr);
            if (has) {
#pragma unroll
                for (int i = 0; i < 32; ++i) v[i] = vn[i];
                cur = nd; }
        }
    }
}
__device__ __forceinline__ void prologue(CPP P, LAS unsigned char* lds, int vb, int G, int wave, int lane) {
    LAS float* scr = (LAS float*)(lds + wave * 16384);
    const int gw = vb * NWAVES + wave, NGW = G * NWAVES;
    unsigned char* ws = P->ws;
    convert_items(P, lds, 0, PER_LAYER, vb, G, wave, lane);
    bf16* XB = (bf16*)(ws + WS_XB); float* ssq = (float*)(ws + WS_SSQ);
    for (int m0 = gw; m0 < MROWS; m0 += 4 * NGW) {
        f32x4 a[4][4];
#pragma unroll
        for (int q = 0; q < 4; ++q) { const int m = m0 + q * NGW; const int mm = m < MROWS ? m : m0;
            const float* xr = (mm < NP) ? P->in[0] + (size_t)mm * DM : P->in[1] + (size_t)(mm - NP) * DM;
#pragma unroll
            for (int j = 0; j < 4; ++j) a[q][j] = ((const f32x4*)xr)[lane + 64 * j]; }
#pragma unroll
        for (int q = 0; q < 4; ++q) { const int m = m0 + q * NGW;
            if (m < MROWS) { float s0 = 0.f;
#pragma unroll
                for (int j = 0; j < 4; ++j) { s0 += (a[q][j][0] * a[q][j][0] + a[q][j][1] * a[q][j][1]) + (a[q][j][2] * a[q][j][2] + a[q][j][3] * a[q][j][3]);
                    u32x2 w; w.x = pk2(a[q][j][0], a[q][j][1]); w.y = pk2(a[q][j][2], a[q][j][3]); ((u32x2*)(XB + (size_t)m * DM))[lane + 64 * j] = w; }
                s0 += __shfl_xor(s0, 16); s0 += __shfl_xor(s0, 32);
                if (lane < 16) ssq[(size_t)m * 16 + lane] = s0; } }
    }
    const int gt = vb * (NWAVES * 64) + wave * 64 + lane, NGT = G * NWAVES * 64;
    bf16* WT = (bf16*)(ws + WS_WTRIL);
    for (int i = gt; i < NL * 4 * 128 * 128; i += NGT) { const int s = i & 127, t = (i >> 7) & 127; WT[i] = (bf16)(s <= t ? f2bf(P->in[17][i]) : 0u); }
    convert_caches(P, 0, gt, NGT);
}

#define MFMA32(a, b, c) __builtin_amdgcn_mfma_f32_32x32x16_bf16((a), (b), (c), 0, 0, 0)
template <int KH>
__device__ __forceinline__ void attn_block(const bf16x8 (&Kf)[4], const bf16x8 (&Vf)[2][2], const bf16x8 (&Qf)[2][4], f32x16 (&O)[2][2], float (&mrun)[2], float (&lsum)[2],
                                           int delta, int r, int hi, const LAS float* tblR) {
    f32x16 S[2];
    if (delta >= 3) {
#pragma unroll
        for (int qb = 0; qb < 2; ++qb)
#pragma unroll
            for (int i = 0; i < 16; ++i) S[qb][i] = 0.f; }
    else {
#pragma unroll
        for (int qb = 0; qb < 2; ++qb) { const LAS float* tp = tblR + (191 - (64 * delta + (32 * qb + r) - (32 * KH + 4 * hi)));
#pragma unroll
            for (int i = 0; i < 16; ++i) S[qb][i] = tp[(i & 3) + 8 * (i >> 2)]; } }
#pragma unroll
    for (int kk = 0; kk < 4; ++kk)
#pragma unroll
        for (int qb = 0; qb < 2; ++qb) S[qb] = MFMA32(Kf[kk], Qf[qb][kk], S[qb]);
    float mx[2], mnew[2], alpha[2];
#pragma unroll
    for (int qb = 0; qb < 2; ++qb) { float m = fmaxf(fmaxf(S[qb][0], S[qb][1]), fmaxf(S[qb][2], S[qb][3]));
#pragma unroll
        for (int i = 4; i < 16; i += 2) m = fmaxf(m, fmaxf(S[qb][i], S[qb][i + 1]));
        mx[qb] = m; }
#pragma unroll
    for (int qb = 0; qb < 2; ++qb) mx[qb] = fmaxf(mx[qb], __shfl_xor(mx[qb], 32));
#pragma unroll
    for (int qb = 0; qb < 2; ++qb) { mnew[qb] = fmaxf(mrun[qb], mx[qb]); alpha[qb] = fast_exp2(mrun[qb] - mnew[qb]); mrun[qb] = mnew[qb]; }
#pragma unroll
    for (int i = 0; i < 16; ++i)
#pragma unroll
        for (int qb = 0; qb < 2; ++qb) S[qb][i] = fast_exp2(S[qb][i] - mnew[qb]);
#pragma unroll
    for (int qb = 0; qb < 2; ++qb) {
        const float ps = (((S[qb][0] + S[qb][1]) + (S[qb][2] + S[qb][3])) + ((S[qb][4] + S[qb][5]) + (S[qb][6] + S[qb][7]))) + (((S[qb][8] + S[qb][9]) + (S[qb][10] + S[qb][11])) + ((S[qb][12] + S[qb][13]) + (S[qb][14] + S[qb][15])));
        lsum[qb] = lsum[qb] * alpha[qb] + ps; }
    if (__builtin_amdgcn_ballot_w64(alpha[0] != 1.f || alpha[1] != 1.f) != 0ull) {
#pragma unroll
        for (int qb = 0; qb < 2; ++qb)
#pragma unroll
            for (int db = 0; db < 2; ++db)
#pragma unroll
                for (int i = 0; i < 16; ++i) O[db][qb][i] *= alpha[qb]; }
    bf16x8 Pf[2][2];
#pragma unroll
    for (int qb = 0; qb < 2; ++qb)
#pragma unroll
        for (int s = 0; s < 2; ++s) { u32x4 w; w.x = pk2(S[qb][8 * s], S[qb][8 * s + 1]); w.y = pk2(S[qb][8 * s + 2], S[qb][8 * s + 3]); w.z = pk2(S[qb][8 * s + 4], S[qb][8 * s + 5]); w.w = pk2(S[qb][8 * s + 6], S[qb][8 * s + 7]); Pf[qb][s] = __builtin_bit_cast(bf16x8, w); }
#pragma unroll
    for (int s = 0; s < 2; ++s)
#pragma unroll
        for (int qb = 0; qb < 2; ++qb)
#pragma unroll
            for (int db = 0; db < 2; ++db) O[db][qb] = MFMA32(Vf[db][s], Pf[qb][s], O[db][qb]);
}
__device__ __forceinline__ void attn_unit(CPP P, int l, int u, int wave, int lane, const LAS float* tblR) {
    unsigned char* ws = P->ws;
    const int h = wave, r = lane & 31, hi = lane >> 5;
    const bf16* Kb0; const bf16* Vb0; int ntiles, row0;
    int cm = 0;
    if (u < 512) { const int b = u >> 7, c = u & 127; cm = c % 9; row0 = b * SEQ + 64 * c; ntiles = (c < 8 ? c : 8) + 1; const int kbg0 = (row0 - 64 * (ntiles - 1)) >> 5;
        Kb0 = (const bf16*)(ws + WS_PK) + (size_t)(h * 1024 + kbg0) * 2048; Vb0 = (const bf16*)(ws + WS_PVT) + (size_t)(h * 1024 + kbg0) * 2048; }
    else { const int b = u - 512; row0 = NP + 64 * b; ntiles = 9;
        Kb0 = (const bf16*)(ws + WS_SK) + (size_t)(l * 16 + b) * 294912 + (size_t)(h * 18) * 2048; Vb0 = (const bf16*)(ws + WS_SVT) + (size_t)(l * 16 + b) * 294912 + (size_t)(h * 18) * 2048; }
    const bf16* Qp = (const bf16*)(ws + WS_Q) + (size_t)row0 * 512 + h * 64;
    bf16x8 Qf[2][4];
#pragma unroll
    for (int qb = 0; qb < 2; ++qb)
#pragma unroll
        for (int kk = 0; kk < 4; ++kk) Qf[qb][kk] = *(const bf16x8*)(Qp + (size_t)(32 * qb + r) * 512 + 16 * kk + 8 * hi);
    f32x16 O[2][2];
#pragma unroll
    for (int a = 0; a < 2; ++a)
#pragma unroll
        for (int b = 0; b < 2; ++b)
#pragma unroll
            for (int i = 0; i < 16; ++i) O[a][b][i] = 0.f;
    float mrun[2] = {-1e30f, -1e30f}, lsum[2] = {0.f, 0.f};
#define ATT_LOAD_K(kb_, Kd) do { const bf16* kp_ = Kb0 + (size_t)(kb_) * 2048 + (hi * 32 + r) * 8; \
        _Pragma("unroll") for (int kk = 0; kk < 4; ++kk) Kd[kk] = *(const bf16x8*)(kp_ + kk * 512); } while (0)
#define ATT_LOAD_V(kb_, Vd) do { const bf16* vp_ = Vb0 + (size_t)(kb_) * 2048 + (hi * 32 + r) * 8; \
        _Pragma("unroll") for (int db = 0; db < 2; ++db) _Pragma("unroll") for (int s_ = 0; s_ < 2; ++s_) Vd[db][s_] = *(const bf16x8*)(vp_ + (db * 2 + s_) * 512); } while (0)
    const bool full = (ntiles == 9);
#define ATT_TILE_OF(t_) (full ? 8 - ((cm - (t_) + 9) % 9) : (t_))
    bf16x8 K0[4], K1[4], Vc[2][2];
    int ti = ATT_TILE_OF(0);
    ATT_LOAD_K(2 * ti, K0);
#pragma unroll 1
    for (int t = 0; t < ntiles; ++t) {
        const int delta = (ntiles - 1) - ti;
        ATT_LOAD_K(2 * ti + 1, K1); ATT_LOAD_V(2 * ti, Vc);
        attn_block<0>(K0, Vc, Qf, O, mrun, lsum, delta, r, hi, tblR);
        const int tn = (t + 1 < ntiles) ? ATT_TILE_OF(t + 1) : ti;
        ATT_LOAD_K(2 * tn, K0); ATT_LOAD_V(2 * ti + 1, Vc);
        attn_block<1>(K1, Vc, Qf, O, mrun, lsum, delta, r, hi, tblR);
        ti = tn;
    }
#undef ATT_TILE_OF
#undef ATT_LOAD_K
#undef ATT_LOAD_V
    bf16* MX = (bf16*)(ws + WS_MIX);
#pragma unroll
    for (int qb = 0; qb < 2; ++qb) {
        const float lt = lsum[qb] + __shfl_xor(lsum[qb], 32), inv = 1.f / lt;
        bf16* orow = MX + (size_t)(row0 + 32 * qb + r) * DM + 512 + h * 64;
#pragma unroll
        for (int db = 0; db < 2; ++db)
#pragma unroll
            for (int g = 0; g < 4; ++g) { u32x2 w; w.x = pk2(O[db][qb][4 * g] * inv, O[db][qb][4 * g + 1] * inv); w.y = pk2(O[db][qb][4 * g + 2] * inv, O[db][qb][4 * g + 3] * inv);
                *(u32x2*)(orow + 32 * db + 8 * g + 4 * hi) = w; }
    }
}
constexpr int VPITCH = 136;
__device__ __forceinline__ void gmlp_unit(CPP P, int l, int g, int wave, int lane, LAS bf16* vnT) {
    unsigned char* ws = P->ws;
    const bool samp = g >= 256;
    const int row0 = samp ? NP + 64 * (g - 256) : 128 * g, T = samp ? 64 : 128;
    const bf16* VG = (const bf16*)(ws + WS_VG);
    const f32x4 gg = *(const f32x4*)(P->in[15] + l * 256 + 4 * lane), bb = *(const f32x4*)(P->in[16] + l * 256 + 4 * lane);
    {
        const int nq = T >> 3;
        u32x2 raw[16];
#pragma unroll
        for (int q = 0; q < 16; ++q) if (q < nq) raw[q] = *(const u32x2*)(VG + (size_t)(row0 + 4 * wave + 32 * (q >> 2) + (q & 3)) * 256 + 4 * lane);
        f32x4 x[16]; float sm[16], sq[16];
#pragma unroll
        for (int q = 0; q < 16; ++q) if (q < nq) { x[q] = (f32x4){__builtin_bit_cast(float, raw[q].x << 16), __builtin_bit_cast(float, raw[q].x & 0xffff0000u), __builtin_bit_cast(float, raw[q].y << 16), __builtin_bit_cast(float, raw[q].y & 0xffff0000u)};
            sm[q] = (x[q][0] + x[q][1]) + (x[q][2] + x[q][3]); }
#pragma unroll
        for (int o = 1; o < 64; o <<= 1)
#pragma unroll
            for (int q = 0; q < 16; ++q) if (q < nq) sm[q] += __shfl_xor(sm[q], o);
#pragma unroll
        for (int q = 0; q < 16; ++q) if (q < nq) { x[q] = x[q] - sm[q] * (1.f / 256.f); sq[q] = (x[q][0] * x[q][0] + x[q][1] * x[q][1]) + (x[q][2] * x[q][2] + x[q][3] * x[q][3]); }
#pragma unroll
        for (int o = 1; o < 64; o <<= 1)
#pragma unroll
            for (int q = 0; q < 16; ++q) if (q < nq) sq[q] += __shfl_xor(sq[q], o);
#pragma unroll
        for (int q = 0; q < 16; ++q) if (q < nq) { const float rstd = __builtin_amdgcn_rsqf(sq[q] * (1.f / 256.f) + EPS); const f32x4 y = x[q] * rstd * gg + bb; const int t = 4 * wave + 32 * (q >> 2) + (q & 3);
            if (samp) *(f32x4*)(P->out + O_SG + ((size_t)((l * 16 + (g - 256)) * 64 + t)) * 256 + 4 * lane) = y;
            const unsigned p01 = pk2(y[0], y[1]), p23 = pk2(y[2], y[3]);
            vnT[(4 * lane + 0) * VPITCH + t] = (bf16)(p01 & 0xffffu); vnT[(4 * lane + 1) * VPITCH + t] = (bf16)(p01 >> 16);
            vnT[(4 * lane + 2) * VPITCH + t] = (bf16)(p23 & 0xffffu); vnT[(4 * lane + 3) * VPITCH + t] = (bf16)(p23 >> 16); }
    }
    __syncthreads();
    const int h = wave >> 1, th = wave & 1, r = lane & 31, hi = lane >> 5;
    if (64 * th < T) {
        const int nks = (th == 0) ? 4 : 8;
        f32x16 acc[2][2];
#pragma unroll
        for (int a = 0; a < 2; ++a)
#pragma unroll
            for (int b = 0; b < 2; ++b)
#pragma unroll
                for (int i = 0; i < 16; ++i) acc[a][b][i] = 0.f;
        const bf16* Wp = (const bf16*)(ws + WS_WTRIL) + ((size_t)(l * 4 + h) * 128) * 128;
        bf16x8 Bw[8][2];
#pragma unroll
        for (int ks = 0; ks < 8; ++ks)
#pragma unroll
            for (int tb = 0; tb < 2; ++tb) if (ks < nks) Bw[ks][tb] = *(const bf16x8*)(Wp + (size_t)(64 * th + 32 * tb + r) * 128 + 16 * ks + 8 * hi);
#pragma unroll
        for (int ks = 0; ks < 8; ++ks) if (ks < nks) {
            bf16x8 A[2];
#pragma unroll
            for (int db = 0; db < 2; ++db) A[db] = *(const LAS bf16x8*)(vnT + (h * 64 + 32 * db + r) * VPITCH + 16 * ks + 8 * hi);
#pragma unroll
            for (int db = 0; db < 2; ++db)
#pragma unroll
                for (int tb = 0; tb < 2; ++tb) acc[db][tb] = MFMA32(A[db], Bw[ks][tb], acc[db][tb]);
        }
        const bf16* U = (const bf16*)(ws + WS_U); bf16* MX = (bf16*)(ws + WS_MIX);
#pragma unroll
        for (int tb = 0; tb < 2; ++tb) {
            const int t = 64 * th + 32 * tb + r, row = row0 + t;
            const float bias = P->in[18][(l * 4 + h) * 128 + t];
#pragma unroll
            for (int db = 0; db < 2; ++db)
#pragma unroll
                for (int g4 = 0; g4 < 4; ++g4) { const int d = 32 * db + 8 * g4 + 4 * hi;
                    const u32x2 uu = *(const u32x2*)(U + (size_t)row * 256 + h * 64 + d);
                    const float u0 = __builtin_bit_cast(float, uu.x << 16), u1 = __builtin_bit_cast(float, uu.x & 0xffff0000u), u2 = __builtin_bit_cast(float, uu.y << 16), u3 = __builtin_bit_cast(float, uu.y & 0xffff0000u);
                    u32x2 w; w.x = pk2((acc[db][tb][4 * g4] + bias) * u0, (acc[db][tb][4 * g4 + 1] + bias) * u1); w.y = pk2((acc[db][tb][4 * g4 + 2] + bias) * u2, (acc[db][tb][4 * g4 + 3] + bias) * u3);
                    *(u32x2*)(MX + (size_t)row * DM + 256 + h * 64 + d) = w; }
        }
    }
    __syncthreads();
}
constexpr int CW_OFF = 73728;
__device__ __forceinline__ void conv_units(CPP P, int l, int first, int stride, int wave, int lane, const LAS float* cwL) {
    unsigned char* ws = P->ws;
    const f32x4 cb = *(const f32x4*)(P->in[12] + l * 256 + 4 * lane), lg = *(const f32x4*)(P->in[13] + l * 256 + 4 * lane), lb = *(const f32x4*)(P->in[14] + l * 256 + 4 * lane);
    const bf16* GLU = (const bf16*)(ws + WS_GLU); bf16* MX = (bf16*)(ws + WS_MIX);
    const LAS f32x4* cw = (const LAS f32x4*)cwL + lane;
    for (int tile = first; tile < 528; tile += stride) {
        const int row0 = 64 * tile + 8 * wave;
        const int grow0 = (tile >= 512) ? (GLU_SROW0 + (tile - 512) * 94 + 8 * wave) : ((tile >> 7) * GLU_PB + (tile & 127) * 64 + 8 * wave);
        f32x4 acc[8];
#pragma unroll
        for (int tt = 0; tt < 8; ++tt) acc[tt] = cb;
        u32x2 xr[38];
#pragma unroll
        for (int j = 0; j < 38; ++j) xr[j] = *(const u32x2*)(GLU + (size_t)(grow0 + j) * 256 + 4 * lane);
        __builtin_amdgcn_sched_barrier(0);
#pragma unroll
        for (int j = 0; j < 38; ++j) {
            const u32x2 w = xr[j];
            const f32x4 x = (f32x4){__builtin_bit_cast(float, w.x << 16), __builtin_bit_cast(float, w.x & 0xffff0000u), __builtin_bit_cast(float, w.y << 16), __builtin_bit_cast(float, w.y & 0xffff0000u)};
#pragma unroll
            for (int tt = 0; tt < 8; ++tt) { const int tap = j - tt; if (tap >= 0 && tap <= 30) acc[tt] += cw[tap * 64] * x; }
            __builtin_amdgcn_sched_barrier(0);
        }
        float sm[8], sq[8];
#pragma unroll
        for (int tt = 0; tt < 8; ++tt) sm[tt] = (acc[tt][0] + acc[tt][1]) + (acc[tt][2] + acc[tt][3]);
#pragma unroll
        for (int o = 1; o < 64; o <<= 1)
#pragma unroll
            for (int tt = 0; tt < 8; ++tt) sm[tt] += __shfl_xor(sm[tt], o);
#pragma unroll
        for (int tt = 0; tt < 8; ++tt) { acc[tt] = acc[tt] - sm[tt] * (1.f / 256.f); sq[tt] = (acc[tt][0] * acc[tt][0] + acc[tt][1] * acc[tt][1]) + (acc[tt][2] * acc[tt][2] + acc[tt][3] * acc[tt][3]); }
#pragma unroll
        for (int o = 1; o < 64; o <<= 1)
#pragma unroll
            for (int tt = 0; tt < 8; ++tt) sq[tt] += __shfl_xor(sq[tt], o);
#pragma unroll
        for (int tt = 0; tt < 8; ++tt) {
            const float rstd = __builtin_amdgcn_rsqf(sq[tt] * (1.f / 256.f) + EPS);
            const f32x4 y = acc[tt] * rstd * lg + lb;
            u32x2 w; w.x = pk2(siluf_(y[0]), siluf_(y[1])); w.y = pk2(siluf_(y[2]), siluf_(y[3]));
            *(u32x2*)(MX + (size_t)(row0 + tt) * DM + 4 * lane) = w;
        }
    }
}

__global__ void __launch_bounds__(NWAVES * 64, 2) mega_fwd(Params Pk) {
    extern __shared__ __attribute__((aligned(16))) unsigned char lds_raw[];
    LAS unsigned char* lds = (LAS unsigned char*)lds_raw;
    cg::grid_group grid = cg::this_grid();
    const int tid = threadIdx.x, lane = tid & 63, wave = __builtin_amdgcn_readfirstlane(tid >> 6);
    constexpr int G = GRID_WG; const int bx = blockIdx.x;
    const int vb = (G % 8 == 0) ? (bx % 8) * (G / 8) + bx / 8 : bx;
    unsigned char* ws = kparams()->ws;
    float* ssq = (float*)(ws + WS_SSQ); LAS float* rsbuf = (LAS float*)(lds + RS_OFF);
    bf16* XB = (bf16*)(ws + WS_XB); bf16* AH = (bf16*)(ws + WS_A); bf16* MX = (bf16*)(ws + WS_MIX);

    if (tid < 4) ((LAS unsigned*)(lds + XB_OFF))[tid] = 0u;
    __syncthreads();
    const XcdBarrier xbar = xcd_barrier_post((unsigned*)(ws + WS_BAR), (volatile LAS unsigned*)(lds + XB_OFF));
#ifndef DIS_PRO
    for (int rep = 0; rep < REP_PRO; ++rep) { prologue(kparams(), lds, vb, G, wave, lane); __syncthreads(); }
#endif
    if (ws == nullptr) grid.sync();
    xcd_barrier(xbar);

#pragma unroll 1
    for (int l = 0; l < NL; ++l) {
        unsigned char* wl = ws + WS_W + (size_t)l * W_LAYER;
#pragma unroll 1
        for (int k = 0; k < 10; ++k) { const int st = (k < 6) ? k : (k == 6 ? 9 : k - 1);
            CPP P = kparams();
            int bxl = blockIdx.x; asm volatile("" : "+s"(bxl));
            unsigned* cnt = (unsigned*)(ws + WS_CNT) + 64 * (2 * l + ((st >= 5 && st != 9) ? 1 : 0));
            unsigned* cntO = (unsigned*)(ws + WS_CNT) + 64 * (4 + l);
            if (st == 0 || st == 6) {
                pg8::Gemm g{XB, (const bf16*)(wl + (st ? W_GU2 : W_GU1)), MROWS, 2 * DFF, DM};
                GuOrder S; S.init(MROWS, 2 * DFF, G, bxl); S.ssq = ssq; S.rsbuf = rsbuf; S.cnt = cnt; S.wait_cnt = st ? cntO : nullptr; S.samp_i = st ? 2 : 0;
                EpiSwiGLU E{AH, rsbuf};
                { int t_ = threadIdx.x; asm volatile("" : "+v"(t_)); rs_fill(S, ssq, rsbuf, t_); }
#ifndef DIS_GU
                pg8::gemm_phase<EpiSwiGLU, GuOrder, true, true>(lds, g, S, E);
#endif
            } else if (st == 1 || st == 2 || st == 5 || st == 7 || st == 8 || st == 9) {
                const bool first = (l == 0 && st <= 2), samp = (st == 1 || st == 7), isout = (st == 5 || st == 9);
                if (samp && bxl >= 240) {
                    if (threadIdx.x == 0) { unsigned sp = 0; while (__hip_atomic_load(cnt, __ATOMIC_RELAXED, __HIP_MEMORY_SCOPE_AGENT) < 88u && ++sp < (1u << 24)) __builtin_amdgcn_s_sleep(2);
                        __builtin_amdgcn_fence(__ATOMIC_ACQUIRE, "agent"); asm volatile("s_waitcnt vmcnt(0)" ::: "memory"); }
                    __syncthreads();
                }
                pg8::Gemm g{isout ? MX : AH, (const bf16*)(wl + (isout ? W_OUT : (st < 5 ? W_D1 : W_D2))), MROWS, DM, isout ? DM : DFF};
                RangeOrder S;
                S.pub = nullptr;
                if (samp) { S.init(NS, DM, 16, bxl - 240); S.pm0 = NP / 256; } else if (st == 9) { S.init(NS, DM, 16, (bxl >= 224 && bxl < 240) ? bxl - 224 : -1); S.pm0 = NP / 256; S.pub = cntO; } else { S.init(NP, DM, G, bxl); S.pm0 = 0; }
                const bool lastg = (l == NL - 1 && (st == 7 || st == 8));
                EpiResid E{first ? P->in[0] : nullptr, first ? P->in[1] : nullptr, lastg ? P->out : nullptr, XB, lastg ? nullptr : XB, ssq, isout ? 1.f : 0.5f};
#ifndef DIS_RES
                pg8::gemm_phase<EpiResid, RangeOrder, true, true>(lds, g, S, E);
#endif
            } else if (st == 3) {
                pg8::Gemm g{XB, (const bf16*)(wl + W_IN), MROWS, DIN, DM};
                { int t_ = threadIdx.x; asm volatile("" : "+v"(t_));
                  bf16* GLU = (bf16*)(ws + WS_GLU);
                  for (int i = bxl * (NWAVES * 64) + t_; i < 20 * 30 * 64; i += G * (NWAVES * 64)) {
                      const int c4 = i & 63, p = (i >> 6) % 30, sb = i / (64 * 30);
                      u32x2 w; w.x = 0u; w.y = 0u; int grow;
                      if (sb < 4) grow = sb * GLU_PB + p;
                      else { grow = GLU_SROW0 + (sb - 4) * 94 + p; const f32x4 c = *(const f32x4*)(P->in[2] + ((size_t)((l * 16 + (sb - 4)) * 30 + p)) * 256 + 4 * c4); w.x = pk2(c[0], c[1]); w.y = pk2(c[2], c[3]); }
                      *(u32x2*)(GLU + (size_t)grow * 256 + 4 * c4) = w; } }
                RsOrder S; S.init(MROWS, DIN, G, bxl); S.ssq = ssq; S.rsbuf = rsbuf;
                EpiMix E{rsbuf, P->in[19] + l * 64, P->in[20] + l * 64, ws, P->out, l, lds + VSCR_OFF};
                { int t_ = threadIdx.x; asm volatile("" : "+v"(t_)); rs_fill(S, ssq, rsbuf, t_); }
#ifndef DIS_IN
                pg8::gemm_phase<EpiMix, RsOrder, true, true>(lds, g, S, E);
#endif
                if (l == 0 && bxl >= 40) { int t_ = threadIdx.x; asm volatile("" : "+v"(t_)); convert_items(P, lds, PER_LAYER, 2 * PER_LAYER, bxl - 40, G - 40, __builtin_amdgcn_readfirstlane(t_ >> 6), t_ & 63);
                    convert_caches(P, 1, (bxl - 40) * (NWAVES * 64) + t_, (G - 40) * (NWAVES * 64)); }
            } else {
                for (int rep = 0; rep < REP_MIX; ++rep) {
                int tid_ = threadIdx.x; asm volatile("" : "+v"(tid_)); const int lane_ = tid_ & 63;
                LAS float* tblR = (LAS float*)(lds + BIAS_OFF) + wave * 260;
                for (int j = lane_; j < 256; j += 64) { const int rel = 191 - j; const int idx = (j == 255 || rel > 128) ? 256 : rel + 128; tblR[j] = (P->in[21][(size_t)(l * 8 + wave) * 257 + idx] - P->in[21][(size_t)(l * 8 + wave) * 257 + 256]) * LOG2E; }
                { LAS float* cwL0 = (LAS float*)(lds + CW_OFF);
                  for (int i = tid_; i < 31 * 256; i += NWAVES * 64) cwL0[i] = P->in[11][(size_t)l * 31 * 256 + i]; }
                asm volatile("s_waitcnt lgkmcnt(0)" ::: "memory");
                __syncthreads();
#ifndef DIS_ATTN
                const int vbm = (bxl % 8) * (G / 8) + bxl / 8;
                for (int sl = vbm; sl < 512; sl += G) {
                    int u0, u1 = 0, nu = 1;
                    if (sl < 480) u0 = (sl / 120) * 128 + 8 + (sl % 120);
                    else if (sl < 496) u0 = 512 + (sl - 480);
                    else { const int q = sl - 496, ub = (q >> 2) * 128, c1 = q & 3; u0 = ub + c1; u1 = ub + 7 - c1; nu = 2; }
#pragma unroll 1
                    for (int k = 0; k < nu; ++k) attn_unit(P, l, k ? u1 : u0, wave, lane_, tblR);
                }
#endif
                const int R = G, jr = bxl;
#ifndef DIS_GMLP
                if (jr >= 0) for (int k = jr; k < 272; k += R) gmlp_unit(P, l, k, wave, lane_, (LAS bf16*)lds);
#endif
#ifndef DIS_CONV
                { LAS float* cwL = (LAS float*)(lds + CW_OFF);
                  if (jr >= 0) conv_units(P, l, R - 1 - jr, R, wave, lane_, cwL); }
#endif
                __syncthreads(); }
            }
            if (!(l == NL - 1 && st == 8) && st != 0 && st != 6 && st != 9) for (int rep = 0; rep < REP_SYNC; ++rep) xcd_barrier(xbar);
        }
    }
}

extern "C" void kernel_launch(void* const* d_in, const int* in_sizes, int n_in, void* d_out, int out_size, void* d_ws, size_t ws_size, hipStream_t stream) {
    static int grid = 0;
    if (grid == 0) {
        if (n_in != 27 || (size_t)out_size != O_END || ws_size < WS_END) { fprintf(stderr, "kernel_launch: unexpected shapes n_in %d out %d ws %zu\n", n_in, out_size, ws_size); grid = -1; return; }
        int dev = 0, cus = 0, per_cu = 0;
        (void)hipGetDevice(&dev); (void)hipDeviceGetAttribute(&cus, hipDeviceAttributeMultiprocessorCount, dev);
        if (hipFuncSetAttribute((const void*)mega_fwd, hipFuncAttributeMaxDynamicSharedMemorySize, LDS_BYTES) != hipSuccess) { fprintf(stderr, "kernel_launch: hipFuncSetAttribute failed\n"); grid = -1; return; }
        if (hipOccupancyMaxActiveBlocksPerMultiprocessor(&per_cu, (const void*)mega_fwd, NWAVES * 64, LDS_BYTES) != hipSuccess || per_cu < 1) { fprintf(stderr, "kernel_launch: occupancy query gave %d\n", per_cu); per_cu = 1; }
        (void)hipGetLastError();
        grid = cus * per_cu;
        if (grid != GRID_WG) { fprintf(stderr, "kernel_launch: this build is for a co-resident grid of %d workgroups, the device offers %d; nothing launched\n", GRID_WG, grid); grid = -1; return; }
        fprintf(stderr, "kernel_launch: grid %d (cus %d x %d)\n", grid, cus, per_cu);
    }
    if (grid < 0) return;
    if (hipMemsetAsync((char*)d_ws + WS_BAR, 0, 16384 + 4096, stream) != hipSuccess) { fprintf(stderr, "kernel_launch: memset failed\n"); return; }
    Params p{};
    for (int i = 0; i < 27; ++i) p.in[i] = (const float*)d_in[i];
    p.out = (float*)d_out; p.ws = (unsigned char*)d_ws;
    void* args[] = {&p};
    hipError_t e = hipLaunchCooperativeKernel((const void*)mega_fwd, dim3(grid), dim3(NWAVES * 64), args, LDS_BYTES, stream);
    if (e != hipSuccess) fprintf(stderr, "kernel_launch: cooperative launch failed: %s (grid %d)\n", hipGetErrorString(e), grid);
}
```

```cpp
#include <hip/hip_runtime.h>
#include <hip/hip_cooperative_groups.h>
#include <cstdio>
#include <cstdint>
namespace cg = cooperative_groups;
namespace pg8 {
#define PG8_LAS __attribute__((address_space(3)))
typedef unsigned short bf16_t;
typedef short bf16x8 __attribute__((ext_vector_type(8)));
typedef float f32x4 __attribute__((ext_vector_type(4)));
typedef unsigned u32x4 __attribute__((ext_vector_type(4)));
constexpr int BM = 256, BK = 64, HALF = 128, HTB = HALF * BK * 2  , STAGE_BYTES = 8 * HTB, NXCD = 8, WGM = 8;

__host__ __device__ __forceinline__ int lds_byte(int r, int c) { const int st = (r >> 4) * 2 + (c >> 5), rr = r & 15, cc = c & 31, ob = rr * 64 + cc * 2; return st * 1024 + (ob ^ (((ob >> 9) & 1) << 5)); }
__host__ __device__ __forceinline__ void stage_rc(int b, int& R, int& C) { const int st = b / 1024, sb = b % 1024, swz = sb ^ (((sb >> 9) & 1) << 5); R = (st >> 1) * 16 + swz / 64; C = (st & 1) * 32 + (swz % 64) / 2; }
__host__ __device__ __forceinline__ int perm32(int rho) { const int n = rho >> 4, i = rho & 15; return 8 * (i >> 2) + 4 * n + (i & 3); }

struct Unit { int pm, pn, idx; };
struct Gemm { const bf16_t* A; const bf16_t* Bt; int M, N, K; };

struct StaticOrder {
    int nM, nN, nwg, G, c;
    __host__ __device__ void init(int M, int N, int G_, int c_) { nM = M / BM; nN = N / BM; nwg = nM * nN; G = G_; c = c_; }
    __host__ __device__ bool next(int i, Unit& u) const {
        const int L = i * G + c; if (L >= nwg) return false;
        int wgid = (int)L; { const int q = nwg / NXCD, r = nwg % NXCD, xcd = wgid % NXCD, off = wgid / NXCD; wgid = (xcd < r ? xcd * (q + 1) : r * (q + 1) + (xcd - r) * q) + off; }
        const int nig = WGM * nN, gid = wgid / nig, fm = gid * WGM, gsz = (nM - fm) < WGM ? (nM - fm) : WGM;
        u.pm = fm + ((wgid % nig) % gsz); u.pn = (wgid % nig) / gsz; u.idx = i; return true;
    }
    __device__ __forceinline__ void a_ready(const Unit&) const {}
    __device__ __forceinline__ void done(const Unit&) const {}
};

__device__ __forceinline__ unsigned cvt_pk_bf16(float lo, float hi) { unsigned r; asm volatile("v_cvt_pk_bf16_f32 %0, %1, %2" : "=v"(r) : "v"(lo), "v"(hi)); return r; }
typedef float f32x2 __attribute__((ext_vector_type(2)));
__device__ __forceinline__ f32x2 gelu_pk(f32x2 v) {
    const f32x2 av = __builtin_elementwise_abs(v), d = av * 0.2316418882f + 1.0f;
    f32x2 t; t.x = __builtin_amdgcn_rcpf(d.x); t.y = __builtin_amdgcn_rcpf(d.y);
    f32x2 q = t * 0.5307027145f + (-0.7265760135f); q = q * t + 0.7107068705f; q = q * t + (-0.142248368f); q = q * t + 0.127414796f; q = q * t;
    const f32x2 s = (v * v) * (-0.72134752044f);
    f32x2 e; e.x = __builtin_amdgcn_exp2f(s.x); e.y = __builtin_amdgcn_exp2f(s.y);
    const f32x2 m = v * (q * e), r = v - m;
    f32x2 o; o.x = v.x < 0.f ? m.x : r.x; o.y = v.y < 0.f ? m.y : r.y; return o;
}

template <int ACT  > struct EpiBf16 {
    static constexpr bool PERM = true, AFTER_DRAIN = false; static_assert(ACT == 0 || ACT == 1, "EpiBf16: ACT is 0 (none) or 1 (gelu_pk)");
    bf16_t* O; int ldc; const float* bias; int split_cols; size_t split_stride; float scale0;
    __device__ __forceinline__ void operator()(const f32x4 (&acc)[2][2][4][2], const Unit& u, int wr, int wc, int fr, int fq) const {
        const int row0 = u.pm * BM + wr * 64 + fr; int colt = u.pn * BM; bf16_t* base = O;
        float sc = 1.f; if (split_cols) { const int t = colt / split_cols; base += (size_t)t * split_stride; colt -= t * split_cols; if (t == 0) sc = scale0; }
        const int col0 = colt + wc * 32 + 8 * fq, bcol0 = u.pn * BM + wc * 32 + 8 * fq;
        f32x4 bv[2][2];
#pragma unroll
        for (int bj = 0; bj < 2; ++bj)
#pragma unroll
            for (int n = 0; n < 2; ++n) bv[bj][n] = bias ? *(const f32x4*)(bias + bcol0 + bj * HALF + 4 * n) : (f32x4){0.f, 0.f, 0.f, 0.f};
#pragma unroll
        for (int ai = 0; ai < 2; ++ai)
#pragma unroll
            for (int m = 0; m < 4; ++m) { bf16_t* rowp = base + (size_t)(row0 + ai * HALF + m * 16) * ldc + col0;
#pragma unroll
                for (int bj = 0; bj < 2; ++bj) { f32x4 v0 = acc[ai][bj][m][0] + bv[bj][0], v1 = acc[ai][bj][m][1] + bv[bj][1];
                    if (ACT == 1) { f32x2 a = gelu_pk((f32x2){v0[0], v0[1]}), b = gelu_pk((f32x2){v0[2], v0[3]}), c = gelu_pk((f32x2){v1[0], v1[1]}), d = gelu_pk((f32x2){v1[2], v1[3]});
                        v0 = (f32x4){a.x, a.y, b.x, b.y}; v1 = (f32x4){c.x, c.y, d.x, d.y}; }
                    v0 = v0 * sc; v1 = v1 * sc; u32x4 w; w.x = cvt_pk_bf16(v0[0], v0[1]); w.y = cvt_pk_bf16(v0[2], v0[3]); w.z = cvt_pk_bf16(v1[0], v1[1]); w.w = cvt_pk_bf16(v1[2], v1[3]);
                    *(u32x4*)(rowp + bj * HALF) = w; } }
    }
};
template <class Epi, class Sched, bool ALIGN_EPI = false, bool SP2 = false>
__device__ __forceinline__ void gemm_phase(PG8_LAS unsigned char* lds, const Gemm g, const Sched& S, const Epi& E) {
    int tid_ = threadIdx.x; asm volatile("" : "+v"(tid_));
    const int tid = tid_, wid = __builtin_amdgcn_readfirstlane(tid >> 6), lane = tid & 63, wr = wid >> 2, wc = wid & 3, fr = lane & 15, fq = lane >> 4;
    const int K = g.K, nt = K / BK;
    unsigned voffA[2], voffB[2];
#pragma unroll
    for (int i = 0; i < 2; ++i) { int R, C; stage_rc(tid * 16 + i * 8192, R, C); const int Rb = Epi::PERM ? ((R & ~31) + perm32(R & 31)) : R;
        voffA[i] = (unsigned)(R * K + C) * 2u; voffB[i] = (unsigned)(Rb * K + C) * 2u; }
    const size_t kstep = (size_t)(BK * 2);
    const size_t hstep = (size_t)HALF * K * 2;
    const size_t tstep = 2 * hstep;
    const unsigned ldsw = (unsigned)wid * 1024u;
    const int aoff = lds_byte(wr * 64 + fr, fq * 8), boff = lds_byte(wc * 32 + fr, fq * 8);
#define PG8_SA(b, h) (((b) * 2 + (h)) * HTB)
#define PG8_SB(b, h) ((4 + (b) * 2 + (h)) * HTB)
#define PG8_STAGE(bufoff, gbase, voff) do { _Pragma("unroll") for (int _i = 0; _i < 2; ++_i) \
        __builtin_amdgcn_global_load_lds((const unsigned*)((const char*)(gbase) + (voff)[_i]), (PG8_LAS unsigned*)(lds + (bufoff) + ldsw + _i * 8192), 16, 0, 0); } while (0)
#define PG8_LDA(dst, b, h) do { _Pragma("unroll") for (int m = 0; m < 4; ++m) _Pragma("unroll") for (int k = 0; k < 2; ++k) dst[m][k] = *(const PG8_LAS bf16x8*)(lds + PG8_SA(b, h) + aoff + m * 2048 + k * 1024); } while (0)
#define PG8_LDB(dst, b, h) do { _Pragma("unroll") for (int n = 0; n < 2; ++n) _Pragma("unroll") for (int k = 0; k < 2; ++k) dst[n][k] = *(const PG8_LAS bf16x8*)(lds + PG8_SB(b, h) + boff + n * 2048 + k * 1024); } while (0)
#define PG8_MMA(ai, bj, At, Bt) do { __builtin_amdgcn_s_setprio(1); _Pragma("unroll") for (int m = 0; m < 4; ++m) _Pragma("unroll") for (int n = 0; n < 2; ++n) _Pragma("unroll") for (int k = 0; k < 2; ++k) \
        acc[ai][bj][m][n] = __builtin_amdgcn_mfma_f32_16x16x32_bf16(Bt[n][k], At[m][k], acc[ai][bj][m][n], 0, 0, 0); __builtin_amdgcn_s_setprio(0); } while (0)
#define PG8_WAIT_V(n) asm volatile("s_waitcnt vmcnt(" #n ")" ::: "memory")
#define PG8_WAIT_L(n) asm volatile("s_waitcnt lgkmcnt(" #n ")" ::: "memory")
#define PG8_BAR __builtin_amdgcn_s_barrier()
#define PG8_SCHED __builtin_amdgcn_sched_barrier(0)
    Unit cur, nxt; int ui = 0;
    if (!S.next(0, cur)) return;
    f32x4 acc[2][2][4][2];
#pragma unroll
    for (int a = 0; a < 2; ++a)
#pragma unroll
        for (int b = 0; b < 2; ++b)
#pragma unroll
            for (int m = 0; m < 4; ++m)
#pragma unroll
                for (int n = 0; n < 2; ++n) acc[a][b][m][n] = (f32x4){0.f, 0.f, 0.f, 0.f};
    bf16x8 At[4][2], B0[2][2], B1[2][2];
    const char* cA = (const char*)g.A + (size_t)cur.pm * tstep; const char* cB = (const char*)g.Bt + (size_t)cur.pn * tstep;
    S.a_ready(cur);
    if constexpr (SP2) {
        PG8_STAGE(PG8_SB(0, 0), cB, voffB); PG8_STAGE(PG8_SB(0, 1), cB + hstep, voffB); PG8_STAGE(PG8_SA(0, 0), cA, voffA); PG8_STAGE(PG8_SA(0, 1), cA + hstep, voffA);
        if (wr == 1) PG8_BAR;
        PG8_WAIT_V(2); PG8_BAR;
        PG8_STAGE(PG8_SB(1, 0), cB + kstep, voffB); PG8_STAGE(PG8_SA(1, 0), cA + kstep, voffA); PG8_STAGE(PG8_SB(1, 1), cB + hstep + kstep, voffB);
        PG8_WAIT_V(6); PG8_BAR;
    } else {
        PG8_STAGE(PG8_SB(0, 0), cB, voffB); PG8_STAGE(PG8_SA(0, 0), cA, voffA); PG8_STAGE(PG8_SB(0, 1), cB + hstep, voffB); PG8_STAGE(PG8_SA(0, 1), cA + hstep, voffA);
        if (wr == 1) PG8_BAR;
        PG8_WAIT_V(4); PG8_BAR;
        PG8_STAGE(PG8_SB(1, 0), cB + kstep, voffB); PG8_STAGE(PG8_SA(1, 0), cA + kstep, voffA); PG8_STAGE(PG8_SB(1, 1), cB + hstep + kstep, voffB);
        PG8_WAIT_V(6); PG8_BAR;
    }
    for (;;) {
        const bool has_next = S.next(ui + 1, nxt);
        const char* nA = has_next ? (const char*)g.A + (size_t)nxt.pm * tstep : cA; const char* nB = has_next ? (const char*)g.Bt + (size_t)nxt.pn * tstep : cB;
        for (int t = 0; t < nt; t += 2) {
            const bool last = (t == nt - 2);
            const char* a1 = cA + (size_t)(t + 1) * kstep;
            const char* a2 = last ? nA : cA + (size_t)(t + 2) * kstep; const char* b2 = last ? nB : cB + (size_t)(t + 2) * kstep;
            const char* a3 = a2 + kstep; const char* b3 = b2 + kstep;
            if (last && has_next) S.a_ready(nxt);
            if constexpr (SP2) {
            PG8_LDB(B0, 0, 0); PG8_LDB(B1, 0, 1); PG8_SCHED; PG8_LDA(At, 0, 0); PG8_STAGE(PG8_SA(1, 1), a1 + hstep, voffA);
            PG8_WAIT_V(8); PG8_WAIT_L(0); PG8_BAR; PG8_MMA(0, 0, At, B0); PG8_MMA(0, 1, At, B1); PG8_BAR; PG8_SCHED;
            PG8_LDA(At, 0, 1); PG8_STAGE(PG8_SB(0, 0), b2, voffB); PG8_STAGE(PG8_SB(0, 1), b2 + hstep, voffB); PG8_STAGE(PG8_SA(0, 0), a2, voffA);
            PG8_WAIT_V(8); PG8_WAIT_L(0); PG8_BAR; PG8_MMA(1, 0, At, B0); PG8_MMA(1, 1, At, B1); PG8_BAR; PG8_SCHED;
            PG8_LDB(B0, 1, 0); PG8_LDB(B1, 1, 1); PG8_SCHED; PG8_LDA(At, 1, 0); PG8_STAGE(PG8_SA(0, 1), a2 + hstep, voffA);
            PG8_WAIT_V(8); PG8_WAIT_L(0); PG8_BAR; PG8_MMA(0, 0, At, B0); PG8_MMA(0, 1, At, B1); PG8_BAR; PG8_SCHED;
            PG8_LDA(At, 1, 1); PG8_STAGE(PG8_SB(1, 0), b3, voffB); PG8_STAGE(PG8_SB(1, 1), b3 + hstep, voffB); PG8_STAGE(PG8_SA(1, 0), a3, voffA);
            PG8_WAIT_V(8); PG8_WAIT_L(0); PG8_BAR; PG8_MMA(1, 0, At, B0); PG8_MMA(1, 1, At, B1); PG8_BAR; PG8_SCHED;
            } else {
            PG8_LDB(B0, 0, 0); PG8_SCHED; PG8_LDA(At, 0, 0); PG8_STAGE(PG8_SA(1, 1), a1 + hstep, voffA);
            PG8_WAIT_L(8); PG8_BAR; PG8_WAIT_L(0); PG8_MMA(0, 0, At, B0); PG8_BAR; PG8_SCHED;
            PG8_LDB(B1, 0, 1); PG8_STAGE(PG8_SB(0, 0), b2, voffB);
            PG8_BAR; PG8_WAIT_L(0); PG8_MMA(0, 1, At, B1); PG8_BAR;
            PG8_LDA(At, 0, 1); PG8_STAGE(PG8_SA(0, 0), a2, voffA);
            PG8_BAR; PG8_WAIT_L(0); PG8_MMA(1, 0, At, B0); PG8_BAR; PG8_SCHED;
            PG8_STAGE(PG8_SB(0, 1), b2 + hstep, voffB);
            PG8_WAIT_V(6); PG8_BAR; PG8_MMA(1, 1, At, B1); PG8_BAR;
            PG8_LDB(B0, 1, 0); PG8_SCHED; PG8_LDA(At, 1, 0); PG8_STAGE(PG8_SA(0, 1), a2 + hstep, voffA);
            PG8_WAIT_L(8); PG8_BAR; PG8_WAIT_L(0); PG8_MMA(0, 0, At, B0); PG8_BAR; PG8_SCHED;
            PG8_LDB(B1, 1, 1); PG8_STAGE(PG8_SB(1, 0), b3, voffB);
            PG8_BAR; PG8_WAIT_L(0); PG8_MMA(0, 1, At, B1); PG8_BAR;
            PG8_LDA(At, 1, 1); PG8_STAGE(PG8_SA(1, 0), a3, voffA);
            PG8_BAR; PG8_WAIT_L(0); PG8_MMA(1, 0, At, B0); PG8_BAR; PG8_SCHED;
            PG8_STAGE(PG8_SB(1, 1), b3 + hstep, voffB);
            PG8_WAIT_V(6); PG8_BAR; PG8_MMA(1, 1, At, B1); PG8_BAR;
            }
        }
        if constexpr (ALIGN_EPI) { if (wr == 0) PG8_BAR; }
        if constexpr (!Epi::AFTER_DRAIN) { E(acc, cur, wr, wc, fr, fq); S.done(cur); }
        if (!has_next) break;
#pragma unroll
        for (int a = 0; a < 2; ++a)
#pragma unroll
            for (int b = 0; b < 2; ++b)
#pragma unroll
                for (int m = 0; m < 4; ++m)
#pragma unroll
                    for (int n = 0; n < 2; ++n) acc[a][b][m][n] = (f32x4){0.f, 0.f, 0.f, 0.f};
        cur = nxt; cA = nA; cB = nB; ++ui;
        if constexpr (ALIGN_EPI) { if (wr == 1) PG8_BAR; }
    }
    PG8_WAIT_V(0);
    if constexpr (!ALIGN_EPI) { if (wr == 0) PG8_BAR; }
    PG8_BAR;
    if constexpr (Epi::AFTER_DRAIN) { E.fused(acc, cur, wr, wc, fr, fq, lds, wid, lane); S.done(cur); }
#undef PG8_SA
#undef PG8_SB
#undef PG8_STAGE
#undef PG8_LDA
#undef PG8_LDB
#undef PG8_MMA
#undef PG8_WAIT_V
#undef PG8_WAIT_L
#undef PG8_BAR
#undef PG8_SCHED
}
}
#define LAS __attribute__((address_space(3)))
#define XB_TMO      128
#define XB_XCNT(j)  (256  + 64 * (j))
#define XB_XSUB(j)  (1280 + 64 * (j))
#define XB_XGEN(j)  (2304 + 64 * (j))
#define XB_TOP      3328
#define XB_TOPGEN   3392
#define XCD_BAR_WORDS 3456
#define XB_SPIN_CAP (1u << 18)

__device__ __forceinline__ unsigned xb_ld(unsigned* p)              { return __hip_atomic_load(p, __ATOMIC_RELAXED, __HIP_MEMORY_SCOPE_AGENT); }
__device__ __forceinline__ unsigned xb_add(unsigned* p, unsigned v) { return __hip_atomic_fetch_add(p, v, __ATOMIC_RELAXED, __HIP_MEMORY_SCOPE_AGENT); }
__device__ __forceinline__ unsigned xb_xcc_id() { return (unsigned)__builtin_amdgcn_s_getreg((3 << 11) | 20) & 0xFu; }
#define XB_SPIN(cond, bar) do { unsigned _sp = 0; while (cond) { __builtin_amdgcn_s_sleep(1); \
    if ((++_sp & 255u) == 0u) { if (xb_ld(&(bar)[XB_TMO])) break; if (_sp > XB_SPIN_CAP) { atomicAdd(&(bar)[XB_TMO], 1u); break; } } } } while (0)

struct XcdBarrier {
    unsigned* bar; unsigned x;
    volatile LAS unsigned* st;
};

__device__ __forceinline__ XcdBarrier xcd_barrier_post(unsigned* bar, volatile LAS unsigned* st) {
    XcdBarrier b; b.bar = bar; b.x = xb_xcc_id(); b.st = st;
    if (threadIdx.x == 0) (void)xb_add(&bar[XB_XCNT(b.x)], 1u);
    return b;
}
__device__ __forceinline__ void xcd_barrier_complete(unsigned* bar, unsigned x, unsigned& nloc, unsigned& nx) {
    const unsigned G = gridDim.x * gridDim.y * gridDim.z;
    unsigned sum, cnt, mine, sp = 0u;
    for (;;) {
        sum = 0u; cnt = 0u; mine = 0u;
#pragma unroll
        for (unsigned j = 0; j < 16; ++j) { const unsigned c = xb_ld(&bar[XB_XCNT(j)]); sum += c; cnt += (c > 0u) ? 1u : 0u; mine = (j == x) ? c : mine; }
        if (sum == G) break;
        __builtin_amdgcn_s_sleep(1);
        if ((++sp & 255u) == 0u) { if (xb_ld(&bar[XB_TMO])) break; if (sp > XB_SPIN_CAP) { atomicAdd(&bar[XB_TMO], 1u); break; } }
    }
    nloc = mine > 0u ? mine : 1u; nx = cnt > 0u ? cnt : 1u;
}

__device__ __forceinline__ void xcd_barrier(const XcdBarrier& b) {
    asm volatile("s_waitcnt vmcnt(0)" ::: "memory");
    __syncthreads();
    if (threadIdx.x == 0) {
        unsigned* bar = b.bar; const unsigned bx_ = xb_xcc_id();
        __builtin_amdgcn_s_waitcnt(0);
        unsigned nloc = b.st[0], nx = b.st[1];
        if (nloc == 0u) { xcd_barrier_complete(bar, bx_, nloc, nx); b.st[0] = nloc; b.st[1] = nx; }
        const unsigned old = xb_add(&bar[XB_XSUB(bx_)], 1u);
        const unsigned gen = old / nloc;
        if (old + 1u == (gen + 1u) * nloc) {
            __builtin_amdgcn_fence(__ATOMIC_RELEASE, "agent");
            asm volatile("s_waitcnt vmcnt(0)" ::: "memory");
            const unsigned og = xb_add(&bar[XB_TOP], 1u);
            const unsigned tg = og / nx;
            if (og + 1u == (tg + 1u) * nx) xb_add(&bar[XB_TOPGEN], 1u);
            else XB_SPIN(xb_ld(&bar[XB_TOPGEN]) == tg, bar);
            __builtin_amdgcn_fence(__ATOMIC_ACQUIRE, "agent");
            xb_add(&bar[XB_XGEN(bx_)], 1u);
            asm volatile("s_waitcnt vmcnt(0)" ::: "memory");
        } else {
            XB_SPIN(xb_ld(&bar[XB_XGEN(bx_)]) == gen, bar);
            __builtin_amdgcn_fence(__ATOMIC_ACQUIRE, "agent");
            asm volatile("s_waitcnt vmcnt(0)" ::: "memory");
        }
    }
    __syncthreads();
}

#define GAS __attribute__((address_space(1)))
#define LAS __attribute__((address_space(3)))
typedef unsigned short bf16;
typedef float f32x4 __attribute__((ext_vector_type(4)));
typedef float f32x16 __attribute__((ext_vector_type(16)));
typedef short bf16x8 __attribute__((ext_vector_type(8)));
typedef short s16x4 __attribute__((ext_vector_type(4)));
typedef unsigned u32x4 __attribute__((ext_vector_type(4)));
typedef unsigned u32x2 __attribute__((ext_vector_type(2)));

#ifndef REP_MIX
#define REP_MIX 1
#endif
#ifndef REP_PRO
#define REP_PRO 1
#endif
#ifndef REP_SYNC
#define REP_SYNC 1
#endif
constexpr int NWAVES = 8;
constexpr int GRID_WG = 256;
constexpr int DM = 1024, NP = 32768, NS = 1024, MROWS = NP + NS, SEQ = 8192, DFF = 2816, DIN = 2560, NL = 2;
constexpr float EPS = 1e-6f;
constexpr float LOG2E = 1.4426950408889634f;
constexpr size_t MiB = 1u << 20;
constexpr size_t WS_W = 0;
constexpr size_t W_LAYER = 40 * MiB, W_GU1 = 0, W_D1 = 11 * MiB, W_IN = 16 * MiB + 512 * 1024, W_OUT = 21 * MiB + 512 * 1024, W_GU2 = 23 * MiB + 512 * 1024, W_D2 = 34 * MiB + 512 * 1024;
constexpr size_t WS_WTRIL = 80 * MiB;
constexpr size_t WS_BAR = 80 * MiB + 512 * 1024;
constexpr size_t WS_CNT = WS_BAR + 16384;
constexpr size_t WS_SSQ = 81 * MiB;
constexpr size_t WS_SK = 84 * MiB;
constexpr size_t WS_SVT = 102 * MiB;
constexpr size_t WS_XB = 120 * MiB;
constexpr size_t WS_MIX = 186 * MiB;
constexpr size_t WS_A = 252 * MiB;
constexpr size_t WS_GLU = WS_A, WS_U = WS_A + 17 * MiB, WS_VG = WS_A + 34 * MiB, WS_Q = WS_A + 51 * MiB, WS_PK = WS_A + 84 * MiB, WS_PVT = WS_A + 116 * MiB;
constexpr size_t WS_END = WS_A + 182 * MiB;
static_assert(WS_PVT + 32 * MiB <= WS_END, "overlay");
constexpr size_t O_YP = 0, O_YS = 33554432, O_PCS = O_YS + 1048576, O_PK = O_PCS + 61440, O_PV = O_PK + 2097152, O_SCS = O_PV + 2097152,
                 O_SK = O_SCS + 245760, O_SV = O_SK + 1048576, O_SG = O_SV + 1048576, O_END = O_SG + 524288;
constexpr int GLU_PB = SEQ + 30, GLU_SROW0 = 4 * GLU_PB;
constexpr int RING_BYTES = 131072, BIAS_OFF = RING_BYTES, RS_OFF = RING_BYTES + 8448, RS_UNITS = 12, XB_OFF = RS_OFF + RS_UNITS * 1024, VSCR_OFF = XB_OFF + 32, LDS_BYTES = 160256;

struct Params {
    const float* in[27];
    float* out; unsigned char* ws;
};
typedef const __attribute__((address_space(4))) Params* CPP;
__device__ __forceinline__ CPP kparams() { CPP q = (CPP)__builtin_amdgcn_kernarg_segment_ptr(); asm volatile("" : "+s"(q)); return q; }

__device__ __forceinline__ unsigned f2bf(float f) { unsigned u = __builtin_bit_cast(unsigned, f); return (u + 0x7fffu + ((u >> 16) & 1u)) >> 16; }
typedef __bf16 bf16x2_t __attribute__((ext_vector_type(2)));
typedef float f32x2_t __attribute__((ext_vector_type(2)));
__device__ __forceinline__ unsigned pk2(float lo, float hi) { const f32x2_t f = {lo, hi}; const bf16x2_t h = __builtin_convertvector(f, bf16x2_t); return __builtin_bit_cast(unsigned, h); }
__device__ __forceinline__ float bf2f(unsigned short b) { return __builtin_bit_cast(float, (unsigned)b << 16); }
__device__ __forceinline__ unsigned cvtpk(float lo, float hi) { return pk2(lo, hi); }
__device__ __forceinline__ float wave_sum(float v) {
#pragma unroll
    for (int o = 1; o < 64; o <<= 1) v += __shfl_xor(v, o);
    return v;
}
__device__ __forceinline__ float fast_exp2(float x) { return __builtin_amdgcn_exp2f(x); }
__device__ __forceinline__ float fast_rcp(float x) { return __builtin_amdgcn_rcpf(x); }
__device__ __forceinline__ float sigmoidf_(float x) { return fast_rcp(1.f + fast_exp2(-LOG2E * x)); }
__device__ __forceinline__ float siluf_(float x) { return x * sigmoidf_(x); }
__device__ __forceinline__ float gelu_tanh(float x) { const float t = 0.7978845608028654f * (x + 0.044715f * x * x * x); return x * sigmoidf_(2.f * t); }
__device__ __forceinline__ float row_rs(const float* ssq, int row) {
    const f32x4* p = (const f32x4*)(ssq + (size_t)row * 16);
    const f32x4 a = p[0], b = p[1], c = p[2], d = p[3];
    const f32x4 s = (a + b) + (c + d);
    return __builtin_amdgcn_rsqf(((s[0] + s[1]) + (s[2] + s[3])) * (1.f / 1024.f) + EPS);
}

struct RsOrder : pg8::StaticOrder {
    const float* ssq; LAS float* rsbuf;
    __device__ __forceinline__ void a_ready(const pg8::Unit&) const {}
};
template <class Sched>
__device__ __forceinline__ void rs_fill(const Sched& S, const float* ssq, LAS float* rsbuf, int tid) {
    int pms[RS_UNITS]; int nu = 0;
#pragma unroll
    for (int i = 0; i < RS_UNITS; ++i) { pg8::Unit u; const bool ok = S.next(i, u); pms[i] = ok ? u.pm : 0; nu += ok ? 1 : 0; }
    const int half = tid >> 8, rr = tid & 255;
#pragma unroll
    for (int b = 0; b < RS_UNITS / 2; b += 6) {
        f32x4 v[6][4];
#pragma unroll
        for (int k = 0; k < 6; ++k) { const int ui = 2 * (b + k) + half; const int pm = half ? pms[2 * (b + k) + 1] : pms[2 * (b + k)];
            const f32x4* p = (const f32x4*)(ssq + ((size_t)pm * 256 + rr) * 16);
            if (ui < nu) { v[k][0] = p[0]; v[k][1] = p[1]; v[k][2] = p[2]; v[k][3] = p[3]; } }
#pragma unroll
        for (int k = 0; k < 6; ++k) { const int ui = 2 * (b + k) + half;
            if (ui < nu) { const f32x4 s4 = (v[k][0] + v[k][1]) + (v[k][2] + v[k][3]); rsbuf[ui * 256 + rr] = __builtin_amdgcn_rsqf(((s4[0] + s4[1]) + (s4[2] + s4[3])) * (1.f / 1024.f) + EPS); } }
    }
    __syncthreads();
}
struct GuOrder : RsOrder {
    unsigned* cnt;
    const unsigned* wait_cnt;
    int samp_i;
    __device__ __forceinline__ bool next(int i, pg8::Unit& u) const {
        int L;
        if (c < 240) { L = i * 240 + c; if (L >= 2760) return false; }
        else { if (i >= 9) return false; L = 2760 + (c - 240) + 16 * i; }
        u.idx = i;
        const int s0 = 240 * samp_i;
        if (L >= s0 && L < s0 + 88) { const int q = L - s0; u.pm = 128 + q / 22; u.pn = q % 22; return true; }
        int wgid = (L < s0) ? L : L - 88; { const int xcd = wgid % 8, off = wgid / 8; wgid = xcd * 352 + off; }
        const int gid = wgid / 176, rem = wgid % 176;
        u.pm = gid * 8 + (rem % 8); u.pn = rem / 8; return true;
    }
    __device__ __forceinline__ void a_ready(const pg8::Unit& u) const {
        if (wait_cnt != nullptr && u.pm >= 128) {
            if (threadIdx.x < 64) { unsigned sp = 0; while ((unsigned)__builtin_amdgcn_readfirstlane(__hip_atomic_load(wait_cnt, __ATOMIC_RELAXED, __HIP_MEMORY_SCOPE_AGENT)) < 16u && ++sp < (1u << 22)) __builtin_amdgcn_s_sleep(2);
                __builtin_amdgcn_fence(__ATOMIC_ACQUIRE, "agent"); }
            asm volatile("s_waitcnt vmcnt(0)" ::: "memory");
            __builtin_amdgcn_s_barrier();
            if (threadIdx.x < 256) rsbuf[u.idx * 256 + threadIdx.x] = row_rs(ssq, u.pm * 256 + threadIdx.x);
        }
    }
    __device__ __forceinline__ void done(const pg8::Unit& u) const {
        if (u.pm >= 128) {
            asm volatile("s_waitcnt vmcnt(0)" ::: "memory");
            __builtin_amdgcn_s_barrier();
            if (threadIdx.x == 0) { __builtin_amdgcn_fence(__ATOMIC_RELEASE, "agent"); asm volatile("s_waitcnt vmcnt(0)" ::: "memory");
                __hip_atomic_fetch_add(cnt, 1u, __ATOMIC_RELAXED, __HIP_MEMORY_SCOPE_AGENT); }
        }
    }
};
struct RangeOrder : pg8::StaticOrder {
    int pm0; unsigned* pub;
    __device__ __forceinline__ bool next(int i, pg8::Unit& u) const { if (c < 0) return false; if (!pg8::StaticOrder::next(i, u)) return false; u.pm += pm0; return true; }
    __device__ __forceinline__ void done(const pg8::Unit&) const {
        if (pub != nullptr) {
            asm volatile("s_waitcnt vmcnt(0)" ::: "memory");
            __builtin_amdgcn_s_barrier();
            if (threadIdx.x == 0) { __builtin_amdgcn_fence(__ATOMIC_RELEASE, "agent"); asm volatile("s_waitcnt vmcnt(0)" ::: "memory");
                __hip_atomic_fetch_add(pub, 1u, __ATOMIC_RELAXED, __HIP_MEMORY_SCOPE_AGENT); }
        }
    }
};
struct EpiSwiGLU {
    static constexpr bool PERM = true, AFTER_DRAIN = false;
    bf16* O; const LAS float* rsbuf;
    __device__ __forceinline__ void operator()(const pg8::f32x4 (&acc)[2][2][4][2], const pg8::Unit& u, int wr, int wc, int fr, int fq) const {
        const int row0 = u.pm * 256 + wr * 64 + fr, col0 = u.pn * 128 + wc * 32 + 8 * fq;
#pragma unroll
        for (int ai = 0; ai < 2; ++ai)
#pragma unroll
            for (int m = 0; m < 4; ++m) {
                const int row = row0 + ai * 128 + m * 16;
                const float rs = rsbuf[u.idx * 256 + (row & 255)];
                float h[8];
#pragma unroll
                for (int n = 0; n < 2; ++n)
#pragma unroll
                    for (int e = 0; e < 4; ++e) { const float g = acc[ai][0][m][n][e] * rs, up = acc[ai][1][m][n][e] * rs; h[4 * n + e] = siluf_(g) * up; }
                u32x4 w; w.x = cvtpk(h[0], h[1]); w.y = cvtpk(h[2], h[3]); w.z = cvtpk(h[4], h[5]); w.w = cvtpk(h[6], h[7]);
                *(u32x4*)(O + (size_t)row * DFF + col0) = w;
            }
    }
};
struct EpiResid {
    static constexpr bool PERM = true, AFTER_DRAIN = false;
    const float* bp; const float* bs; float* X; const bf16* XBr; bf16* XB; float* ssq; float alpha;
    __device__ __forceinline__ void operator()(const pg8::f32x4 (&acc)[2][2][4][2], const pg8::Unit& u, int wr, int wc, int fr, int fq) const {
        const int row0 = u.pm * 256 + wr * 64 + fr, col0 = u.pn * 256 + wc * 32 + 8 * fq;
        const float* base = (u.pm * 256 < NP) ? bp : (bs - (size_t)NP * DM);
        if (bp == nullptr) {
            u32x4 q[2][4][2];
#pragma unroll
            for (int ai = 0; ai < 2; ++ai)
#pragma unroll
                for (int m = 0; m < 4; ++m)
#pragma unroll
                    for (int bj = 0; bj < 2; ++bj) q[ai][m][bj] = *(const u32x4*)(XBr + (size_t)(row0 + ai * 128 + m * 16) * DM + col0 + bj * 128);
#pragma unroll
            for (int ai = 0; ai < 2; ++ai)
#pragma unroll
                for (int m = 0; m < 4; ++m) {
                    const int row = row0 + ai * 128 + m * 16;
                    float ss = 0.f;
#pragma unroll
                    for (int bj = 0; bj < 2; ++bj) {
                        const size_t off = (size_t)row * DM + col0 + bj * 128;
                        const u32x4 qq = q[ai][m][bj];
                        const f32x4 b0 = (f32x4){__builtin_bit_cast(float, qq.x << 16), __builtin_bit_cast(float, qq.x & 0xffff0000u), __builtin_bit_cast(float, qq.y << 16), __builtin_bit_cast(float, qq.y & 0xffff0000u)};
                        const f32x4 b1 = (f32x4){__builtin_bit_cast(float, qq.z << 16), __builtin_bit_cast(float, qq.z & 0xffff0000u), __builtin_bit_cast(float, qq.w << 16), __builtin_bit_cast(float, qq.w & 0xffff0000u)};
                        const f32x4 v0 = b0 + acc[ai][bj][m][0] * alpha, v1 = b1 + acc[ai][bj][m][1] * alpha;
                        if (X != nullptr) { *(f32x4*)(X + off) = v0; *(f32x4*)(X + off + 4) = v1; }
                        if (XB != nullptr) {
                            u32x4 w; w.x = cvtpk(v0[0], v0[1]); w.y = cvtpk(v0[2], v0[3]); w.z = cvtpk(v1[0], v1[1]); w.w = cvtpk(v1[2], v1[3]);
                            *(u32x4*)(XB + off) = w;
                            ss += (v0[0] * v0[0] + v0[1] * v0[1]) + (v0[2] * v0[2] + v0[3] * v0[3]) + (v1[0] * v1[0] + v1[1] * v1[1]) + (v1[2] * v1[2] + v1[3] * v1[3]); }
                    }
                    if (XB != nullptr) { ss += __shfl_xor(ss, 16); ss += __shfl_xor(ss, 32);
                        if (fq == 0) ssq[(size_t)row * 16 + 4 * u.pn + wc] = ss; }
                }
            return;
        }
#pragma unroll
        for (int ai = 0; ai < 2; ++ai) {
            f32x4 fb[4][2][2];
#pragma unroll
            for (int m = 0; m < 4; ++m)
#pragma unroll
                for (int bj = 0; bj < 2; ++bj) { const float* p = base + (size_t)(row0 + ai * 128 + m * 16) * DM + col0 + bj * 128; fb[m][bj][0] = *(const f32x4*)p; fb[m][bj][1] = *(const f32x4*)(p + 4); }
#pragma unroll
            for (int m = 0; m < 4; ++m) {
                const int row = row0 + ai * 128 + m * 16;
                float ss = 0.f;
#pragma unroll
                for (int bj = 0; bj < 2; ++bj) {
                    const size_t off = (size_t)row * DM + col0 + bj * 128;
                    const f32x4 v0 = fb[m][bj][0] + acc[ai][bj][m][0] * alpha, v1 = fb[m][bj][1] + acc[ai][bj][m][1] * alpha;
                    u32x4 w; w.x = cvtpk(v0[0], v0[1]); w.y = cvtpk(v0[2], v0[3]); w.z = cvtpk(v1[0], v1[1]); w.w = cvtpk(v1[2], v1[3]);
                    *(u32x4*)(XB + off) = w;
                    ss += (v0[0] * v0[0] + v0[1] * v0[1]) + (v0[2] * v0[2] + v0[3] * v0[3]) + (v1[0] * v1[0] + v1[1] * v1[1]) + (v1[2] * v1[2] + v1[3] * v1[3]);
                }
                ss += __shfl_xor(ss, 16); ss += __shfl_xor(ss, 32);
                if (fq == 0) ssq[(size_t)row * 16 + 4 * u.pn + wc] = ss;
            }
        }
    }
};
struct EpiMix {
    static constexpr bool PERM = true, AFTER_DRAIN = false;
    const LAS float* rsbuf; const float* qg; const float* kg; unsigned char* ws; float* out; int l; LAS unsigned char* vscr;
    __device__ __forceinline__ void operator()(const pg8::f32x4 (&acc)[2][2][4][2], const pg8::Unit& u, int wr, int wc, int fr, int fq) const {
        bf16* const GLU = (bf16*)(ws + WS_GLU); bf16* const U = (bf16*)(ws + WS_U); bf16* const VG = (bf16*)(ws + WS_VG); bf16* const Q = (bf16*)(ws + WS_Q);
        bf16* const PK = (bf16*)(ws + WS_PK); bf16* const PVT = (bf16*)(ws + WS_PVT);
        bf16* const SK = (bf16*)(ws + WS_SK) + (size_t)l * 16 * 576 * 512; bf16* const SVT = (bf16*)(ws + WS_SVT) + (size_t)l * 16 * 512 * 576;
        float* const o_pcs = out + O_PCS + (size_t)l * 4 * 30 * 256; float* const o_pk = out + O_PK + (size_t)l * 4 * 512 * 512; float* const o_pv = out + O_PV + (size_t)l * 4 * 512 * 512;
        float* const o_scs = out + O_SCS + (size_t)l * 16 * 30 * 256; float* const o_sk = out + O_SK + (size_t)l * 16 * 64 * 512; float* const o_sv = out + O_SV + (size_t)l * 16 * 64 * 512;
        const int row0 = u.pm * 256 + wr * 64 + fr, pn = u.pn;
        const bool samp = (u.pm * 256 >= NP);
        if (pn < 2) {
            const int ch0 = pn * 128 + wc * 32 + 8 * fq;
#pragma unroll
            for (int ai = 0; ai < 2; ++ai)
#pragma unroll
                for (int m = 0; m < 4; ++m) {
                    const int row = row0 + ai * 128 + m * 16; const float rs = rsbuf[u.idx * 256 + (row & 255)];
                    float h[8];
#pragma unroll
                    for (int n = 0; n < 2; ++n)
#pragma unroll
                        for (int e = 0; e < 4; ++e) h[4 * n + e] = (acc[ai][0][m][n][e] * rs) * sigmoidf_(acc[ai][1][m][n][e] * rs);
                    u32x4 w; w.x = cvtpk(h[0], h[1]); w.y = cvtpk(h[2], h[3]); w.z = cvtpk(h[4], h[5]); w.w = cvtpk(h[6], h[7]);
                    { const int grow = samp ? (GLU_SROW0 + ((row - NP) >> 6) * 94 + 30 + ((row - NP) & 63)) : ((row >> 13) * GLU_PB + 30 + (row & 8191));
                      *(u32x4*)(GLU + (size_t)grow * 256 + ch0) = w; }
                    float* dst = nullptr;
                    if (!samp) { const int b = row >> 13, t = row & 8191; if (t >= SEQ - 30) dst = o_pcs + ((size_t)(b * 30 + (t - (SEQ - 30)))) * 256 + ch0; }
                    else { const int rr = row - NP, b = rr >> 6, t = rr & 63; if (t >= 34) dst = o_scs + ((size_t)(b * 30 + (t - 34))) * 256 + ch0; }
                    if (dst) { *(f32x4*)dst = (f32x4){h[0], h[1], h[2], h[3]}; *(f32x4*)(dst + 4) = (f32x4){h[4], h[5], h[6], h[7]}; }
                }
        } else if (pn < 4) {
            bf16* O = (pn == 2) ? U : VG;
#pragma unroll
            for (int ai = 0; ai < 2; ++ai)
#pragma unroll
                for (int m = 0; m < 4; ++m) {
                    const int row = row0 + ai * 128 + m * 16; const float rs = rsbuf[u.idx * 256 + (row & 255)];
#pragma unroll
                    for (int bj = 0; bj < 2; ++bj) {
                        float h[8];
#pragma unroll
                        for (int n = 0; n < 2; ++n)
#pragma unroll
                            for (int e = 0; e < 4; ++e) h[4 * n + e] = gelu_tanh(acc[ai][bj][m][n][e] * rs);
                        u32x4 w; w.x = cvtpk(h[0], h[1]); w.y = cvtpk(h[2], h[3]); w.z = cvtpk(h[4], h[5]); w.w = cvtpk(h[6], h[7]);
                        *(u32x4*)(O + (size_t)row * 256 + bj * 128 + wc * 32 + 8 * fq) = w;
                    }
                }
        } else if (pn < 8) {
            const bool isq = pn < 6;
            const int head = 4 * ((pn - 4) & 1) + wc;
            const float* gp = isq ? qg : kg;
            const float sc = isq ? 0.125f * LOG2E : 1.f;
            float gn[2][8];
#pragma unroll
            for (int bj = 0; bj < 2; ++bj) { const f32x4 ga = *(const f32x4*)(gp + 32 * bj + 8 * fq) * sc, gb = *(const f32x4*)(gp + 32 * bj + 8 * fq + 4) * sc;
#pragma unroll
                for (int j = 0; j < 4; ++j) { gn[bj][j] = ga[j]; gn[bj][4 + j] = gb[j]; } }
#pragma unroll
            for (int ai = 0; ai < 2; ++ai)
#pragma unroll
                for (int m = 0; m < 4; ++m) {
                    const int row = row0 + ai * 128 + m * 16; const float rs = rsbuf[u.idx * 256 + (row & 255)];
                    float z[2][8]; float ss = 0.f;
#pragma unroll
                    for (int bj = 0; bj < 2; ++bj)
#pragma unroll
                        for (int n = 0; n < 2; ++n)
#pragma unroll
                            for (int e = 0; e < 4; ++e) { const float v = acc[ai][bj][m][n][e] * rs; z[bj][4 * n + e] = v; ss += v * v; }
                    ss += __shfl_xor(ss, 16); ss += __shfl_xor(ss, 32);
                    const float inv = __builtin_amdgcn_rsqf(ss * (1.f / 64.f) + EPS);
#pragma unroll
                    for (int bj = 0; bj < 2; ++bj)
#pragma unroll
                        for (int j = 0; j < 8; ++j) z[bj][j] = z[bj][j] * inv * gn[bj][j];
                    bf16* dstb; float* dstf = nullptr;
                    if (isq) dstb = Q + (size_t)row * 512 + head * 64;
                    else if (!samp) { dstb = PK + ((size_t)(head * 1024 + (row >> 5)) * 256 + (row & 31)) * 8; const int b = row >> 13, t = row & 8191; if (t >= SEQ - 512) dstf = o_pk + ((size_t)(b * 512 + (t - (SEQ - 512))) * 8 + head) * 64; }
                    else { const int rr = row - NP, b = rr >> 6, t = rr & 63; dstb = SK + (size_t)b * 294912 + ((size_t)(head * 18 + 16 + (t >> 5)) * 256 + (t & 31)) * 8; dstf = o_sk + ((size_t)(b * 64 + t) * 8 + head) * 64; }
#pragma unroll
                    for (int bj = 0; bj < 2; ++bj) {
                        u32x4 w; w.x = cvtpk(z[bj][0], z[bj][1]); w.y = cvtpk(z[bj][2], z[bj][3]); w.z = cvtpk(z[bj][4], z[bj][5]); w.w = cvtpk(z[bj][6], z[bj][7]);
                        *(u32x4*)(dstb + (isq ? 32 * bj + 8 * fq : ((2 * bj + (fq >> 1)) * 2 + (fq & 1)) * 256)) = w;
                        if (dstf) { *(f32x4*)(dstf + 32 * bj + 8 * fq) = (f32x4){z[bj][0], z[bj][1], z[bj][2], z[bj][3]}; *(f32x4*)(dstf + 32 * bj + 8 * fq + 4) = (f32x4){z[bj][4], z[bj][5], z[bj][6], z[bj][7]}; }
                    }
                }
        } else {
#pragma unroll
            for (int ai = 0; ai < 2; ++ai)
#pragma unroll
                for (int m = 0; m < 4; ++m) {
                    const int row = row0 + ai * 128 + m * 16; const float rs = rsbuf[u.idx * 256 + (row & 255)];
                    bf16* dstb; float* dstf = nullptr;
                    const int rowg = row - fr;
                    if (!samp) { dstb = PVT + (size_t)(rowg >> 5) * 2048 + ((rowg >> 4) & 1) * 512; const int b = row >> 13, t = row & 8191; if (t >= SEQ - 512) dstf = o_pv + (size_t)(b * 512 + (t - (SEQ - 512))) * 512; }
                    else { const int rr = rowg - NP, b = rr >> 6, t0 = rr & 63, t = (row - NP) & 63; dstb = SVT + (size_t)b * 294912 + (size_t)(16 + (t0 >> 5)) * 2048 + ((t0 >> 4) & 1) * 512; dstf = o_sv + (size_t)(b * 64 + t) * 512; }
                    const size_t hstride = samp ? (size_t)18 * 2048 : (size_t)1024 * 2048;
                    LAS unsigned short* sc = (LAS unsigned short*)(vscr + (wr * 4 + wc) * 1024);
                    const int ln = fq * 16 + fr;
#pragma unroll
                    for (int bj = 0; bj < 2; ++bj) {
                        const int c0 = (pn - 8) * 256 + bj * 128 + wc * 32 + 8 * fq;
                        float z[8];
#pragma unroll
                        for (int n = 0; n < 2; ++n)
#pragma unroll
                            for (int e = 0; e < 4; ++e) z[4 * n + e] = acc[ai][bj][m][n][e] * rs;
#pragma unroll
                        for (int j = 0; j < 8; j += 2) { const unsigned p = pk2(z[j], z[j + 1]); sc[(8 * fq + j) * 16 + fr] = (unsigned short)(p & 0xffffu); sc[(8 * fq + j + 1) * 16 + fr] = (unsigned short)(p >> 16); }
                        asm volatile("s_waitcnt lgkmcnt(0)" ::: "memory");
                        { const int ch = ln & 31, hx = ln >> 5;
                          const u32x2 lo = *(const LAS u32x2*)(sc + ch * 16 + 4 * hx), hh = *(const LAS u32x2*)(sc + ch * 16 + 8 + 4 * hx);
                          const int cw0 = (pn - 8) * 256 + bj * 128 + wc * 32;
                          u32x4 w; w.x = lo.x; w.y = lo.y; w.z = hh.x; w.w = hh.y;
                          *(u32x4*)(dstb + (size_t)(cw0 >> 6) * hstride + ((cw0 >> 5) & 1) * 1024 + hx * 256 + ch * 8) = w; }
                        asm volatile("s_waitcnt lgkmcnt(0)" ::: "memory");
                        if (dstf) { *(f32x4*)(dstf + c0) = (f32x4){z[0], z[1], z[2], z[3]}; *(f32x4*)(dstf + c0 + 4) = (f32x4){z[4], z[5], z[6], z[7]}; }
                    }
                }
        }
    }
};

struct TItem { const float* W; const float* gain; bf16* WT; int N, pitch, drow, k0, n0; };
__device__ __forceinline__ int win_dst_row(int n0) {
    if (n0 < 256) return 256 * (n0 >> 7) + (n0 & 127);
    if (n0 < 512) { const int ch = n0 - 256; return 256 * (ch >> 7) + 128 + (ch & 127); }
    if (n0 < 1024) return n0;
    if (n0 < 2048) { const int k = (n0 >= 1536); const int c = n0 - 1024 - 512 * k, head = c >> 6, d = c & 63; return 256 * (4 + 2 * k + (head >> 2)) + 128 * (d >> 5) + 32 * (head & 3) + (d & 31); }
    return n0;
}
constexpr int PER_LAYER = 10240, NW_ITEMS = NL * PER_LAYER, NV_ITEMS = 0, NT_ITEMS = NW_ITEMS + NV_ITEMS;
__device__ __forceinline__ TItem decode_item(CPP P, int it) {
    TItem d; unsigned char* ws = P->ws;
    if (it < NW_ITEMS) {
        const int l = it / PER_LAYER, r = it % PER_LAYER;
        unsigned char* wl = ws + WS_W + (size_t)l * W_LAYER;
        if (r < 8448) {
            const int mi = r / 1408, rr = r % 1408, ffn = mi / 3, kind = mi % 3;
            if (kind < 2) {
                const int nb = rr % 88, kb = rr / 88; d.n0 = 32 * nb; d.k0 = 64 * kb;
                d.W = P->in[(ffn ? 24 : 6) + kind] + (size_t)l * DM * DFF; d.gain = P->in[ffn ? 23 : 5] + l * DM; d.N = DFF;
                d.WT = (bf16*)(wl + (ffn ? W_GU2 : W_GU1)); d.pitch = DM; d.drow = 256 * (d.n0 >> 7) + 128 * kind + (d.n0 & 127);
            } else {
                const int nb = rr % 32, kb = rr / 32; d.n0 = 32 * nb; d.k0 = 64 * kb;
                d.W = P->in[ffn ? 26 : 8] + (size_t)l * DFF * DM; d.gain = nullptr; d.N = DM;
                d.WT = (bf16*)(wl + (ffn ? W_D2 : W_D1)); d.pitch = DFF; d.drow = d.n0;
            }
        } else if (r < 8448 + 1280) {
            const int rr = r - 8448, nb = rr % 80, kb = rr / 80; d.n0 = 32 * nb; d.k0 = 64 * kb;
            d.W = P->in[10] + (size_t)l * DM * DIN; d.gain = P->in[9] + l * DM; d.N = DIN; d.WT = (bf16*)(wl + W_IN); d.pitch = DM; d.drow = win_dst_row(d.n0);
        } else {
            const int rr = r - 8448 - 1280, nb = rr % 32, kb = rr / 32; d.n0 = 32 * nb; d.k0 = 64 * kb;
            d.W = P->in[22] + (size_t)l * DM * DM; d.gain = nullptr; d.N = DM; d.WT = (bf16*)(wl + W_OUT); d.pitch = DM; d.drow = d.n0;
        }
    } else {
        const int r = it - NW_ITEMS, lb = r >> 7, rr = r & 127, nb = rr & 15, kb = rr >> 4;
        d.n0 = 32 * nb; d.k0 = 64 * kb; d.W = P->in[4] + (size_t)lb * 512 * 512; d.gain = nullptr; d.N = 512;
        d.WT = (bf16*)(ws + WS_SVT) + (size_t)lb * 512 * 576; d.pitch = 576; d.drow = d.n0;
    }
    return d;
}
__device__ __forceinline__ void item_load(const TItem& d, int lane, float (&v)[32]) {
    const float* p = d.W + (size_t)(d.k0 + (lane >> 5)) * d.N + d.n0 + (lane & 31);
#pragma unroll
    for (int i = 0; i < 32; ++i) v[i] = p[(size_t)(2 * i) * d.N];
}
__device__ __forceinline__ void item_store(const TItem& d, int lane, const float (&v)[32], LAS float* scr) {
#pragma unroll
    for (int i = 0; i < 32; ++i) scr[(2 * i + (lane >> 5)) * 33 + (lane & 31)] = v[i];
    asm volatile("s_waitcnt lgkmcnt(0)" ::: "memory");
    const int c = lane & 7;
    f32x4 g0 = (f32x4){1.f, 1.f, 1.f, 1.f}, g1 = g0;
    if (d.gain) { g0 = *(const f32x4*)(d.gain + d.k0 + 8 * c); g1 = *(const f32x4*)(d.gain + d.k0 + 8 * c + 4); }
#pragma unroll
    for (int j = 0; j < 4; ++j) { const int n = (lane >> 3) + 8 * j; const LAS float* s = scr + (8 * c) * 33 + n;
        u32x4 o; o.x = pk2(s[0 * 33] * g0[0], s[1 * 33] * g0[1]); o.y = pk2(s[2 * 33] * g0[2], s[3 * 33] * g0[3]); o.z = pk2(s[4 * 33] * g1[0], s[5 * 33] * g1[1]); o.w = pk2(s[6 * 33] * g1[2], s[7 * 33] * g1[3]);
        *(u32x4*)(d.WT + (size_t)(d.drow + n) * d.pitch + d.k0 + 8 * c) = o; }
    asm volatile("s_waitcnt lgkmcnt(0)" ::: "memory");
}
__device__ __forceinline__ void convert_caches(CPP P, int l, int gt, int NGT) {
    unsigned char* ws = P->ws;
    bf16* SK = (bf16*)(ws + WS_SK); bf16* SV = (bf16*)(ws + WS_SVT);
    for (int i0 = gt; i0 < 16 * 512 * 64; i0 += 4 * NGT) {
        f32x4 a[4], b[4];
#pragma unroll
        for (int q = 0; q < 4; ++q) { const int i = i0 + q * NGT; const int ii = i < 16 * 512 * 64 ? i : i0; const int c8 = ii & 63, s_ = (ii >> 6) & 511, lb = l * 16 + (ii >> 15);
            const f32x4* srck = (const f32x4*)(P->in[3] + ((size_t)(lb * 512 + s_)) * 512 + 8 * c8); a[q] = srck[0]; b[q] = srck[1]; }
#pragma unroll
        for (int q = 0; q < 4; ++q) { const int i = i0 + q * NGT;
            if (i < 16 * 512 * 64) { const int c8 = i & 63, s_ = (i >> 6) & 511, lb = l * 16 + (i >> 15), head = c8 >> 3, d0 = (c8 & 7) * 8;
                u32x4 w; w.x = pk2(a[q][0], a[q][1]); w.y = pk2(a[q][2], a[q][3]); w.z = pk2(b[q][0], b[q][1]); w.w = pk2(b[q][2], b[q][3]);
                *(u32x4*)(SK + (size_t)lb * 294912 + (size_t)(head * 18 + (s_ >> 5)) * 2048 + ((((d0 >> 4) * 2 + ((d0 >> 3) & 1)) * 32) + (s_ & 31)) * 8) = w; } }
    }
    for (int i0 = gt; i0 < 16 * 64 * 512; i0 += 2 * NGT) {
        float v[2][8];
#pragma unroll
        for (int q = 0; q < 2; ++q) { const int i = i0 + q * NGT; const int ii = i < 16 * 64 * 512 ? i : i0; const int ch = ii & 511, kg = (ii >> 9) & 63, lb = l * 16 + (ii >> 15), kb = kg >> 2, sx = (kg >> 1) & 1, hx = kg & 1;
            const float* src = P->in[4] + ((size_t)(lb * 512 + 32 * kb + 16 * sx + 4 * hx)) * 512 + ch;
#pragma unroll
            for (int j = 0; j < 8; ++j) v[q][j] = src[(size_t)(8 * (j >> 2) + (j & 3)) * 512]; }
#pragma unroll
        for (int q = 0; q < 2; ++q) { const int i = i0 + q * NGT;
            if (i < 16 * 64 * 512) { const int ch = i & 511, kg = (i >> 9) & 63, lb = l * 16 + (i >> 15), kb = kg >> 2, sx = (kg >> 1) & 1, hx = kg & 1, head = ch >> 6, d = ch & 63;
                u32x4 w; w.x = pk2(v[q][0], v[q][1]); w.y = pk2(v[q][2], v[q][3]); w.z = pk2(v[q][4], v[q][5]); w.w = pk2(v[q][6], v[q][7]);
                *(u32x4*)(SV + (size_t)lb * 294912 + (size_t)(head * 18 + kb) * 2048 + (((((d >> 5) * 2 + sx) * 2 + hx) * 32) + (d & 31)) * 8) = w; } }
    }
}
__device__ __forceinline__ void convert_items(CPP P, LAS unsigned char* lds, int it0, int it1, int worker, int nworkers, int wave, int lane) {
    LAS float* scr = (LAS float*)(lds + wave * 16384);
    const int gw = it0 + worker * NWAVES + wave, NGW = nworkers * NWAVES;
    if (gw < it1) {
        TItem cur = decode_item(P, gw); float v[32]; item_load(cur, lane, v);
#pragma unroll 1
        for (int it = gw; it < it1; it += NGW) {
            const int nx = it + NGW; const bool has = nx < it1;
            TItem nd = decode_item(P, has ? nx : it); float vn[32];
            if (has) item_load(nd, lane, vn);
            item_store(cur, lane, v, scr);
            if (has) {
#pragma unroll
                for (int i = 0; i < 32; ++i) v[i] = vn[i];
                cur = nd; }
        }
    }
}
__device__ __forceinline__ void prologue(CPP P, LAS unsigned char* lds, int vb, int G, int wave, int lane) {
    LAS float* scr = (LAS float*)(lds + wave * 16384);
    const int gw = vb * NWAVES + wave, NGW = G * NWAVES;
    unsigned char* ws = P->ws;
    convert_items(P, lds, 0, PER_LAYER, vb, G, wave, lane);
    bf16* XB = (bf16*)(ws + WS_XB); float* ssq = (float*)(ws + WS_SSQ);
    for (int m0 = gw; m0 < MROWS; m0 += 4 * NGW) {
        f32x4 a[4][4];
#pragma unroll
        for (int q = 0; q < 4; ++q) { const int m = m0 + q * NGW; const int mm = m < MROWS ? m : m0;
            const float* xr = (mm < NP) ? P->in[0] + (size_t)mm * DM : P->in[1] + (size_t)(mm - NP) * DM;
#pragma unroll
            for (int j = 0; j < 4; ++j) a[q][j] = ((const f32x4*)xr)[lane + 64 * j]; }
#pragma unroll
        for (int q = 0; q < 4; ++q) { const int m = m0 + q * NGW;
            if (m < MROWS) { float s0 = 0.f;
#pragma unroll
                for (int j = 0; j < 4; ++j) { s0 += (a[q][j][0] * a[q][j][0] + a[q][j][1] * a[q][j][1]) + (a[q][j][2] * a[q][j][2] + a[q][j][3] * a[q][j][3]);
                    u32x2 w; w.x = pk2(a[q][j][0], a[q][j][1]); w.y = pk2(a[q][j][2], a[q][j][3]); ((u32x2*)(XB + (size_t)m * DM))[lane + 64 * j] = w; }
                s0 += __shfl_xor(s0, 16); s0 += __shfl_xor(s0, 32);
                if (lane < 16) ssq[(size_t)m * 16 + lane] = s0; } }
    }
    const int gt = vb * (NWAVES * 64) + wave * 64 + lane, NGT = G * NWAVES * 64;
    bf16* WT = (bf16*)(ws + WS_WTRIL);
    for (int i = gt; i < NL * 4 * 128 * 128; i += NGT) { const int s = i & 127, t = (i >> 7) & 127; WT[i] = (bf16)(s <= t ? f2bf(P->in[17][i]) : 0u); }
    convert_caches(P, 0, gt, NGT);
}

#define MFMA32(a, b, c) __builtin_amdgcn_mfma_f32_32x32x16_bf16((a), (b), (c), 0, 0, 0)
template <int KH>
__device__ __forceinline__ void attn_block(const bf16x8 (&Kf)[4], const bf16x8 (&Vf)[2][2], const bf16x8 (&Qf)[2][4], f32x16 (&O)[2][2], float (&mrun)[2], float (&lsum)[2],
                                           int delta, int r, int hi, const LAS float* tblR) {
    f32x16 S[2];
    if (delta >= 3) {
#pragma unroll
        for (int qb = 0; qb < 2; ++qb)
#pragma unroll
            for (int i = 0; i < 16; ++i) S[qb][i] = 0.f; }
    else {
#pragma unroll
        for (int qb = 0; qb < 2; ++qb) { const LAS float* tp = tblR + (191 - (64 * delta + (32 * qb + r) - (32 * KH + 4 * hi)));
#pragma unroll
            for (int i = 0; i < 16; ++i) S[qb][i] = tp[(i & 3) + 8 * (i >> 2)]; } }
#pragma unroll
    for (int kk = 0; kk < 4; ++kk)
#pragma unroll
        for (int qb = 0; qb < 2; ++qb) S[qb] = MFMA32(Kf[kk], Qf[qb][kk], S[qb]);
    float mx[2], mnew[2], alpha[2];
#pragma unroll
    for (int qb = 0; qb < 2; ++qb) { float m = fmaxf(fmaxf(S[qb][0], S[qb][1]), fmaxf(S[qb][2], S[qb][3]));
#pragma unroll
        for (int i = 4; i < 16; i += 2) m = fmaxf(m, fmaxf(S[qb][i], S[qb][i + 1]));
        mx[qb] = m; }
#pragma unroll
    for (int qb = 0; qb < 2; ++qb) mx[qb] = fmaxf(mx[qb], __shfl_xor(mx[qb], 32));
#pragma unroll
    for (int qb = 0; qb < 2; ++qb) { mnew[qb] = fmaxf(mrun[qb], mx[qb]); alpha[qb] = fast_exp2(mrun[qb] - mnew[qb]); mrun[qb] = mnew[qb]; }
#pragma unroll
    for (int i = 0; i < 16; ++i)
#pragma unroll
        for (int qb = 0; qb < 2; ++qb) S[qb][i] = fast_exp2(S[qb][i] - mnew[qb]);
#pragma unroll
    for (int qb = 0; qb < 2; ++qb) {
        const float ps = (((S[qb][0] + S[qb][1]) + (S[qb][2] + S[qb][3])) + ((S[qb][4] + S[qb][5]) + (S[qb][6] + S[qb][7]))) + (((S[qb][8] + S[qb][9]) + (S[qb][10] + S[qb][11])) + ((S[qb][12] + S[qb][13]) + (S[qb][14] + S[qb][15])));
        lsum[qb] = lsum[qb] * alpha[qb] + ps; }
    if (__builtin_amdgcn_ballot_w64(alpha[0] != 1.f || alpha[1] != 1.f) != 0ull) {
#pragma unroll
        for (int qb = 0; qb < 2; ++qb)
#pragma unroll
            for (int db = 0; db < 2; ++db)
#pragma unroll
                for (int i = 0; i < 16; ++i) O[db][qb][i] *= alpha[qb]; }
    bf16x8 Pf[2][2];
#pragma unroll
    for (int qb = 0; qb < 2; ++qb)
#pragma unroll
        for (int s = 0; s < 2; ++s) { u32x4 w; w.x = pk2(S[qb][8 * s], S[qb][8 * s + 1]); w.y = pk2(S[qb][8 * s + 2], S[qb][8 * s + 3]); w.z = pk2(S[qb][8 * s + 4], S[qb][8 * s + 5]); w.w = pk2(S[qb][8 * s + 6], S[qb][8 * s + 7]); Pf[qb][s] = __builtin_bit_cast(bf16x8, w); }
#pragma unroll
    for (int s = 0; s < 2; ++s)
#pragma unroll
        for (int qb = 0; qb < 2; ++qb)
#pragma unroll
            for (int db = 0; db < 2; ++db) O[db][qb] = MFMA32(Vf[db][s], Pf[qb][s], O[db][qb]);
}
__device__ __forceinline__ void attn_unit(CPP P, int l, int u, int wave, int lane, const LAS float* tblR) {
    unsigned char* ws = P->ws;
    const int h = wave, r = lane & 31, hi = lane >> 5;
    const bf16* Kb0; const bf16* Vb0; int ntiles, row0;
    int cm = 0;
    if (u < 512) { const int b = u >> 7, c = u & 127; cm = c % 9; row0 = b * SEQ + 64 * c; ntiles = (c < 8 ? c : 8) + 1; const int kbg0 = (row0 - 64 * (ntiles - 1)) >> 5;
        Kb0 = (const bf16*)(ws + WS_PK) + (size_t)(h * 1024 + kbg0) * 2048; Vb0 = (const bf16*)(ws + WS_PVT) + (size_t)(h * 1024 + kbg0) * 2048; }
    else { const int b = u - 512; row0 = NP + 64 * b; ntiles = 9;
        Kb0 = (const bf16*)(ws + WS_SK) + (size_t)(l * 16 + b) * 294912 + (size_t)(h * 18) * 2048; Vb0 = (const bf16*)(ws + WS_SVT) + (size_t)(l * 16 + b) * 294912 + (size_t)(h * 18) * 2048; }
    const bf16* Qp = (const bf16*)(ws + WS_Q) + (size_t)row0 * 512 + h * 64;
    bf16x8 Qf[2][4];
#pragma unroll
    for (int qb = 0; qb < 2; ++qb)
#pragma unroll
        for (int kk = 0; kk < 4; ++kk) Qf[qb][kk] = *(const bf16x8*)(Qp + (size_t)(32 * qb + r) * 512 + 16 * kk + 8 * hi);
    f32x16 O[2][2];
#pragma unroll
    for (int a = 0; a < 2; ++a)
#pragma unroll
        for (int b = 0; b < 2; ++b)
#pragma unroll
            for (int i = 0; i < 16; ++i) O[a][b][i] = 0.f;
    float mrun[2] = {-1e30f, -1e30f}, lsum[2] = {0.f, 0.f};
#define ATT_LOAD_K(kb_, Kd) do { const bf16* kp_ = Kb0 + (size_t)(kb_) * 2048 + (hi * 32 + r) * 8; \
        _Pragma("unroll") for (int kk = 0; kk < 4; ++kk) Kd[kk] = *(const bf16x8*)(kp_ + kk * 512); } while (0)
#define ATT_LOAD_V(kb_, Vd) do { const bf16* vp_ = Vb0 + (size_t)(kb_) * 2048 + (hi * 32 + r) * 8; \
        _Pragma("unroll") for (int db = 0; db < 2; ++db) _Pragma("unroll") for (int s_ = 0; s_ < 2; ++s_) Vd[db][s_] = *(const bf16x8*)(vp_ + (db * 2 + s_) * 512); } while (0)
    const bool full = (ntiles == 9);
#define ATT_TILE_OF(t_) (full ? 8 - ((cm - (t_) + 9) % 9) : (t_))
    bf16x8 K0[4], K1[4], Vc[2][2];
    int ti = ATT_TILE_OF(0);
    ATT_LOAD_K(2 * ti, K0);
#pragma unroll 1
    for (int t = 0; t < ntiles; ++t) {
        const int delta = (ntiles - 1) - ti;
        ATT_LOAD_K(2 * ti + 1, K1); ATT_LOAD_V(2 * ti, Vc);
        attn_block<0>(K0, Vc, Qf, O, mrun, lsum, delta, r, hi, tblR);
        const int tn = (t + 1 < ntiles) ? ATT_TILE_OF(t + 1) : ti;
        ATT_LOAD_K(2 * tn, K0); ATT_LOAD_V(2 * ti + 1, Vc);
        attn_block<1>(K1, Vc, Qf, O, mrun, lsum, delta, r, hi, tblR);
        ti = tn;
    }
#undef ATT_TILE_OF
#undef ATT_LOAD_K
#undef ATT_LOAD_V
    bf16* MX = (bf16*)(ws + WS_MIX);
#pragma unroll
    for (int qb = 0; qb < 2; ++qb) {
        const float lt = lsum[qb] + __shfl_xor(lsum[qb], 32), inv = 1.f / lt;
        bf16* orow = MX + (size_t)(row0 + 32 * qb + r) * DM + 512 + h * 64;
#pragma unroll
        for (int db = 0; db < 2; ++db)
#pragma unroll
            for (int g = 0; g < 4; ++g) { u32x2 w; w.x = pk2(O[db][qb][4 * g] * inv, O[db][qb][4 * g + 1] * inv); w.y = pk2(O[db][qb][4 * g + 2] * inv, O[db][qb][4 * g + 3] * inv);
                *(u32x2*)(orow + 32 * db + 8 * g + 4 * hi) = w; }
    }
}
constexpr int VPITCH = 136;
__device__ __forceinline__ void gmlp_unit(CPP P, int l, int g, int wave, int lane, LAS bf16* vnT) {
    unsigned char* ws = P->ws;
    const bool samp = g >= 256;
    const int row0 = samp ? NP + 64 * (g - 256) : 128 * g, T = samp ? 64 : 128;
    const bf16* VG = (const bf16*)(ws + WS_VG);
    const f32x4 gg = *(const f32x4*)(P->in[15] + l * 256 + 4 * lane), bb = *(const f32x4*)(P->in[16] + l * 256 + 4 * lane);
    {
        const int nq = T >> 3;
        u32x2 raw[16];
#pragma unroll
        for (int q = 0; q < 16; ++q) if (q < nq) raw[q] = *(const u32x2*)(VG + (size_t)(row0 + 4 * wave + 32 * (q >> 2) + (q & 3)) * 256 + 4 * lane);
        f32x4 x[16]; float sm[16], sq[16];
#pragma unroll
        for (int q = 0; q < 16; ++q) if (q < nq) { x[q] = (f32x4){__builtin_bit_cast(float, raw[q].x << 16), __builtin_bit_cast(float, raw[q].x & 0xffff0000u), __builtin_bit_cast(float, raw[q].y << 16), __builtin_bit_cast(float, raw[q].y & 0xffff0000u)};
            sm[q] = (x[q][0] + x[q][1]) + (x[q][2] + x[q][3]); }
#pragma unroll
        for (int o = 1; o < 64; o <<= 1)
#pragma unroll
            for (int q = 0; q < 16; ++q) if (q < nq) sm[q] += __shfl_xor(sm[q], o);
#pragma unroll
        for (int q = 0; q < 16; ++q) if (q < nq) { x[q] = x[q] - sm[q] * (1.f / 256.f); sq[q] = (x[q][0] * x[q][0] + x[q][1] * x[q][1]) + (x[q][2] * x[q][2] + x[q][3] * x[q][3]); }
#pragma unroll
        for (int o = 1; o < 64; o <<= 1)
#pragma unroll
            for (int q = 0; q < 16; ++q) if (q < nq) sq[q] += __shfl_xor(sq[q], o);
#pragma unroll
        for (int q = 0; q < 16; ++q) if (q < nq) { const float rstd = __builtin_amdgcn_rsqf(sq[q] * (1.f / 256.f) + EPS); const f32x4 y = x[q] * rstd * gg + bb; const int t = 4 * wave + 32 * (q >> 2) + (q & 3);
            if (samp) *(f32x4*)(P->out + O_SG + ((size_t)((l * 16 + (g - 256)) * 64 + t)) * 256 + 4 * lane) = y;
            const unsigned p01 = pk2(y[0], y[1]), p23 = pk2(y[2], y[3]);
            vnT[(4 * lane + 0) * VPITCH + t] = (bf16)(p01 & 0xffffu); vnT[(4 * lane + 1) * VPITCH + t] = (bf16)(p01 >> 16);
            vnT[(4 * lane + 2) * VPITCH + t] = (bf16)(p23 & 0xffffu); vnT[(4 * lane + 3) * VPITCH + t] = (bf16)(p23 >> 16); }
    }
    __syncthreads();
    const int h = wave >> 1, th = wave & 1, r = lane & 31, hi = lane >> 5;
    if (64 * th < T) {
        const int nks = (th == 0) ? 4 : 8;
        f32x16 acc[2][2];
#pragma unroll
        for (int a = 0; a < 2; ++a)
#pragma unroll
            for (int b = 0; b < 2; ++b)
#pragma unroll
                for (int i = 0; i < 16; ++i) acc[a][b][i] = 0.f;
        const bf16* Wp = (const bf16*)(ws + WS_WTRIL) + ((size_t)(l * 4 + h) * 128) * 128;
        bf16x8 Bw[8][2];
#pragma unroll
        for (int ks = 0; ks < 8; ++ks)
#pragma unroll
            for (int tb = 0; tb < 2; ++tb) if (ks < nks) Bw[ks][tb] = *(const bf16x8*)(Wp + (size_t)(64 * th + 32 * tb + r) * 128 + 16 * ks + 8 * hi);
#pragma unroll
        for (int ks = 0; ks < 8; ++ks) if (ks < nks) {
            bf16x8 A[2];
#pragma unroll
            for (int db = 0; db < 2; ++db) A[db] = *(const LAS bf16x8*)(vnT + (h * 64 + 32 * db + r) * VPITCH + 16 * ks + 8 * hi);
#pragma unroll
            for (int db = 0; db < 2; ++db)
#pragma unroll
                for (int tb = 0; tb < 2; ++tb) acc[db][tb] = MFMA32(A[db], Bw[ks][tb], acc[db][tb]);
        }
        const bf16* U = (const bf16*)(ws + WS_U); bf16* MX = (bf16*)(ws + WS_MIX);
#pragma unroll
        for (int tb = 0; tb < 2; ++tb) {
            const int t = 64 * th + 32 * tb + r, row = row0 + t;
            const float bias = P->in[18][(l * 4 + h) * 128 + t];
#pragma unroll
            for (int db = 0; db < 2; ++db)
#pragma unroll
                for (int g4 = 0; g4 < 4; ++g4) { const int d = 32 * db + 8 * g4 + 4 * hi;
                    const u32x2 uu = *(const u32x2*)(U + (size_t)row * 256 + h * 64 + d);
                    const float u0 = __builtin_bit_cast(float, uu.x << 16), u1 = __builtin_bit_cast(float, uu.x & 0xffff0000u), u2 = __builtin_bit_cast(float, uu.y << 16), u3 = __builtin_bit_cast(float, uu.y & 0xffff0000u);
                    u32x2 w; w.x = pk2((acc[db][tb][4 * g4] + bias) * u0, (acc[db][tb][4 * g4 + 1] + bias) * u1); w.y = pk2((acc[db][tb][4 * g4 + 2] + bias) * u2, (acc[db][tb][4 * g4 + 3] + bias) * u3);
                    *(u32x2*)(MX + (size_t)row * DM + 256 + h * 64 + d) = w; }
        }
    }
    __syncthreads();
}
constexpr int CW_OFF = 73728;
__device__ __forceinline__ void conv_units(CPP P, int l, int first, int stride, int wave, int lane, const LAS float* cwL) {
    unsigned char* ws = P->ws;
    const f32x4 cb = *(const f32x4*)(P->in[12] + l * 256 + 4 * lane), lg = *(const f32x4*)(P->in[13] + l * 256 + 4 * lane), lb = *(const f32x4*)(P->in[14] + l * 256 + 4 * lane);
    const bf16* GLU = (const bf16*)(ws + WS_GLU); bf16* MX = (bf16*)(ws + WS_MIX);
    const LAS f32x4* cw = (const LAS f32x4*)cwL + lane;
    for (int tile = first; tile < 528; tile += stride) {
        const int row0 = 64 * tile + 8 * wave;
        const int grow0 = (tile >= 512) ? (GLU_SROW0 + (tile - 512) * 94 + 8 * wave) : ((tile >> 7) * GLU_PB + (tile & 127) * 64 + 8 * wave);
        f32x4 acc[8];
#pragma unroll
        for (int tt = 0; tt < 8; ++tt) acc[tt] = cb;
        u32x2 xr[38];
#pragma unroll
        for (int j = 0; j < 38; ++j) xr[j] = *(const u32x2*)(GLU + (size_t)(grow0 + j) * 256 + 4 * lane);
        __builtin_amdgcn_sched_barrier(0);
        f32x4 wv[31];
#pragma unroll
        for (int j = 0; j < 38; ++j) {
            const u32x2 w = xr[j];
            const f32x4 x = (f32x4){__builtin_bit_cast(float, w.x << 16), __builtin_bit_cast(float, w.x & 0xffff0000u), __builtin_bit_cast(float, w.y << 16), __builtin_bit_cast(float, w.y & 0xffff0000u)};
            if (j <= 30) wv[j] = cw[j * 64];
#pragma unroll
            for (int tt = 0; tt < 8; ++tt) { const int tap = j - tt; if (tap >= 0 && tap <= 30) acc[tt] += wv[tap] * x; }
            __builtin_amdgcn_sched_barrier(0);
        }
        float sm[8], sq[8];
#pragma unroll
        for (int tt = 0; tt < 8; ++tt) sm[tt] = (acc[tt][0] + acc[tt][1]) + (acc[tt][2] + acc[tt][3]);
#pragma unroll
        for (int o = 1; o < 64; o <<= 1)
#pragma unroll
            for (int tt = 0; tt < 8; ++tt) sm[tt] += __shfl_xor(sm[tt], o);
#pragma unroll
        for (int tt = 0; tt < 8; ++tt) { acc[tt] = acc[tt] - sm[tt] * (1.f / 256.f); sq[tt] = (acc[tt][0] * acc[tt][0] + acc[tt][1] * acc[tt][1]) + (acc[tt][2] * acc[tt][2] + acc[tt][3] * acc[tt][3]); }
#pragma unroll
        for (int o = 1; o < 64; o <<= 1)
#pragma unroll
            for (int tt = 0; tt < 8; ++tt) sq[tt] += __shfl_xor(sq[tt], o);
#pragma unroll
        for (int tt = 0; tt < 8; ++tt) {
            const float rstd = __builtin_amdgcn_rsqf(sq[tt] * (1.f / 256.f) + EPS);
            const f32x4 y = acc[tt] * rstd * lg + lb;
            u32x2 w; w.x = pk2(siluf_(y[0]), siluf_(y[1])); w.y = pk2(siluf_(y[2]), siluf_(y[3]));
            *(u32x2*)(MX + (size_t)(row0 + tt) * DM + 4 * lane) = w;
        }
    }
}

__global__ void __launch_bounds__(NWAVES * 64, 2) mega_fwd(Params Pk) {
    extern __shared__ __attribute__((aligned(16))) unsigned char lds_raw[];
    LAS unsigned char* lds = (LAS unsigned char*)lds_raw;
    cg::grid_group grid = cg::this_grid();
    const int tid = threadIdx.x, lane = tid & 63, wave = __builtin_amdgcn_readfirstlane(tid >> 6);
    constexpr int G = GRID_WG; const int bx = blockIdx.x;
    const int vb = (G % 8 == 0) ? (bx % 8) * (G / 8) + bx / 8 : bx;
    unsigned char* ws = kparams()->ws;
    float* ssq = (float*)(ws + WS_SSQ); LAS float* rsbuf = (LAS float*)(lds + RS_OFF);
    bf16* XB = (bf16*)(ws + WS_XB); bf16* AH = (bf16*)(ws + WS_A); bf16* MX = (bf16*)(ws + WS_MIX);

    if (tid < 4) ((LAS unsigned*)(lds + XB_OFF))[tid] = 0u;
    __syncthreads();
    const XcdBarrier xbar = xcd_barrier_post((unsigned*)(ws + WS_BAR), (volatile LAS unsigned*)(lds + XB_OFF));
#ifndef DIS_PRO
    for (int rep = 0; rep < REP_PRO; ++rep) { prologue(kparams(), lds, vb, G, wave, lane); __syncthreads(); }
#endif
    if (ws == nullptr) grid.sync();
    xcd_barrier(xbar);

#pragma unroll 1
    for (int l = 0; l < NL; ++l) {
        unsigned char* wl = ws + WS_W + (size_t)l * W_LAYER;
#pragma unroll 1
        for (int k = 0; k < 10; ++k) { const int st = (k < 6) ? k : (k == 6 ? 9 : k - 1);
            CPP P = kparams();
            int bxl = blockIdx.x; asm volatile("" : "+s"(bxl));
            unsigned* cnt = (unsigned*)(ws + WS_CNT) + 64 * (2 * l + ((st >= 5 && st != 9) ? 1 : 0));
            unsigned* cntO = (unsigned*)(ws + WS_CNT) + 64 * (4 + l);
            if (st == 0 || st == 6) {
                pg8::Gemm g{XB, (const bf16*)(wl + (st ? W_GU2 : W_GU1)), MROWS, 2 * DFF, DM};
                GuOrder S; S.init(MROWS, 2 * DFF, G, bxl); S.ssq = ssq; S.rsbuf = rsbuf; S.cnt = cnt; S.wait_cnt = st ? cntO : nullptr; S.samp_i = st ? 2 : 0;
                EpiSwiGLU E{AH, rsbuf};
                { int t_ = threadIdx.x; asm volatile("" : "+v"(t_)); rs_fill(S, ssq, rsbuf, t_); }
#ifndef DIS_GU
                pg8::gemm_phase<EpiSwiGLU, GuOrder, true, true>(lds, g, S, E);
#endif
            } else if (st == 1 || st == 2 || st == 5 || st == 7 || st == 8 || st == 9) {
                const bool first = (l == 0 && st <= 2), samp = (st == 1 || st == 7), isout = (st == 5 || st == 9);
                if (samp && bxl >= 240) {
                    if (threadIdx.x == 0) { unsigned sp = 0; while (__hip_atomic_load(cnt, __ATOMIC_RELAXED, __HIP_MEMORY_SCOPE_AGENT) < 88u && ++sp < (1u << 24)) __builtin_amdgcn_s_sleep(2);
                        __builtin_amdgcn_fence(__ATOMIC_ACQUIRE, "agent"); asm volatile("s_waitcnt vmcnt(0)" ::: "memory"); }
                    __syncthreads();
                }
                pg8::Gemm g{isout ? MX : AH, (const bf16*)(wl + (isout ? W_OUT : (st < 5 ? W_D1 : W_D2))), MROWS, DM, isout ? DM : DFF};
                RangeOrder S;
                S.pub = nullptr;
                if (samp) { S.init(NS, DM, 16, bxl - 240); S.pm0 = NP / 256; } else if (st == 9) { S.init(NS, DM, 16, (bxl >= 224 && bxl < 240) ? bxl - 224 : -1); S.pm0 = NP / 256; S.pub = cntO; } else { S.init(NP, DM, G, bxl); S.pm0 = 0; }
                const bool lastg = (l == NL - 1 && (st == 7 || st == 8));
                EpiResid E{first ? P->in[0] : nullptr, first ? P->in[1] : nullptr, lastg ? P->out : nullptr, XB, lastg ? nullptr : XB, ssq, isout ? 1.f : 0.5f};
#ifndef DIS_RES
                pg8::gemm_phase<EpiResid, RangeOrder, true, true>(lds, g, S, E);
#endif
            } else if (st == 3) {
                pg8::Gemm g{XB, (const bf16*)(wl + W_IN), MROWS, DIN, DM};
                { int t_ = threadIdx.x; asm volatile("" : "+v"(t_));
                  bf16* GLU = (bf16*)(ws + WS_GLU);
                  for (int i = bxl * (NWAVES * 64) + t_; i < 20 * 30 * 64; i += G * (NWAVES * 64)) {
                      const int c4 = i & 63, p = (i >> 6) % 30, sb = i / (64 * 30);
                      u32x2 w; w.x = 0u; w.y = 0u; int grow;
                      if (sb < 4) grow = sb * GLU_PB + p;
                      else { grow = GLU_SROW0 + (sb - 4) * 94 + p; const f32x4 c = *(const f32x4*)(P->in[2] + ((size_t)((l * 16 + (sb - 4)) * 30 + p)) * 256 + 4 * c4); w.x = pk2(c[0], c[1]); w.y = pk2(c[2], c[3]); }
                      *(u32x2*)(GLU + (size_t)grow * 256 + 4 * c4) = w; } }
                RsOrder S; S.init(MROWS, DIN, G, bxl); S.ssq = ssq; S.rsbuf = rsbuf;
                EpiMix E{rsbuf, P->in[19] + l * 64, P->in[20] + l * 64, ws, P->out, l, lds + VSCR_OFF};
                { int t_ = threadIdx.x; asm volatile("" : "+v"(t_)); rs_fill(S, ssq, rsbuf, t_); }
#ifndef DIS_IN
                pg8::gemm_phase<EpiMix, RsOrder, true, true>(lds, g, S, E);
#endif
                if (l == 0 && bxl >= 40) { int t_ = threadIdx.x; asm volatile("" : "+v"(t_)); convert_items(P, lds, PER_LAYER, 2 * PER_LAYER, bxl - 40, G - 40, __builtin_amdgcn_readfirstlane(t_ >> 6), t_ & 63);
                    convert_caches(P, 1, (bxl - 40) * (NWAVES * 64) + t_, (G - 40) * (NWAVES * 64)); }
            } else {
                for (int rep = 0; rep < REP_MIX; ++rep) {
                int tid_ = threadIdx.x; asm volatile("" : "+v"(tid_)); const int lane_ = tid_ & 63;
                LAS float* tblR = (LAS float*)(lds + BIAS_OFF) + wave * 260;
                for (int j = lane_; j < 256; j += 64) { const int rel = 191 - j; const int idx = (j == 255 || rel > 128) ? 256 : rel + 128; tblR[j] = (P->in[21][(size_t)(l * 8 + wave) * 257 + idx] - P->in[21][(size_t)(l * 8 + wave) * 257 + 256]) * LOG2E; }
                { LAS float* cwL0 = (LAS float*)(lds + CW_OFF);
                  for (int i = tid_; i < 31 * 256; i += NWAVES * 64) cwL0[i] = P->in[11][(size_t)l * 31 * 256 + i]; }
                asm volatile("s_waitcnt lgkmcnt(0)" ::: "memory");
                __syncthreads();
#ifndef DIS_ATTN
                const int vbm = (bxl % 8) * (G / 8) + bxl / 8;
                for (int sl = vbm; sl < 512; sl += G) {
                    int u0, u1 = 0, nu = 1;
                    if (sl < 480) u0 = (sl / 120) * 128 + 8 + (sl % 120);
                    else if (sl < 496) u0 = 512 + (sl - 480);
                    else { const int q = sl - 496, ub = (q >> 2) * 128, c1 = q & 3; u0 = ub + c1; u1 = ub + 7 - c1; nu = 2; }
#pragma unroll 1
                    for (int k = 0; k < nu; ++k) attn_unit(P, l, k ? u1 : u0, wave, lane_, tblR);
                }
#endif
                const int R = G, jr = bxl;
#ifndef DIS_GMLP
                if (jr >= 0) for (int k = jr; k < 272; k += R) gmlp_unit(P, l, k, wave, lane_, (LAS bf16*)lds);
#endif
#ifndef DIS_CONV
                { LAS float* cwL = (LAS float*)(lds + CW_OFF);
                  if (jr >= 0) conv_units(P, l, R - 1 - jr, R, wave, lane_, cwL); }
#endif
                __syncthreads(); }
            }
            if (!(l == NL - 1 && st == 8) && st != 0 && st != 6 && st != 9) for (int rep = 0; rep < REP_SYNC; ++rep) xcd_barrier(xbar);
        }
    }
}

extern "C" void kernel_launch(void* const* d_in, const int* in_sizes, int n_in, void* d_out, int out_size, void* d_ws, size_t ws_size, hipStream_t stream) {
    static int grid = 0;
    if (grid == 0) {
        if (n_in != 27 || (size_t)out_size != O_END || ws_size < WS_END) { fprintf(stderr, "kernel_launch: unexpected shapes n_in %d out %d ws %zu\n", n_in, out_size, ws_size); grid = -1; return; }
        int dev = 0, cus = 0, per_cu = 0;
        (void)hipGetDevice(&dev); (void)hipDeviceGetAttribute(&cus, hipDeviceAttributeMultiprocessorCount, dev);
        if (hipFuncSetAttribute((const void*)mega_fwd, hipFuncAttributeMaxDynamicSharedMemorySize, LDS_BYTES) != hipSuccess) { fprintf(stderr, "kernel_launch: hipFuncSetAttribute failed\n"); grid = -1; return; }
        if (hipOccupancyMaxActiveBlocksPerMultiprocessor(&per_cu, (const void*)mega_fwd, NWAVES * 64, LDS_BYTES) != hipSuccess || per_cu < 1) { fprintf(stderr, "kernel_launch: occupancy query gave %d\n", per_cu); per_cu = 1; }
        (void)hipGetLastError();
        grid = cus * per_cu;
        if (grid != GRID_WG) { fprintf(stderr, "kernel_launch: this build is for a co-resident grid of %d workgroups, the device offers %d; nothing launched\n", GRID_WG, grid); grid = -1; return; }
        fprintf(stderr, "kernel_launch: grid %d (cus %d x %d)\n", grid, cus, per_cu);
    }
    if (grid < 0) return;
    if (hipMemsetAsync((char*)d_ws + WS_BAR, 0, 16384 + 4096, stream) != hipSuccess) { fprintf(stderr, "kernel_launch: memset failed\n"); return; }
    Params p{};
    for (int i = 0; i < 27; ++i) p.in[i] = (const float*)d_in[i];
    p.out = (float*)d_out; p.ws = (unsigned char*)d_ws;
    void* args[] = {&p};
    hipError_t e = hipLaunchCooperativeKernel((const void*)mega_fwd, dim3(grid), dim3(NWAVES * 64), args, LDS_BYTES, stream);
    if (e != hipSuccess) fprintf(stderr, "kernel_launch: cooperative launch failed: %s (grid %d)\n", hipGetErrorString(e), grid);
}
```

```cpp
#include <hip/hip_runtime.h>
#include <hip/hip_cooperative_groups.h>
#include <cstdio>
#include <cstdint>
namespace cg = cooperative_groups;
namespace pg8 {
#define PG8_LAS __attribute__((address_space(3)))
typedef unsigned short bf16_t;
typedef short bf16x8 __attribute__((ext_vector_type(8)));
typedef float f32x4 __attribute__((ext_vector_type(4)));
typedef unsigned u32x4 __attribute__((ext_vector_type(4)));
constexpr int BM = 256, BK = 64, HALF = 128, HTB = HALF * BK * 2  , STAGE_BYTES = 8 * HTB, NXCD = 8, WGM = 8;

__host__ __device__ __forceinline__ int lds_byte(int r, int c) { const int st = (r >> 4) * 2 + (c >> 5), rr = r & 15, cc = c & 31, ob = rr * 64 + cc * 2; return st * 1024 + (ob ^ (((ob >> 9) & 1) << 5)); }
__host__ __device__ __forceinline__ void stage_rc(int b, int& R, int& C) { const int st = b / 1024, sb = b % 1024, swz = sb ^ (((sb >> 9) & 1) << 5); R = (st >> 1) * 16 + swz / 64; C = (st & 1) * 32 + (swz % 64) / 2; }
__host__ __device__ __forceinline__ int perm32(int rho) { const int n = rho >> 4, i = rho & 15; return 8 * (i >> 2) + 4 * n + (i & 3); }

struct Unit { int pm, pn, idx; };
struct Gemm { const bf16_t* A; const bf16_t* Bt; int M, N, K; };

struct StaticOrder {
    int nM, nN, nwg, G, c;
    __host__ __device__ void init(int M, int N, int G_, int c_) { nM = M / BM; nN = N / BM; nwg = nM * nN; G = G_; c = c_; }
    __host__ __device__ bool next(int i, Unit& u) const {
        const int L = i * G + c; if (L >= nwg) return false;
        int wgid = (int)L; { const int q = nwg / NXCD, r = nwg % NXCD, xcd = wgid % NXCD, off = wgid / NXCD; wgid = (xcd < r ? xcd * (q + 1) : r * (q + 1) + (xcd - r) * q) + off; }
        const int nig = WGM * nN, gid = wgid / nig, fm = gid * WGM, gsz = (nM - fm) < WGM ? (nM - fm) : WGM;
        u.pm = fm + ((wgid % nig) % gsz); u.pn = (wgid % nig) / gsz; u.idx = i; return true;
    }
    __device__ __forceinline__ void a_ready(const Unit&) const {}
    __device__ __forceinline__ void done(const Unit&) const {}
};

__device__ __forceinline__ unsigned cvt_pk_bf16(float lo, float hi) { unsigned r; asm volatile("v_cvt_pk_bf16_f32 %0, %1, %2" : "=v"(r) : "v"(lo), "v"(hi)); return r; }
typedef float f32x2 __attribute__((ext_vector_type(2)));
__device__ __forceinline__ f32x2 gelu_pk(f32x2 v) {
    const f32x2 av = __builtin_elementwise_abs(v), d = av * 0.2316418882f + 1.0f;
    f32x2 t; t.x = __builtin_amdgcn_rcpf(d.x); t.y = __builtin_amdgcn_rcpf(d.y);
    f32x2 q = t * 0.5307027145f + (-0.7265760135f); q = q * t + 0.7107068705f; q = q * t + (-0.142248368f); q = q * t + 0.127414796f; q = q * t;
    const f32x2 s = (v * v) * (-0.72134752044f);
    f32x2 e; e.x = __builtin_amdgcn_exp2f(s.x); e.y = __builtin_amdgcn_exp2f(s.y);
    const f32x2 m = v * (q * e), r = v - m;
    f32x2 o; o.x = v.x < 0.f ? m.x : r.x; o.y = v.y < 0.f ? m.y : r.y; return o;
}

template <int ACT  > struct EpiBf16 {
    static constexpr bool PERM = true, AFTER_DRAIN = false; static_assert(ACT == 0 || ACT == 1, "EpiBf16: ACT is 0 (none) or 1 (gelu_pk)");
    bf16_t* O; int ldc; const float* bias; int split_cols; size_t split_stride; float scale0;
    __device__ __forceinline__ void operator()(const f32x4 (&acc)[2][2][4][2], const Unit& u, int wr, int wc, int fr, int fq) const {
        const int row0 = u.pm * BM + wr * 64 + fr; int colt = u.pn * BM; bf16_t* base = O;
        float sc = 1.f; if (split_cols) { const int t = colt / split_cols; base += (size_t)t * split_stride; colt -= t * split_cols; if (t == 0) sc = scale0; }
        const int col0 = colt + wc * 32 + 8 * fq, bcol0 = u.pn * BM + wc * 32 + 8 * fq;
        f32x4 bv[2][2];
#pragma unroll
        for (int bj = 0; bj < 2; ++bj)
#pragma unroll
            for (int n = 0; n < 2; ++n) bv[bj][n] = bias ? *(const f32x4*)(bias + bcol0 + bj * HALF + 4 * n) : (f32x4){0.f, 0.f, 0.f, 0.f};
#pragma unroll
        for (int ai = 0; ai < 2; ++ai)
#pragma unroll
            for (int m = 0; m < 4; ++m) { bf16_t* rowp = base + (size_t)(row0 + ai * HALF + m * 16) * ldc + col0;
#pragma unroll
                for (int bj = 0; bj < 2; ++bj) { f32x4 v0 = acc[ai][bj][m][0] + bv[bj][0], v1 = acc[ai][bj][m][1] + bv[bj][1];
                    if (ACT == 1) { f32x2 a = gelu_pk((f32x2){v0[0], v0[1]}), b = gelu_pk((f32x2){v0[2], v0[3]}), c = gelu_pk((f32x2){v1[0], v1[1]}), d = gelu_pk((f32x2){v1[2], v1[3]});
                        v0 = (f32x4){a.x, a.y, b.x, b.y}; v1 = (f32x4){c.x, c.y, d.x, d.y}; }
                    v0 = v0 * sc; v1 = v1 * sc; u32x4 w; w.x = cvt_pk_bf16(v0[0], v0[1]); w.y = cvt_pk_bf16(v0[2], v0[3]); w.z = cvt_pk_bf16(v1[0], v1[1]); w.w = cvt_pk_bf16(v1[2], v1[3]);
                    *(u32x4*)(rowp + bj * HALF) = w; } }
    }
};
template <class Epi, class Sched, bool ALIGN_EPI = false, bool SP2 = false>
__device__ __forceinline__ void gemm_phase(PG8_LAS unsigned char* lds, const Gemm g, const Sched& S, const Epi& E) {
    int tid_ = threadIdx.x; asm volatile("" : "+v"(tid_));
    const int tid = tid_, wid = __builtin_amdgcn_readfirstlane(tid >> 6), lane = tid & 63, wr = wid >> 2, wc = wid & 3, fr = lane & 15, fq = lane >> 4;
    const int K = g.K, nt = K / BK;
    unsigned voffA[2], voffB[2];
#pragma unroll
    for (int i = 0; i < 2; ++i) { int R, C; stage_rc(tid * 16 + i * 8192, R, C); const int Rb = Epi::PERM ? ((R & ~31) + perm32(R & 31)) : R;
        voffA[i] = (unsigned)(R * K + C) * 2u; voffB[i] = (unsigned)(Rb * K + C) * 2u; }
    const size_t kstep = (size_t)(BK * 2);
    const size_t hstep = (size_t)HALF * K * 2;
    const size_t tstep = 2 * hstep;
    const unsigned ldsw = (unsigned)wid * 1024u;
    const int aoff = lds_byte(wr * 64 + fr, fq * 8), boff = lds_byte(wc * 32 + fr, fq * 8);
#define PG8_SA(b, h) (((b) * 2 + (h)) * HTB)
#define PG8_SB(b, h) ((4 + (b) * 2 + (h)) * HTB)
#define PG8_STAGE(bufoff, gbase, voff) do { _Pragma("unroll") for (int _i = 0; _i < 2; ++_i) \
        __builtin_amdgcn_global_load_lds((const unsigned*)((const char*)(gbase) + (voff)[_i]), (PG8_LAS unsigned*)(lds + (bufoff) + ldsw + _i * 8192), 16, 0, 0); } while (0)
#define PG8_LDA(dst, b, h) do { _Pragma("unroll") for (int m = 0; m < 4; ++m) _Pragma("unroll") for (int k = 0; k < 2; ++k) dst[m][k] = *(const PG8_LAS bf16x8*)(lds + PG8_SA(b, h) + aoff + m * 2048 + k * 1024); } while (0)
#define PG8_LDB(dst, b, h) do { _Pragma("unroll") for (int n = 0; n < 2; ++n) _Pragma("unroll") for (int k = 0; k < 2; ++k) dst[n][k] = *(const PG8_LAS bf16x8*)(lds + PG8_SB(b, h) + boff + n * 2048 + k * 1024); } while (0)
#define PG8_MMA(ai, bj, At, Bt) do { __builtin_amdgcn_s_setprio(1); _Pragma("unroll") for (int m = 0; m < 4; ++m) _Pragma("unroll") for (int n = 0; n < 2; ++n) _Pragma("unroll") for (int k = 0; k < 2; ++k) \
        acc[ai][bj][m][n] = __builtin_amdgcn_mfma_f32_16x16x32_bf16(Bt[n][k], At[m][k], acc[ai][bj][m][n], 0, 0, 0); __builtin_amdgcn_s_setprio(0); } while (0)
#define PG8_WAIT_V(n) asm volatile("s_waitcnt vmcnt(" #n ")" ::: "memory")
#define PG8_WAIT_L(n) asm volatile("s_waitcnt lgkmcnt(" #n ")" ::: "memory")
#define PG8_BAR __builtin_amdgcn_s_barrier()
#define PG8_SCHED __builtin_amdgcn_sched_barrier(0)
    Unit cur, nxt; int ui = 0;
    if (!S.next(0, cur)) return;
    f32x4 acc[2][2][4][2];
#pragma unroll
    for (int a = 0; a < 2; ++a)
#pragma unroll
        for (int b = 0; b < 2; ++b)
#pragma unroll
            for (int m = 0; m < 4; ++m)
#pragma unroll
                for (int n = 0; n < 2; ++n) acc[a][b][m][n] = (f32x4){0.f, 0.f, 0.f, 0.f};
    bf16x8 At[4][2], B0[2][2], B1[2][2];
    const char* cA = (const char*)g.A + (size_t)cur.pm * tstep; const char* cB = (const char*)g.Bt + (size_t)cur.pn * tstep;
    S.a_ready(cur);
    if constexpr (SP2) {
        PG8_STAGE(PG8_SB(0, 0), cB, voffB); PG8_STAGE(PG8_SB(0, 1), cB + hstep, voffB); PG8_STAGE(PG8_SA(0, 0), cA, voffA); PG8_STAGE(PG8_SA(0, 1), cA + hstep, voffA);
        if (wr == 1) PG8_BAR;
        PG8_WAIT_V(2); PG8_BAR;
        PG8_STAGE(PG8_SB(1, 0), cB + kstep, voffB); PG8_STAGE(PG8_SA(1, 0), cA + kstep, voffA); PG8_STAGE(PG8_SB(1, 1), cB + hstep + kstep, voffB);
        PG8_WAIT_V(6); PG8_BAR;
    } else {
        PG8_STAGE(PG8_SB(0, 0), cB, voffB); PG8_STAGE(PG8_SA(0, 0), cA, voffA); PG8_STAGE(PG8_SB(0, 1), cB + hstep, voffB); PG8_STAGE(PG8_SA(0, 1), cA + hstep, voffA);
        if (wr == 1) PG8_BAR;
        PG8_WAIT_V(4); PG8_BAR;
        PG8_STAGE(PG8_SB(1, 0), cB + kstep, voffB); PG8_STAGE(PG8_SA(1, 0), cA + kstep, voffA); PG8_STAGE(PG8_SB(1, 1), cB + hstep + kstep, voffB);
        PG8_WAIT_V(6); PG8_BAR;
    }
    for (;;) {
        const bool has_next = S.next(ui + 1, nxt);
        const char* nA = has_next ? (const char*)g.A + (size_t)nxt.pm * tstep : cA; const char* nB = has_next ? (const char*)g.Bt + (size_t)nxt.pn * tstep : cB;
        for (int t = 0; t < nt; t += 2) {
            const bool last = (t == nt - 2);
            const char* a1 = cA + (size_t)(t + 1) * kstep;
            const char* a2 = last ? nA : cA + (size_t)(t + 2) * kstep; const char* b2 = last ? nB : cB + (size_t)(t + 2) * kstep;
            const char* a3 = a2 + kstep; const char* b3 = b2 + kstep;
            if (last && has_next) S.a_ready(nxt);
            if constexpr (SP2) {
            PG8_LDB(B0, 0, 0); PG8_LDB(B1, 0, 1); PG8_SCHED; PG8_LDA(At, 0, 0); PG8_STAGE(PG8_SA(1, 1), a1 + hstep, voffA);
            PG8_WAIT_V(8); PG8_WAIT_L(0); PG8_BAR; PG8_MMA(0, 0, At, B0); PG8_MMA(0, 1, At, B1); PG8_BAR; PG8_SCHED;
            PG8_LDA(At, 0, 1); PG8_STAGE(PG8_SB(0, 0), b2, voffB); PG8_STAGE(PG8_SB(0, 1), b2 + hstep, voffB); PG8_STAGE(PG8_SA(0, 0), a2, voffA);
            PG8_WAIT_V(8); PG8_WAIT_L(0); PG8_BAR; PG8_MMA(1, 0, At, B0); PG8_MMA(1, 1, At, B1); PG8_BAR; PG8_SCHED;
            PG8_LDB(B0, 1, 0); PG8_LDB(B1, 1, 1); PG8_SCHED; PG8_LDA(At, 1, 0); PG8_STAGE(PG8_SA(0, 1), a2 + hstep, voffA);
            PG8_WAIT_V(8); PG8_WAIT_L(0); PG8_BAR; PG8_MMA(0, 0, At, B0); PG8_MMA(0, 1, At, B1); PG8_BAR; PG8_SCHED;
            PG8_LDA(At, 1, 1); PG8_STAGE(PG8_SB(1, 0), b3, voffB); PG8_STAGE(PG8_SB(1, 1), b3 + hstep, voffB); PG8_STAGE(PG8_SA(1, 0), a3, voffA);
            PG8_WAIT_V(8); PG8_WAIT_L(0); PG8_BAR; PG8_MMA(1, 0, At, B0); PG8_MMA(1, 1, At, B1); PG8_BAR; PG8_SCHED;
            } else {
            PG8_LDB(B0, 0, 0); PG8_SCHED; PG8_LDA(At, 0, 0); PG8_STAGE(PG8_SA(1, 1), a1 + hstep, voffA);
            PG8_WAIT_L(8); PG8_BAR; PG8_WAIT_L(0); PG8_MMA(0, 0, At, B0); PG8_BAR; PG8_SCHED;
            PG8_LDB(B1, 0, 1); PG8_STAGE(PG8_SB(0, 0), b2, voffB);
            PG8_BAR; PG8_WAIT_L(0); PG8_MMA(0, 1, At, B1); PG8_BAR;
            PG8_LDA(At, 0, 1); PG8_STAGE(PG8_SA(0, 0), a2, voffA);
            PG8_BAR; PG8_WAIT_L(0); PG8_MMA(1, 0, At, B0); PG8_BAR; PG8_SCHED;
            PG8_STAGE(PG8_SB(0, 1), b2 + hstep, voffB);
            PG8_WAIT_V(6); PG8_BAR; PG8_MMA(1, 1, At, B1); PG8_BAR;
            PG8_LDB(B0, 1, 0); PG8_SCHED; PG8_LDA(At, 1, 0); PG8_STAGE(PG8_SA(0, 1), a2 + hstep, voffA);
            PG8_WAIT_L(8); PG8_BAR; PG8_WAIT_L(0); PG8_MMA(0, 0, At, B0); PG8_BAR; PG8_SCHED;
            PG8_LDB(B1, 1, 1); PG8_STAGE(PG8_SB(1, 0), b3, voffB);
            PG8_BAR; PG8_WAIT_L(0); PG8_MMA(0, 1, At, B1); PG8_BAR;
            PG8_LDA(At, 1, 1); PG8_STAGE(PG8_SA(1, 0), a3, voffA);
            PG8_BAR; PG8_WAIT_L(0); PG8_MMA(1, 0, At, B0); PG8_BAR; PG8_SCHED;
            PG8_STAGE(PG8_SB(1, 1), b3 + hstep, voffB);
            PG8_WAIT_V(6); PG8_BAR; PG8_MMA(1, 1, At, B1); PG8_BAR;
            }
        }
        if constexpr (ALIGN_EPI) { if (wr == 0) PG8_BAR; }
        if constexpr (!Epi::AFTER_DRAIN) { E(acc, cur, wr, wc, fr, fq); S.done(cur); }
        if (!has_next) break;
#pragma unroll
        for (int a = 0; a < 2; ++a)
#pragma unroll
            for (int b = 0; b < 2; ++b)
#pragma unroll
                for (int m = 0; m < 4; ++m)
#pragma unroll
                    for (int n = 0; n < 2; ++n) acc[a][b][m][n] = (f32x4){0.f, 0.f, 0.f, 0.f};
        cur = nxt; cA = nA; cB = nB; ++ui;
        if constexpr (ALIGN_EPI) { if (wr == 1) PG8_BAR; }
    }
    PG8_WAIT_V(0);
    if constexpr (!ALIGN_EPI) { if (wr == 0) PG8_BAR; }
    PG8_BAR;
    if constexpr (Epi::AFTER_DRAIN) { E.fused(acc, cur, wr, wc, fr, fq, lds, wid, lane); S.done(cur); }
#undef PG8_SA
#undef PG8_SB
#undef PG8_STAGE
#undef PG8_LDA
#undef PG8_LDB
#undef PG8_MMA
#undef PG8_WAIT_V
#undef PG8_WAIT_L
#undef PG8_BAR
#undef PG8_SCHED
}
}
#define LAS __attribute__((address_space(3)))
#define XB_TMO      128
#define XB_XCNT(j)  (256  + 64 * (j))
#define XB_XSUB(j)  (1280 + 64 * (j))
#define XB_XGEN(j)  (2304 + 64 * (j))
#define XB_TOP      3328
#define XB_TOPGEN   3392
#define XCD_BAR_WORDS 3456
#define XB_SPIN_CAP (1u << 18)

__device__ __forceinline__ unsigned xb_ld(unsigned* p)              { return __hip_atomic_load(p, __ATOMIC_RELAXED, __HIP_MEMORY_SCOPE_AGENT); }
__device__ __forceinline__ unsigned xb_add(unsigned* p, unsigned v) { return __hip_atomic_fetch_add(p, v, __ATOMIC_RELAXED, __HIP_MEMORY_SCOPE_AGENT); }
__device__ __forceinline__ unsigned xb_xcc_id() { return (unsigned)__builtin_amdgcn_s_getreg((3 << 11) | 20) & 0xFu; }
#define XB_SPIN(cond, bar) do { unsigned _sp = 0; while (cond) { __builtin_amdgcn_s_sleep(1); \
    if ((++_sp & 255u) == 0u) { if (xb_ld(&(bar)[XB_TMO])) break; if (_sp > XB_SPIN_CAP) { atomicAdd(&(bar)[XB_TMO], 1u); break; } } } } while (0)

struct XcdBarrier {
    unsigned* bar; unsigned x;
    volatile LAS unsigned* st;
};

__device__ __forceinline__ XcdBarrier xcd_barrier_post(unsigned* bar, volatile LAS unsigned* st) {
    XcdBarrier b; b.bar = bar; b.x = xb_xcc_id(); b.st = st;
    if (threadIdx.x == 0) (void)xb_add(&bar[XB_XCNT(b.x)], 1u);
    return b;
}
__device__ __forceinline__ void xcd_barrier_complete(unsigned* bar, unsigned x, unsigned& nloc, unsigned& nx) {
    const unsigned G = gridDim.x * gridDim.y * gridDim.z;
    unsigned sum, cnt, mine, sp = 0u;
    for (;;) {
        sum = 0u; cnt = 0u; mine = 0u;
#pragma unroll
        for (unsigned j = 0; j < 16; ++j) { const unsigned c = xb_ld(&bar[XB_XCNT(j)]); sum += c; cnt += (c > 0u) ? 1u : 0u; mine = (j == x) ? c : mine; }
        if (sum == G) break;
        __builtin_amdgcn_s_sleep(1);
        if ((++sp & 255u) == 0u) { if (xb_ld(&bar[XB_TMO])) break; if (sp > XB_SPIN_CAP) { atomicAdd(&bar[XB_TMO], 1u); break; } }
    }
    nloc = mine > 0u ? mine : 1u; nx = cnt > 0u ? cnt : 1u;
}

__device__ __forceinline__ void xcd_barrier(const XcdBarrier& b) {
    asm volatile("s_waitcnt vmcnt(0)" ::: "memory");
    __syncthreads();
    if (threadIdx.x == 0) {
        unsigned* bar = b.bar; const unsigned bx_ = xb_xcc_id();
        __builtin_amdgcn_s_waitcnt(0);
        unsigned nloc = b.st[0], nx = b.st[1];
        if (nloc == 0u) { xcd_barrier_complete(bar, bx_, nloc, nx); b.st[0] = nloc; b.st[1] = nx; }
        const unsigned old = xb_add(&bar[XB_XSUB(bx_)], 1u);
        const unsigned gen = old / nloc;
        if (old + 1u == (gen + 1u) * nloc) {
            __builtin_amdgcn_fence(__ATOMIC_RELEASE, "agent");
            asm volatile("s_waitcnt vmcnt(0)" ::: "memory");
            const unsigned og = xb_add(&bar[XB_TOP], 1u);
            const unsigned tg = og / nx;
            if (og + 1u == (tg + 1u) * nx) xb_add(&bar[XB_TOPGEN], 1u);
            else XB_SPIN(xb_ld(&bar[XB_TOPGEN]) == tg, bar);
            __builtin_amdgcn_fence(__ATOMIC_ACQUIRE, "agent");
            xb_add(&bar[XB_XGEN(bx_)], 1u);
            asm volatile("s_waitcnt vmcnt(0)" ::: "memory");
        } else {
            XB_SPIN(xb_ld(&bar[XB_XGEN(bx_)]) == gen, bar);
            __builtin_amdgcn_fence(__ATOMIC_ACQUIRE, "agent");
            asm volatile("s_waitcnt vmcnt(0)" ::: "memory");
        }
    }
    __syncthreads();
}

#define GAS __attribute__((address_space(1)))
#define LAS __attribute__((address_space(3)))
typedef unsigned short bf16;
typedef float f32x4 __attribute__((ext_vector_type(4)));
typedef float f32x16 __attribute__((ext_vector_type(16)));
typedef short bf16x8 __attribute__((ext_vector_type(8)));
typedef short s16x4 __attribute__((ext_vector_type(4)));
typedef unsigned u32x4 __attribute__((ext_vector_type(4)));
typedef unsigned u32x2 __attribute__((ext_vector_type(2)));

#ifndef REP_MIX
#define REP_MIX 1
#endif
#ifndef REP_PRO
#define REP_PRO 1
#endif
#ifndef REP_SYNC
#define REP_SYNC 1
#endif
constexpr int NWAVES = 8;
constexpr int GRID_WG = 256;
constexpr int DM = 1024, NP = 32768, NS = 1024, MROWS = NP + NS, SEQ = 8192, DFF = 2816, DIN = 2560, NL = 2;
constexpr float EPS = 1e-6f;
constexpr float LOG2E = 1.4426950408889634f;
constexpr size_t MiB = 1u << 20;
constexpr size_t WS_W = 0;
constexpr size_t W_LAYER = 40 * MiB, W_GU1 = 0, W_D1 = 11 * MiB, W_IN = 16 * MiB + 512 * 1024, W_OUT = 21 * MiB + 512 * 1024, W_GU2 = 23 * MiB + 512 * 1024, W_D2 = 34 * MiB + 512 * 1024;
constexpr size_t WS_WTRIL = 80 * MiB;
constexpr size_t WS_BAR = 80 * MiB + 512 * 1024;
constexpr size_t WS_CNT = WS_BAR + 16384;
constexpr size_t WS_SSQ = 81 * MiB;
constexpr size_t WS_SK = 84 * MiB;
constexpr size_t WS_SVT = 102 * MiB;
constexpr size_t WS_XB = 120 * MiB;
constexpr size_t WS_MIX = 186 * MiB;
constexpr size_t WS_A = 252 * MiB;
constexpr size_t WS_GLU = WS_A, WS_U = WS_A + 17 * MiB, WS_VG = WS_A + 34 * MiB, WS_Q = WS_A + 51 * MiB, WS_PK = WS_A + 84 * MiB, WS_PVT = WS_A + 116 * MiB;
constexpr size_t WS_END = WS_A + 182 * MiB;
static_assert(WS_PVT + 32 * MiB <= WS_END, "overlay");
constexpr size_t O_YP = 0, O_YS = 33554432, O_PCS = O_YS + 1048576, O_PK = O_PCS + 61440, O_PV = O_PK + 2097152, O_SCS = O_PV + 2097152,
                 O_SK = O_SCS + 245760, O_SV = O_SK + 1048576, O_SG = O_SV + 1048576, O_END = O_SG + 524288;
constexpr int GLU_PB = SEQ + 30, GLU_SROW0 = 4 * GLU_PB;
constexpr int RING_BYTES = 131072, BIAS_OFF = RING_BYTES, RS_OFF = RING_BYTES + 8448, RS_UNITS = 12, XB_OFF = RS_OFF + RS_UNITS * 1024, VSCR_OFF = XB_OFF + 32, LDS_BYTES = 160256;

struct Params {
    const float* in[27];
    float* out; unsigned char* ws;
};
typedef const __attribute__((address_space(4))) Params* CPP;
__device__ __forceinline__ CPP kparams() { CPP q = (CPP)__builtin_amdgcn_kernarg_segment_ptr(); asm volatile("" : "+s"(q)); return q; }

__device__ __forceinline__ unsigned f2bf(float f) { unsigned u = __builtin_bit_cast(unsigned, f); return (u + 0x7fffu + ((u >> 16) & 1u)) >> 16; }
typedef __bf16 bf16x2_t __attribute__((ext_vector_type(2)));
typedef float f32x2_t __attribute__((ext_vector_type(2)));
__device__ __forceinline__ unsigned pk2(float lo, float hi) { const f32x2_t f = {lo, hi}; const bf16x2_t h = __builtin_convertvector(f, bf16x2_t); return __builtin_bit_cast(unsigned, h); }
__device__ __forceinline__ float bf2f(unsigned short b) { return __builtin_bit_cast(float, (unsigned)b << 16); }
__device__ __forceinline__ unsigned cvtpk(float lo, float hi) { return pk2(lo, hi); }
__device__ __forceinline__ float wave_sum(float v) {
#pragma unroll
    for (int o = 1; o < 64; o <<= 1) v += __shfl_xor(v, o);
    return v;
}
__device__ __forceinline__ float fast_exp2(float x) { return __builtin_amdgcn_exp2f(x); }
__device__ __forceinline__ float fast_rcp(float x) { return __builtin_amdgcn_rcpf(x); }
__device__ __forceinline__ float sigmoidf_(float x) { return fast_rcp(1.f + fast_exp2(-LOG2E * x)); }
__device__ __forceinline__ float siluf_(float x) { return x * sigmoidf_(x); }
__device__ __forceinline__ float gelu_tanh(float x) { const float t = 0.7978845608028654f * (x + 0.044715f * x * x * x); return x * sigmoidf_(2.f * t); }
__device__ __forceinline__ float row_rs(const float* ssq, int row) {
    const f32x4* p = (const f32x4*)(ssq + (size_t)row * 16);
    const f32x4 a = p[0], b = p[1], c = p[2], d = p[3];
    const f32x4 s = (a + b) + (c + d);
    return __builtin_amdgcn_rsqf(((s[0] + s[1]) + (s[2] + s[3])) * (1.f / 1024.f) + EPS);
}

struct RsOrder : pg8::StaticOrder {
    const float* ssq; LAS float* rsbuf;
    __device__ __forceinline__ void a_ready(const pg8::Unit&) const {}
};
template <class Sched>
__device__ __forceinline__ void rs_fill(const Sched& S, const float* ssq, LAS float* rsbuf, int tid) {
    int pms[RS_UNITS]; int nu = 0;
#pragma unroll
    for (int i = 0; i < RS_UNITS; ++i) { pg8::Unit u; const bool ok = S.next(i, u); pms[i] = ok ? u.pm : 0; nu += ok ? 1 : 0; }
    const int half = tid >> 8, rr = tid & 255;
#pragma unroll
    for (int b = 0; b < RS_UNITS / 2; b += 6) {
        f32x4 v[6][4];
#pragma unroll
        for (int k = 0; k < 6; ++k) { const int ui = 2 * (b + k) + half; const int pm = half ? pms[2 * (b + k) + 1] : pms[2 * (b + k)];
            const f32x4* p = (const f32x4*)(ssq + ((size_t)pm * 256 + rr) * 16);
            if (ui < nu) { v[k][0] = p[0]; v[k][1] = p[1]; v[k][2] = p[2]; v[k][3] = p[3]; } }
#pragma unroll
        for (int k = 0; k < 6; ++k) { const int ui = 2 * (b + k) + half;
            if (ui < nu) { const f32x4 s4 = (v[k][0] + v[k][1]) + (v[k][2] + v[k][3]); rsbuf[ui * 256 + rr] = __builtin_amdgcn_rsqf(((s4[0] + s4[1]) + (s4[2] + s4[3])) * (1.f / 1024.f) + EPS); } }
    }
    __syncthreads();
}
struct GuOrder : RsOrder {
    unsigned* cnt;
    const unsigned* wait_cnt;
    int samp_i;
    __device__ __forceinline__ bool next(int i, pg8::Unit& u) const {
        int L;
        if (c < 240) { L = i * 240 + c; if (L >= 2760) return false; }
        else { if (i >= 9) return false; L = 2760 + (c - 240) + 16 * i; }
        u.idx = i;
        const int s0 = 240 * samp_i;
        if (L >= s0 && L < s0 + 88) { const int q = L - s0; u.pm = 128 + q / 22; u.pn = q % 22; return true; }
        int wgid = (L < s0) ? L : L - 88; { const int xcd = wgid % 8, off = wgid / 8; wgid = xcd * 352 + off; }
        const int gid = wgid / 176, rem = wgid % 176;
        u.pm = gid * 8 + (rem % 8); u.pn = rem / 8; return true;
    }
    __device__ __forceinline__ void a_ready(const pg8::Unit& u) const {
        if (wait_cnt != nullptr && u.pm >= 128) {
            if (threadIdx.x < 64) { unsigned sp = 0; while ((unsigned)__builtin_amdgcn_readfirstlane(__hip_atomic_load(wait_cnt, __ATOMIC_RELAXED, __HIP_MEMORY_SCOPE_AGENT)) < 16u && ++sp < (1u << 22)) __builtin_amdgcn_s_sleep(2);
                __builtin_amdgcn_fence(__ATOMIC_ACQUIRE, "agent"); }
            asm volatile("s_waitcnt vmcnt(0)" ::: "memory");
            __builtin_amdgcn_s_barrier();
            if (threadIdx.x < 256) rsbuf[u.idx * 256 + threadIdx.x] = row_rs(ssq, u.pm * 256 + threadIdx.x);
        }
    }
    __device__ __forceinline__ void done(const pg8::Unit& u) const {
        if (u.pm >= 128) {
            asm volatile("s_waitcnt vmcnt(0)" ::: "memory");
            __builtin_amdgcn_s_barrier();
            if (threadIdx.x == 0) { __builtin_amdgcn_fence(__ATOMIC_RELEASE, "agent"); asm volatile("s_waitcnt vmcnt(0)" ::: "memory");
                __hip_atomic_fetch_add(cnt, 1u, __ATOMIC_RELAXED, __HIP_MEMORY_SCOPE_AGENT); }
        }
    }
};
struct RangeOrder : pg8::StaticOrder {
    int pm0; unsigned* pub;
    __device__ __forceinline__ bool next(int i, pg8::Unit& u) const { if (c < 0) return false; if (!pg8::StaticOrder::next(i, u)) return false; u.pm += pm0; return true; }
    __device__ __forceinline__ void done(const pg8::Unit&) const {
        if (pub != nullptr) {
            asm volatile("s_waitcnt vmcnt(0)" ::: "memory");
            __builtin_amdgcn_s_barrier();
            if (threadIdx.x == 0) { __builtin_amdgcn_fence(__ATOMIC_RELEASE, "agent"); asm volatile("s_waitcnt vmcnt(0)" ::: "memory");
                __hip_atomic_fetch_add(pub, 1u, __ATOMIC_RELAXED, __HIP_MEMORY_SCOPE_AGENT); }
        }
    }
};
struct EpiSwiGLU {
    static constexpr bool PERM = true, AFTER_DRAIN = false;
    bf16* O; const LAS float* rsbuf;
    __device__ __forceinline__ void operator()(const pg8::f32x4 (&acc)[2][2][4][2], const pg8::Unit& u, int wr, int wc, int fr, int fq) const {
        const int row0 = u.pm * 256 + wr * 64 + fr, col0 = u.pn * 128 + wc * 32 + 8 * fq;
#pragma unroll
        for (int ai = 0; ai < 2; ++ai)
#pragma unroll
            for (int m = 0; m < 4; ++m) {
                const int row = row0 + ai * 128 + m * 16;
                const float rs = rsbuf[u.idx * 256 + (row & 255)];
                float h[8];
#pragma unroll
                for (int n = 0; n < 2; ++n)
#pragma unroll
                    for (int e = 0; e < 4; ++e) { const float g = acc[ai][0][m][n][e] * rs, up = acc[ai][1][m][n][e] * rs; h[4 * n + e] = siluf_(g) * up; }
                u32x4 w; w.x = cvtpk(h[0], h[1]); w.y = cvtpk(h[2], h[3]); w.z = cvtpk(h[4], h[5]); w.w = cvtpk(h[6], h[7]);
                *(u32x4*)(O + (size_t)row * DFF + col0) = w;
            }
    }
};
struct EpiResid {
    static constexpr bool PERM = true, AFTER_DRAIN = false;
    const float* bp; const float* bs; float* X; const bf16* XBr; bf16* XB; float* ssq; float alpha;
    __device__ __forceinline__ void operator()(const pg8::f32x4 (&acc)[2][2][4][2], const pg8::Unit& u, int wr, int wc, int fr, int fq) const {
        const int row0 = u.pm * 256 + wr * 64 + fr, col0 = u.pn * 256 + wc * 32 + 8 * fq;
        const float* base = (u.pm * 256 < NP) ? bp : (bs - (size_t)NP * DM);
        if (bp == nullptr) {
            u32x4 q[2][4][2];
#pragma unroll
            for (int ai = 0; ai < 2; ++ai)
#pragma unroll
                for (int m = 0; m < 4; ++m)
#pragma unroll
                    for (int bj = 0; bj < 2; ++bj) q[ai][m][bj] = *(const u32x4*)(XBr + (size_t)(row0 + ai * 128 + m * 16) * DM + col0 + bj * 128);
#pragma unroll
            for (int ai = 0; ai < 2; ++ai)
#pragma unroll
                for (int m = 0; m < 4; ++m) {
                    const int row = row0 + ai * 128 + m * 16;
                    float ss = 0.f;
#pragma unroll
                    for (int bj = 0; bj < 2; ++bj) {
                        const size_t off = (size_t)row * DM + col0 + bj * 128;
                        const u32x4 qq = q[ai][m][bj];
                        const f32x4 b0 = (f32x4){__builtin_bit_cast(float, qq.x << 16), __builtin_bit_cast(float, qq.x & 0xffff0000u), __builtin_bit_cast(float, qq.y << 16), __builtin_bit_cast(float, qq.y & 0xffff0000u)};
                        const f32x4 b1 = (f32x4){__builtin_bit_cast(float, qq.z << 16), __builtin_bit_cast(float, qq.z & 0xffff0000u), __builtin_bit_cast(float, qq.w << 16), __builtin_bit_cast(float, qq.w & 0xffff0000u)};
                        const f32x4 v0 = b0 + acc[ai][bj][m][0] * alpha, v1 = b1 + acc[ai][bj][m][1] * alpha;
                        if (X != nullptr) { *(f32x4*)(X + off) = v0; *(f32x4*)(X + off + 4) = v1; }
                        if (XB != nullptr) {
                            u32x4 w; w.x = cvtpk(v0[0], v0[1]); w.y = cvtpk(v0[2], v0[3]); w.z = cvtpk(v1[0], v1[1]); w.w = cvtpk(v1[2], v1[3]);
                            *(u32x4*)(XB + off) = w;
                            ss += (v0[0] * v0[0] + v0[1] * v0[1]) + (v0[2] * v0[2] + v0[3] * v0[3]) + (v1[0] * v1[0] + v1[1] * v1[1]) + (v1[2] * v1[2] + v1[3] * v1[3]); }
                    }
                    if (XB != nullptr) { ss += __shfl_xor(ss, 16); ss += __shfl_xor(ss, 32);
                        if (fq == 0) ssq[(size_t)row * 16 + 4 * u.pn + wc] = ss; }
                }
            return;
        }
#pragma unroll
        for (int ai = 0; ai < 2; ++ai) {
            f32x4 fb[4][2][2];
#pragma unroll
            for (int m = 0; m < 4; ++m)
#pragma unroll
                for (int bj = 0; bj < 2; ++bj) { const float* p = base + (size_t)(row0 + ai * 128 + m * 16) * DM + col0 + bj * 128; fb[m][bj][0] = *(const f32x4*)p; fb[m][bj][1] = *(const f32x4*)(p + 4); }
#pragma unroll
            for (int m = 0; m < 4; ++m) {
                const int row = row0 + ai * 128 + m * 16;
                float ss = 0.f;
#pragma unroll
                for (int bj = 0; bj < 2; ++bj) {
                    const size_t off = (size_t)row * DM + col0 + bj * 128;
                    const f32x4 v0 = fb[m][bj][0] + acc[ai][bj][m][0] * alpha, v1 = fb[m][bj][1] + acc[ai][bj][m][1] * alpha;
                    u32x4 w; w.x = cvtpk(v0[0], v0[1]); w.y = cvtpk(v0[2], v0[3]); w.z = cvtpk(v1[0], v1[1]); w.w = cvtpk(v1[2], v1[3]);
                    *(u32x4*)(XB + off) = w;
                    ss += (v0[0] * v0[0] + v0[1] * v0[1]) + (v0[2] * v0[2] + v0[3] * v0[3]) + (v1[0] * v1[0] + v1[1] * v1[1]) + (v1[2] * v1[2] + v1[3] * v1[3]);
                }
                ss += __shfl_xor(ss, 16); ss += __shfl_xor(ss, 32);
                if (fq == 0) ssq[(size_t)row * 16 + 4 * u.pn + wc] = ss;
            }
        }
    }
};
struct EpiMix {
    static constexpr bool PERM = true, AFTER_DRAIN = false;
    const LAS float* rsbuf; const float* qg; const float* kg; unsigned char* ws; float* out; int l; LAS unsigned char* vscr;
    __device__ __forceinline__ void operator()(const pg8::f32x4 (&acc)[2][2][4][2], const pg8::Unit& u, int wr, int wc, int fr, int fq) const {
        bf16* const GLU = (bf16*)(ws + WS_GLU); bf16* const U = (bf16*)(ws + WS_U); bf16* const VG = (bf16*)(ws + WS_VG); bf16* const Q = (bf16*)(ws + WS_Q);
        bf16* const PK = (bf16*)(ws + WS_PK); bf16* const PVT = (bf16*)(ws + WS_PVT);
        bf16* const SK = (bf16*)(ws + WS_SK) + (size_t)l * 16 * 576 * 512; bf16* const SVT = (bf16*)(ws + WS_SVT) + (size_t)l * 16 * 512 * 576;
        float* const o_pcs = out + O_PCS + (size_t)l * 4 * 30 * 256; float* const o_pk = out + O_PK + (size_t)l * 4 * 512 * 512; float* const o_pv = out + O_PV + (size_t)l * 4 * 512 * 512;
        float* const o_scs = out + O_SCS + (size_t)l * 16 * 30 * 256; float* const o_sk = out + O_SK + (size_t)l * 16 * 64 * 512; float* const o_sv = out + O_SV + (size_t)l * 16 * 64 * 512;
        const int row0 = u.pm * 256 + wr * 64 + fr, pn = u.pn;
        const bool samp = (u.pm * 256 >= NP);
        if (pn < 2) {
            const int ch0 = pn * 128 + wc * 32 + 8 * fq;
#pragma unroll
            for (int ai = 0; ai < 2; ++ai)
#pragma unroll
                for (int m = 0; m < 4; ++m) {
                    const int row = row0 + ai * 128 + m * 16; const float rs = rsbuf[u.idx * 256 + (row & 255)];
                    float h[8];
#pragma unroll
                    for (int n = 0; n < 2; ++n)
#pragma unroll
                        for (int e = 0; e < 4; ++e) h[4 * n + e] = (acc[ai][0][m][n][e] * rs) * sigmoidf_(acc[ai][1][m][n][e] * rs);
                    u32x4 w; w.x = cvtpk(h[0], h[1]); w.y = cvtpk(h[2], h[3]); w.z = cvtpk(h[4], h[5]); w.w = cvtpk(h[6], h[7]);
                    { const int grow = samp ? (GLU_SROW0 + ((row - NP) >> 6) * 94 + 30 + ((row - NP) & 63)) : ((row >> 13) * GLU_PB + 30 + (row & 8191));
                      *(u32x4*)(GLU + (size_t)grow * 256 + ch0) = w; }
                    float* dst = nullptr;
                    if (!samp) { const int b = row >> 13, t = row & 8191; if (t >= SEQ - 30) dst = o_pcs + ((size_t)(b * 30 + (t - (SEQ - 30)))) * 256 + ch0; }
                    else { const int rr = row - NP, b = rr >> 6, t = rr & 63; if (t >= 34) dst = o_scs + ((size_t)(b * 30 + (t - 34))) * 256 + ch0; }
                    if (dst) { *(f32x4*)dst = (f32x4){h[0], h[1], h[2], h[3]}; *(f32x4*)(dst + 4) = (f32x4){h[4], h[5], h[6], h[7]}; }
                }
        } else if (pn < 4) {
            bf16* O = (pn == 2) ? U : VG;
#pragma unroll
            for (int ai = 0; ai < 2; ++ai)
#pragma unroll
                for (int m = 0; m < 4; ++m) {
                    const int row = row0 + ai * 128 + m * 16; const float rs = rsbuf[u.idx * 256 + (row & 255)];
#pragma unroll
                    for (int bj = 0; bj < 2; ++bj) {
                        float h[8];
#pragma unroll
                        for (int n = 0; n < 2; ++n)
#pragma unroll
                            for (int e = 0; e < 4; ++e) h[4 * n + e] = gelu_tanh(acc[ai][bj][m][n][e] * rs);
                        u32x4 w; w.x = cvtpk(h[0], h[1]); w.y = cvtpk(h[2], h[3]); w.z = cvtpk(h[4], h[5]); w.w = cvtpk(h[6], h[7]);
                        *(u32x4*)(O + (size_t)row * 256 + bj * 128 + wc * 32 + 8 * fq) = w;
                    }
                }
        } else if (pn < 8) {
            const bool isq = pn < 6;
            const int head = 4 * ((pn - 4) & 1) + wc;
            const float* gp = isq ? qg : kg;
            const float sc = isq ? 0.125f * LOG2E : 1.f;
            float gn[2][8];
#pragma unroll
            for (int bj = 0; bj < 2; ++bj) { const f32x4 ga = *(const f32x4*)(gp + 32 * bj + 8 * fq) * sc, gb = *(const f32x4*)(gp + 32 * bj + 8 * fq + 4) * sc;
#pragma unroll
                for (int j = 0; j < 4; ++j) { gn[bj][j] = ga[j]; gn[bj][4 + j] = gb[j]; } }
#pragma unroll
            for (int ai = 0; ai < 2; ++ai)
#pragma unroll
                for (int m = 0; m < 4; ++m) {
                    const int row = row0 + ai * 128 + m * 16; const float rs = rsbuf[u.idx * 256 + (row & 255)];
                    float z[2][8]; float ss = 0.f;
#pragma unroll
                    for (int bj = 0; bj < 2; ++bj)
#pragma unroll
                        for (int n = 0; n < 2; ++n)
#pragma unroll
                            for (int e = 0; e < 4; ++e) { const float v = acc[ai][bj][m][n][e] * rs; z[bj][4 * n + e] = v; ss += v * v; }
                    ss += __shfl_xor(ss, 16); ss += __shfl_xor(ss, 32);
                    const float inv = __builtin_amdgcn_rsqf(ss * (1.f / 64.f) + EPS);
#pragma unroll
                    for (int bj = 0; bj < 2; ++bj)
#pragma unroll
                        for (int j = 0; j < 8; ++j) z[bj][j] = z[bj][j] * inv * gn[bj][j];
                    bf16* dstb; float* dstf = nullptr;
                    if (isq) dstb = Q + (size_t)row * 512 + head * 64;
                    else if (!samp) { dstb = PK + ((size_t)(head * 1024 + (row >> 5)) * 256 + (row & 31)) * 8; const int b = row >> 13, t = row & 8191; if (t >= SEQ - 512) dstf = o_pk + ((size_t)(b * 512 + (t - (SEQ - 512))) * 8 + head) * 64; }
                    else { const int rr = row - NP, b = rr >> 6, t = rr & 63; dstb = SK + (size_t)b * 294912 + ((size_t)(head * 18 + 16 + (t >> 5)) * 256 + (t & 31)) * 8; dstf = o_sk + ((size_t)(b * 64 + t) * 8 + head) * 64; }
#pragma unroll
                    for (int bj = 0; bj < 2; ++bj) {
                        u32x4 w; w.x = cvtpk(z[bj][0], z[bj][1]); w.y = cvtpk(z[bj][2], z[bj][3]); w.z = cvtpk(z[bj][4], z[bj][5]); w.w = cvtpk(z[bj][6], z[bj][7]);
                        *(u32x4*)(dstb + (isq ? 32 * bj + 8 * fq : ((2 * bj + (fq >> 1)) * 2 + (fq & 1)) * 256)) = w;
                        if (dstf) { *(f32x4*)(dstf + 32 * bj + 8 * fq) = (f32x4){z[bj][0], z[bj][1], z[bj][2], z[bj][3]}; *(f32x4*)(dstf + 32 * bj + 8 * fq + 4) = (f32x4){z[bj][4], z[bj][5], z[bj][6], z[bj][7]}; }
                    }
                }
        } else {
#pragma unroll
            for (int ai = 0; ai < 2; ++ai)
#pragma unroll
                for (int m = 0; m < 4; ++m) {
                    const int row = row0 + ai * 128 + m * 16; const float rs = rsbuf[u.idx * 256 + (row & 255)];
                    bf16* dstb; float* dstf = nullptr;
                    const int rowg = row - fr;
                    if (!samp) { dstb = PVT + (size_t)(rowg >> 5) * 2048 + ((rowg >> 4) & 1) * 512; const int b = row >> 13, t = row & 8191; if (t >= SEQ - 512) dstf = o_pv + (size_t)(b * 512 + (t - (SEQ - 512))) * 512; }
                    else { const int rr = rowg - NP, b = rr >> 6, t0 = rr & 63, t = (row - NP) & 63; dstb = SVT + (size_t)b * 294912 + (size_t)(16 + (t0 >> 5)) * 2048 + ((t0 >> 4) & 1) * 512; dstf = o_sv + (size_t)(b * 64 + t) * 512; }
                    const size_t hstride = samp ? (size_t)18 * 2048 : (size_t)1024 * 2048;
                    LAS unsigned short* sc = (LAS unsigned short*)(vscr + (wr * 4 + wc) * 1024);
                    const int ln = fq * 16 + fr;
#pragma unroll
                    for (int bj = 0; bj < 2; ++bj) {
                        const int c0 = (pn - 8) * 256 + bj * 128 + wc * 32 + 8 * fq;
                        float z[8];
#pragma unroll
                        for (int n = 0; n < 2; ++n)
#pragma unroll
                            for (int e = 0; e < 4; ++e) z[4 * n + e] = acc[ai][bj][m][n][e] * rs;
#pragma unroll
                        for (int j = 0; j < 8; j += 2) { const unsigned p = pk2(z[j], z[j + 1]); sc[(8 * fq + j) * 16 + fr] = (unsigned short)(p & 0xffffu); sc[(8 * fq + j + 1) * 16 + fr] = (unsigned short)(p >> 16); }
                        asm volatile("s_waitcnt lgkmcnt(0)" ::: "memory");
                        { const int ch = ln & 31, hx = ln >> 5;
                          const u32x2 lo = *(const LAS u32x2*)(sc + ch * 16 + 4 * hx), hh = *(const LAS u32x2*)(sc + ch * 16 + 8 + 4 * hx);
                          const int cw0 = (pn - 8) * 256 + bj * 128 + wc * 32;
                          u32x4 w; w.x = lo.x; w.y = lo.y; w.z = hh.x; w.w = hh.y;
                          *(u32x4*)(dstb + (size_t)(cw0 >> 6) * hstride + ((cw0 >> 5) & 1) * 1024 + hx * 256 + ch * 8) = w; }
                        asm volatile("s_waitcnt lgkmcnt(0)" ::: "memory");
                        if (dstf) { *(f32x4*)(dstf + c0) = (f32x4){z[0], z[1], z[2], z[3]}; *(f32x4*)(dstf + c0 + 4) = (f32x4){z[4], z[5], z[6], z[7]}; }
                    }
                }
        }
    }
};

struct TItem { const float* W; const float* gain; bf16* WT; int N, pitch, drow, k0, n0; };
__device__ __forceinline__ int win_dst_row(int n0) {
    if (n0 < 256) return 256 * (n0 >> 7) + (n0 & 127);
    if (n0 < 512) { const int ch = n0 - 256; return 256 * (ch >> 7) + 128 + (ch & 127); }
    if (n0 < 1024) return n0;
    if (n0 < 2048) { const int k = (n0 >= 1536); const int c = n0 - 1024 - 512 * k, head = c >> 6, d = c & 63; return 256 * (4 + 2 * k + (head >> 2)) + 128 * (d >> 5) + 32 * (head & 3) + (d & 31); }
    return n0;
}
constexpr int PER_LAYER = 10240, NW_ITEMS = NL * PER_LAYER, NV_ITEMS = 0, NT_ITEMS = NW_ITEMS + NV_ITEMS;
__device__ __forceinline__ TItem decode_item(CPP P, int it) {
    TItem d; unsigned char* ws = P->ws;
    if (it < NW_ITEMS) {
        const int l = it / PER_LAYER, r = it % PER_LAYER;
        unsigned char* wl = ws + WS_W + (size_t)l * W_LAYER;
        if (r < 8448) {
            const int mi = r / 1408, rr = r % 1408, ffn = mi / 3, kind = mi % 3;
            if (kind < 2) {
                const int nb = rr % 88, kb = rr / 88; d.n0 = 32 * nb; d.k0 = 64 * kb;
                d.W = P->in[(ffn ? 24 : 6) + kind] + (size_t)l * DM * DFF; d.gain = P->in[ffn ? 23 : 5] + l * DM; d.N = DFF;
                d.WT = (bf16*)(wl + (ffn ? W_GU2 : W_GU1)); d.pitch = DM; d.drow = 256 * (d.n0 >> 7) + 128 * kind + (d.n0 & 127);
            } else {
                const int nb = rr % 32, kb = rr / 32; d.n0 = 32 * nb; d.k0 = 64 * kb;
                d.W = P->in[ffn ? 26 : 8] + (size_t)l * DFF * DM; d.gain = nullptr; d.N = DM;
                d.WT = (bf16*)(wl + (ffn ? W_D2 : W_D1)); d.pitch = DFF; d.drow = d.n0;
            }
        } else if (r < 8448 + 1280) {
            const int rr = r - 8448, nb = rr % 80, kb = rr / 80; d.n0 = 32 * nb; d.k0 = 64 * kb;
            d.W = P->in[10] + (size_t)l * DM * DIN; d.gain = P->in[9] + l * DM; d.N = DIN; d.WT = (bf16*)(wl + W_IN); d.pitch = DM; d.drow = win_dst_row(d.n0);
        } else {
            const int rr = r - 8448 - 1280, nb = rr % 32, kb = rr / 32; d.n0 = 32 * nb; d.k0 = 64 * kb;
            d.W = P->in[22] + (size_t)l * DM * DM; d.gain = nullptr; d.N = DM; d.WT = (bf16*)(wl + W_OUT); d.pitch = DM; d.drow = d.n0;
        }
    } else {
        const int r = it - NW_ITEMS, lb = r >> 7, rr = r & 127, nb = rr & 15, kb = rr >> 4;
        d.n0 = 32 * nb; d.k0 = 64 * kb; d.W = P->in[4] + (size_t)lb * 512 * 512; d.gain = nullptr; d.N = 512;
        d.WT = (bf16*)(ws + WS_SVT) + (size_t)lb * 512 * 576; d.pitch = 576; d.drow = d.n0;
    }
    return d;
}
__device__ __forceinline__ void item_load(const TItem& d, int lane, float (&v)[32]) {
    const float* p = d.W + (size_t)(d.k0 + (lane >> 5)) * d.N + d.n0 + (lane & 31);
#pragma unroll
    for (int i = 0; i < 32; ++i) v[i] = p[(size_t)(2 * i) * d.N];
}
__device__ __forceinline__ void item_store(const TItem& d, int lane, const float (&v)[32], LAS float* scr) {
#pragma unroll
    for (int i = 0; i < 32; ++i) scr[(2 * i + (lane >> 5)) * 33 + (lane & 31)] = v[i];
    asm volatile("s_waitcnt lgkmcnt(0)" ::: "memory");
    const int c = lane & 7;
    f32x4 g0 = (f32x4){1.f, 1.f, 1.f, 1.f}, g1 = g0;
    if (d.gain) { g0 = *(const f32x4*)(d.gain + d.k0 + 8 * c); g1 = *(const f32x4*)(d.gain + d.k0 + 8 * c + 4); }
#pragma unroll
    for (int j = 0; j < 4; ++j) { const int n = (lane >> 3) + 8 * j; const LAS float* s = scr + (8 * c) * 33 + n;
        u32x4 o; o.x = pk2(s[0 * 33] * g0[0], s[1 * 33] * g0[1]); o.y = pk2(s[2 * 33] * g0[2], s[3 * 33] * g0[3]); o.z = pk2(s[4 * 33] * g1[0], s[5 * 33] * g1[1]); o.w = pk2(s[6 * 33] * g1[2], s[7 * 33] * g1[3]);
        *(u32x4*)(d.WT + (size_t)(d.drow + n) * d.pitch + d.k0 + 8 * c) = o; }
    asm volatile("s_waitcnt lgkmcnt(0)" ::: "memory");
}
__device__ __forceinline__ void convert_caches(CPP P, int l, int gt, int NGT) {
    unsigned char* ws = P->ws;
    bf16* SK = (bf16*)(ws + WS_SK); bf16* SV = (bf16*)(ws + WS_SVT);
    for (int i0 = gt; i0 < 16 * 512 * 64; i0 += 4 * NGT) {
        f32x4 a[4], b[4];
#pragma unroll
        for (int q = 0; q < 4; ++q) { const int i = i0 + q * NGT; const int ii = i < 16 * 512 * 64 ? i : i0; const int c8 = ii & 63, s_ = (ii >> 6) & 511, lb = l * 16 + (ii >> 15);
            const f32x4* srck = (const f32x4*)(P->in[3] + ((size_t)(lb * 512 + s_)) * 512 + 8 * c8); a[q] = srck[0]; b[q] = srck[1]; }
#pragma unroll
        for (int q = 0; q < 4; ++q) { const int i = i0 + q * NGT;
            if (i < 16 * 512 * 64) { const int c8 = i & 63, s_ = (i >> 6) & 511, lb = l * 16 + (i >> 15), head = c8 >> 3, d0 = (c8 & 7) * 8;
                u32x4 w; w.x = pk2(a[q][0], a[q][1]); w.y = pk2(a[q][2], a[q][3]); w.z = pk2(b[q][0], b[q][1]); w.w = pk2(b[q][2], b[q][3]);
                *(u32x4*)(SK + (size_t)lb * 294912 + (size_t)(head * 18 + (s_ >> 5)) * 2048 + ((((d0 >> 4) * 2 + ((d0 >> 3) & 1)) * 32) + (s_ & 31)) * 8) = w; } }
    }
    for (int i0 = gt; i0 < 16 * 64 * 512; i0 += 2 * NGT) {
        float v[2][8];
#pragma unroll
        for (int q = 0; q < 2; ++q) { const int i = i0 + q * NGT; const int ii = i < 16 * 64 * 512 ? i : i0; const int ch = ii & 511, kg = (ii >> 9) & 63, lb = l * 16 + (ii >> 15), kb = kg >> 2, sx = (kg >> 1) & 1, hx = kg & 1;
            const float* src = P->in[4] + ((size_t)(lb * 512 + 32 * kb + 16 * sx + 4 * hx)) * 512 + ch;
#pragma unroll
            for (int j = 0; j < 8; ++j) v[q][j] = src[(size_t)(8 * (j >> 2) + (j & 3)) * 512]; }
#pragma unroll
        for (int q = 0; q < 2; ++q) { const int i = i0 + q * NGT;
            if (i < 16 * 64 * 512) { const int ch = i & 511, kg = (i >> 9) & 63, lb = l * 16 + (i >> 15), kb = kg >> 2, sx = (kg >> 1) & 1, hx = kg & 1, head = ch >> 6, d = ch & 63;
                u32x4 w; w.x = pk2(v[q][0], v[q][1]); w.y = pk2(v[q][2], v[q][3]); w.z = pk2(v[q][4], v[q][5]); w.w = pk2(v[q][6], v[q][7]);
                *(u32x4*)(SV + (size_t)lb * 294912 + (size_t)(head * 18 + kb) * 2048 + (((((d >> 5) * 2 + sx) * 2 + hx) * 32) + (d & 31)) * 8) = w; } }
    }
}
__device__ __forceinline__ void convert_items(CPP P, LAS unsigned char* lds, int it0, int it1, int worker, int nworkers, int wave, int lane) {
    LAS float* scr = (LAS float*)(lds + wave * 16384);
    const int gw = it0 + worker * NWAVES + wave, NGW = nworkers * NWAVES;
    if (gw < it1) {
        TItem cur = decode_item(P, gw); float v[32]; item_load(cur, lane, v);
#pragma unroll 1
        for (int it = gw; it < it1; it += NGW) {
            const int nx = it + NGW; const bool has = nx < it1;
            TItem nd = decode_item(P, has ? nx : it); float vn[32];
            if (has) item_load(nd, lane, vn);
            item_store(cur, lane, v, scr);
            if (has) {
#pragma unroll
                for (int i = 0; i < 32; ++i) v[i] = vn[i];
                cur = nd; }
        }
    }
}
__device__ __forceinline__ void prologue(CPP P, LAS unsigned char* lds, int vb, int G, int wave, int lane) {
    LAS float* scr = (LAS float*)(lds + wave * 16384);
    const int gw = vb * NWAVES + wave, NGW = G * NWAVES;
    unsigned char* ws = P->ws;
    convert_items(P, lds, 0, PER_LAYER, vb, G, wave, lane);
    bf16* XB = (bf16*)(ws + WS_XB); float* ssq = (float*)(ws + WS_SSQ);
    for (int m0 = gw; m0 < MROWS; m0 += 4 * NGW) {
        f32x4 a[4][4];
#pragma unroll
        for (int q = 0; q < 4; ++q) { const int m = m0 + q * NGW; const int mm = m < MROWS ? m : m0;
            const float* xr = (mm < NP) ? P->in[0] + (size_t)mm * DM : P->in[1] + (size_t)(mm - NP) * DM;
#pragma unroll
            for (int j = 0; j < 4; ++j) a[q][j] = ((const f32x4*)xr)[lane + 64 * j]; }
#pragma unroll
        for (int q = 0; q < 4; ++q) { const int m = m0 + q * NGW;
            if (m < MROWS) { float s0 = 0.f;
#pragma unroll
                for (int j = 0; j < 4; ++j) { s0 += (a[q][j][0] * a[q][j][0] + a[q][j][1] * a[q][j][1]) + (a[q][j][2] * a[q][j][2] + a[q][j][3] * a[q][j][3]);
                    u32x2 w; w.x = pk2(a[q][j][0], a[q][j][1]); w.y = pk2(a[q][j][2], a[q][j][3]); ((u32x2*)(XB + (size_t)m * DM))[lane + 64 * j] = w; }
                s0 += __shfl_xor(s0, 16); s0 += __shfl_xor(s0, 32);
                if (lane < 16) ssq[(size_t)m * 16 + lane] = s0; } }
    }
    const int gt = vb * (NWAVES * 64) + wave * 64 + lane, NGT = G * NWAVES * 64;
    bf16* WT = (bf16*)(ws + WS_WTRIL);
    for (int i = gt; i < NL * 4 * 128 * 128; i += NGT) { const int s = i & 127, t = (i >> 7) & 127; WT[i] = (bf16)(s <= t ? f2bf(P->in[17][i]) : 0u); }
    convert_caches(P, 0, gt, NGT);
}

#define MFMA32(a, b, c) __builtin_amdgcn_mfma_f32_32x32x16_bf16((a), (b), (c), 0, 0, 0)
template <int KH>
__device__ __forceinline__ void attn_block(const bf16x8 (&Kf)[4], const bf16x8 (&Vf)[2][2], const bf16x8 (&Qf)[2][4], f32x16 (&O)[2][2], float (&mrun)[2], float (&lsum)[2],
                                           int delta, int r, int hi, const LAS float* tblR) {
    f32x16 S[2];
    if (delta >= 3) {
#pragma unroll
        for (int qb = 0; qb < 2; ++qb)
#pragma unroll
            for (int i = 0; i < 16; ++i) S[qb][i] = 0.f; }
    else {
#pragma unroll
        for (int qb = 0; qb < 2; ++qb) { const LAS float* tp = tblR + (191 - (64 * delta + (32 * qb + r) - (32 * KH + 4 * hi)));
#pragma unroll
            for (int i = 0; i < 16; ++i) S[qb][i] = tp[(i & 3) + 8 * (i >> 2)]; } }
#pragma unroll
    for (int kk = 0; kk < 4; ++kk)
#pragma unroll
        for (int qb = 0; qb < 2; ++qb) S[qb] = MFMA32(Kf[kk], Qf[qb][kk], S[qb]);
    float mx[2], mnew[2], alpha[2];
#pragma unroll
    for (int qb = 0; qb < 2; ++qb) { float m = fmaxf(fmaxf(S[qb][0], S[qb][1]), fmaxf(S[qb][2], S[qb][3]));
#pragma unroll
        for (int i = 4; i < 16; i += 2) m = fmaxf(m, fmaxf(S[qb][i], S[qb][i + 1]));
        mx[qb] = m; }
#pragma unroll
    for (int qb = 0; qb < 2; ++qb) mx[qb] = fmaxf(mx[qb], __shfl_xor(mx[qb], 32));
#pragma unroll
    for (int qb = 0; qb < 2; ++qb) { mnew[qb] = fmaxf(mrun[qb], mx[qb]); alpha[qb] = fast_exp2(mrun[qb] - mnew[qb]); mrun[qb] = mnew[qb]; }
#pragma unroll
    for (int i = 0; i < 16; ++i)
#pragma unroll
        for (int qb = 0; qb < 2; ++qb) S[qb][i] = fast_exp2(S[qb][i] - mnew[qb]);
#pragma unroll
    for (int qb = 0; qb < 2; ++qb) {
        const float ps = (((S[qb][0] + S[qb][1]) + (S[qb][2] + S[qb][3])) + ((S[qb][4] + S[qb][5]) + (S[qb][6] + S[qb][7]))) + (((S[qb][8] + S[qb][9]) + (S[qb][10] + S[qb][11])) + ((S[qb][12] + S[qb][13]) + (S[qb][14] + S[qb][15])));
        lsum[qb] = lsum[qb] * alpha[qb] + ps; }
    if (__builtin_amdgcn_ballot_w64(alpha[0] != 1.f || alpha[1] != 1.f) != 0ull) {
#pragma unroll
        for (int qb = 0; qb < 2; ++qb)
#pragma unroll
            for (int db = 0; db < 2; ++db)
#pragma unroll
                for (int i = 0; i < 16; ++i) O[db][qb][i] *= alpha[qb]; }
    bf16x8 Pf[2][2];
#pragma unroll
    for (int qb = 0; qb < 2; ++qb)
#pragma unroll
        for (int s = 0; s < 2; ++s) { u32x4 w; w.x = pk2(S[qb][8 * s], S[qb][8 * s + 1]); w.y = pk2(S[qb][8 * s + 2], S[qb][8 * s + 3]); w.z = pk2(S[qb][8 * s + 4], S[qb][8 * s + 5]); w.w = pk2(S[qb][8 * s + 6], S[qb][8 * s + 7]); Pf[qb][s] = __builtin_bit_cast(bf16x8, w); }
#pragma unroll
    for (int s = 0; s < 2; ++s)
#pragma unroll
        for (int qb = 0; qb < 2; ++qb)
#pragma unroll
            for (int db = 0; db < 2; ++db) O[db][qb] = MFMA32(Vf[db][s], Pf[qb][s], O[db][qb]);
}
__device__ __forceinline__ void attn_unit(CPP P, int l, int u, int wave, int lane, const LAS float* tblR) {
    unsigned char* ws = P->ws;
    const int h = wave, r = lane & 31, hi = lane >> 5;
    const bf16* Kb0; const bf16* Vb0; int ntiles, row0;
    int cm = 0;
    if (u < 512) { const int b = u >> 7, c = u & 127; cm = c % 9; row0 = b * SEQ + 64 * c; ntiles = (c < 8 ? c : 8) + 1; const int kbg0 = (row0 - 64 * (ntiles - 1)) >> 5;
        Kb0 = (const bf16*)(ws + WS_PK) + (size_t)(h * 1024 + kbg0) * 2048; Vb0 = (const bf16*)(ws + WS_PVT) + (size_t)(h * 1024 + kbg0) * 2048; }
    else { const int b = u - 512; row0 = NP + 64 * b; ntiles = 9;
        Kb0 = (const bf16*)(ws + WS_SK) + (size_t)(l * 16 + b) * 294912 + (size_t)(h * 18) * 2048; Vb0 = (const bf16*)(ws + WS_SVT) + (size_t)(l * 16 + b) * 294912 + (size_t)(h * 18) * 2048; }
    const bf16* Qp = (const bf16*)(ws + WS_Q) + (size_t)row0 * 512 + h * 64;
    bf16x8 Qf[2][4];
#pragma unroll
    for (int qb = 0; qb < 2; ++qb)
#pragma unroll
        for (int kk = 0; kk < 4; ++kk) Qf[qb][kk] = *(const bf16x8*)(Qp + (size_t)(32 * qb + r) * 512 + 16 * kk + 8 * hi);
    f32x16 O[2][2];
#pragma unroll
    for (int a = 0; a < 2; ++a)
#pragma unroll
        for (int b = 0; b < 2; ++b)
#pragma unroll
            for (int i = 0; i < 16; ++i) O[a][b][i] = 0.f;
    float mrun[2] = {-1e30f, -1e30f}, lsum[2] = {0.f, 0.f};
#define ATT_LOAD_K(kb_, Kd) do { const bf16* kp_ = Kb0 + (size_t)(kb_) * 2048 + (hi * 32 + r) * 8; \
        _Pragma("unroll") for (int kk = 0; kk < 4; ++kk) Kd[kk] = *(const bf16x8*)(kp_ + kk * 512); } while (0)
#define ATT_LOAD_V(kb_, Vd) do { const bf16* vp_ = Vb0 + (size_t)(kb_) * 2048 + (hi * 32 + r) * 8; \
        _Pragma("unroll") for (int db = 0; db < 2; ++db) _Pragma("unroll") for (int s_ = 0; s_ < 2; ++s_) Vd[db][s_] = *(const bf16x8*)(vp_ + (db * 2 + s_) * 512); } while (0)
    const bool full = (ntiles == 9);
#define ATT_TILE_OF(t_) (full ? 8 - ((cm - (t_) + 9) % 9) : (t_))
    bf16x8 K0[4], K1[4], Vc[2][2];
    int ti = ATT_TILE_OF(0);
    ATT_LOAD_K(2 * ti, K0);
#pragma unroll 1
    for (int t = 0; t < ntiles; ++t) {
        const int delta = (ntiles - 1) - ti;
        ATT_LOAD_K(2 * ti + 1, K1); ATT_LOAD_V(2 * ti, Vc);
        attn_block<0>(K0, Vc, Qf, O, mrun, lsum, delta, r, hi, tblR);
        const int tn = (t + 1 < ntiles) ? ATT_TILE_OF(t + 1) : ti;
        ATT_LOAD_K(2 * tn, K0); ATT_LOAD_V(2 * ti + 1, Vc);
        attn_block<1>(K1, Vc, Qf, O, mrun, lsum, delta, r, hi, tblR);
        ti = tn;
    }
#undef ATT_TILE_OF
#undef ATT_LOAD_K
#undef ATT_LOAD_V
    bf16* MX = (bf16*)(ws + WS_MIX);
#pragma unroll
    for (int qb = 0; qb < 2; ++qb) {
        const float lt = lsum[qb] + __shfl_xor(lsum[qb], 32), inv = 1.f / lt;
        bf16* orow = MX + (size_t)(row0 + 32 * qb + r) * DM + 512 + h * 64;
#pragma unroll
        for (int db = 0; db < 2; ++db)
#pragma unroll
            for (int g = 0; g < 4; ++g) { u32x2 w; w.x = pk2(O[db][qb][4 * g] * inv, O[db][qb][4 * g + 1] * inv); w.y = pk2(O[db][qb][4 * g + 2] * inv, O[db][qb][4 * g + 3] * inv);
                *(u32x2*)(orow + 32 * db + 8 * g + 4 * hi) = w; }
    }
}
constexpr int VPITCH = 136;
__device__ __forceinline__ void gmlp_unit(CPP P, int l, int g, int wave, int lane, LAS bf16* vnT) {
    unsigned char* ws = P->ws;
    const bool samp = g >= 256;
    const int row0 = samp ? NP + 64 * (g - 256) : 128 * g, T = samp ? 64 : 128;
    const bf16* VG = (const bf16*)(ws + WS_VG);
    const f32x4 gg = *(const f32x4*)(P->in[15] + l * 256 + 4 * lane), bb = *(const f32x4*)(P->in[16] + l * 256 + 4 * lane);
    const int h = wave >> 1, th = wave & 1, r = lane & 31, hi = lane >> 5;
    const int nks = (th == 0) ? 4 : 8;
    const bf16* Wp = (const bf16*)(ws + WS_WTRIL) + ((size_t)(l * 4 + h) * 128) * 128;
    bf16x8 Bw[8][2];
    if (64 * th < T) {
#pragma unroll
        for (int ks = 0; ks < 8; ++ks)
#pragma unroll
            for (int tb = 0; tb < 2; ++tb) if (ks < nks) Bw[ks][tb] = *(const bf16x8*)(Wp + (size_t)(64 * th + 32 * tb + r) * 128 + 16 * ks + 8 * hi);
    }
    {
        const int nq = T >> 3;
        u32x2 raw[16];
#pragma unroll
        for (int q = 0; q < 16; ++q) if (q < nq) raw[q] = *(const u32x2*)(VG + (size_t)(row0 + 4 * wave + 32 * (q >> 2) + (q & 3)) * 256 + 4 * lane);
        f32x4 x[16]; float sm[16], sq[16];
#pragma unroll
        for (int q = 0; q < 16; ++q) if (q < nq) { x[q] = (f32x4){__builtin_bit_cast(float, raw[q].x << 16), __builtin_bit_cast(float, raw[q].x & 0xffff0000u), __builtin_bit_cast(float, raw[q].y << 16), __builtin_bit_cast(float, raw[q].y & 0xffff0000u)};
            sm[q] = (x[q][0] + x[q][1]) + (x[q][2] + x[q][3]); }
#pragma unroll
        for (int o = 1; o < 64; o <<= 1)
#pragma unroll
            for (int q = 0; q < 16; ++q) if (q < nq) sm[q] += __shfl_xor(sm[q], o);
#pragma unroll
        for (int q = 0; q < 16; ++q) if (q < nq) { x[q] = x[q] - sm[q] * (1.f / 256.f); sq[q] = (x[q][0] * x[q][0] + x[q][1] * x[q][1]) + (x[q][2] * x[q][2] + x[q][3] * x[q][3]); }
#pragma unroll
        for (int o = 1; o < 64; o <<= 1)
#pragma unroll
            for (int q = 0; q < 16; ++q) if (q < nq) sq[q] += __shfl_xor(sq[q], o);
#pragma unroll
        for (int q = 0; q < 16; ++q) if (q < nq) { const float rstd = __builtin_amdgcn_rsqf(sq[q] * (1.f / 256.f) + EPS); const f32x4 y = x[q] * rstd * gg + bb; const int t = 4 * wave + 32 * (q >> 2) + (q & 3);
            if (samp) *(f32x4*)(P->out + O_SG + ((size_t)((l * 16 + (g - 256)) * 64 + t)) * 256 + 4 * lane) = y;
            const unsigned p01 = pk2(y[0], y[1]), p23 = pk2(y[2], y[3]);
            vnT[(4 * lane + 0) * VPITCH + t] = (bf16)(p01 & 0xffffu); vnT[(4 * lane + 1) * VPITCH + t] = (bf16)(p01 >> 16);
            vnT[(4 * lane + 2) * VPITCH + t] = (bf16)(p23 & 0xffffu); vnT[(4 * lane + 3) * VPITCH + t] = (bf16)(p23 >> 16); }
    }
    __syncthreads();
    if (64 * th < T) {
        f32x16 acc[2][2];
#pragma unroll
        for (int a = 0; a < 2; ++a)
#pragma unroll
            for (int b = 0; b < 2; ++b)
#pragma unroll
                for (int i = 0; i < 16; ++i) acc[a][b][i] = 0.f;
#pragma unroll
        for (int ks = 0; ks < 8; ++ks) if (ks < nks) {
            bf16x8 A[2];
#pragma unroll
            for (int db = 0; db < 2; ++db) A[db] = *(const LAS bf16x8*)(vnT + (h * 64 + 32 * db + r) * VPITCH + 16 * ks + 8 * hi);
#pragma unroll
            for (int db = 0; db < 2; ++db)
#pragma unroll
                for (int tb = 0; tb < 2; ++tb) acc[db][tb] = MFMA32(A[db], Bw[ks][tb], acc[db][tb]);
        }
        const bf16* U = (const bf16*)(ws + WS_U); bf16* MX = (bf16*)(ws + WS_MIX);
#pragma unroll
        for (int tb = 0; tb < 2; ++tb) {
            const int t = 64 * th + 32 * tb + r, row = row0 + t;
            const float bias = P->in[18][(l * 4 + h) * 128 + t];
#pragma unroll
            for (int db = 0; db < 2; ++db)
#pragma unroll
                for (int g4 = 0; g4 < 4; ++g4) { const int d = 32 * db + 8 * g4 + 4 * hi;
                    const u32x2 uu = *(const u32x2*)(U + (size_t)row * 256 + h * 64 + d);
                    const float u0 = __builtin_bit_cast(float, uu.x << 16), u1 = __builtin_bit_cast(float, uu.x & 0xffff0000u), u2 = __builtin_bit_cast(float, uu.y << 16), u3 = __builtin_bit_cast(float, uu.y & 0xffff0000u);
                    u32x2 w; w.x = pk2((acc[db][tb][4 * g4] + bias) * u0, (acc[db][tb][4 * g4 + 1] + bias) * u1); w.y = pk2((acc[db][tb][4 * g4 + 2] + bias) * u2, (acc[db][tb][4 * g4 + 3] + bias) * u3);
                    *(u32x2*)(MX + (size_t)row * DM + 256 + h * 64 + d) = w; }
        }
    }
    __syncthreads();
}
constexpr int CW_OFF = 73728;
__device__ __forceinline__ void conv_units(CPP P, int l, int first, int stride, int wave, int lane, const LAS float* cwL) {
    unsigned char* ws = P->ws;
    const f32x4 cb = *(const f32x4*)(P->in[12] + l * 256 + 4 * lane), lg = *(const f32x4*)(P->in[13] + l * 256 + 4 * lane), lb = *(const f32x4*)(P->in[14] + l * 256 + 4 * lane);
    const bf16* GLU = (const bf16*)(ws + WS_GLU); bf16* MX = (bf16*)(ws + WS_MIX);
    const LAS f32x4* cw = (const LAS f32x4*)cwL + lane;
    for (int tile = first; tile < 528; tile += stride) {
        const int row0 = 64 * tile + 8 * wave;
        const int grow0 = (tile >= 512) ? (GLU_SROW0 + (tile - 512) * 94 + 8 * wave) : ((tile >> 7) * GLU_PB + (tile & 127) * 64 + 8 * wave);
        f32x4 acc[8];
#pragma unroll
        for (int tt = 0; tt < 8; ++tt) acc[tt] = cb;
        u32x2 xr[38];
#pragma unroll
        for (int j = 0; j < 38; ++j) xr[j] = *(const u32x2*)(GLU + (size_t)(grow0 + j) * 256 + 4 * lane);
        __builtin_amdgcn_sched_barrier(0);
        f32x4 wv[31];
#pragma unroll
        for (int j = 0; j < 38; ++j) {
            const u32x2 w = xr[j];
            const f32x4 x = (f32x4){__builtin_bit_cast(float, w.x << 16), __builtin_bit_cast(float, w.x & 0xffff0000u), __builtin_bit_cast(float, w.y << 16), __builtin_bit_cast(float, w.y & 0xffff0000u)};
            if (j <= 30) wv[j] = cw[j * 64];
#pragma unroll
            for (int tt = 0; tt < 8; ++tt) { const int tap = j - tt; if (tap >= 0 && tap <= 30) acc[tt] += wv[tap] * x; }
            __builtin_amdgcn_sched_barrier(0);
        }
        float sm[8], sq[8];
#pragma unroll
        for (int tt = 0; tt < 8; ++tt) sm[tt] = (acc[tt][0] + acc[tt][1]) + (acc[tt][2] + acc[tt][3]);
#pragma unroll
        for (int o = 1; o < 64; o <<= 1)
#pragma unroll
            for (int tt = 0; tt < 8; ++tt) sm[tt] += __shfl_xor(sm[tt], o);
#pragma unroll
        for (int tt = 0; tt < 8; ++tt) { acc[tt] = acc[tt] - sm[tt] * (1.f / 256.f); sq[tt] = (acc[tt][0] * acc[tt][0] + acc[tt][1] * acc[tt][1]) + (acc[tt][2] * acc[tt][2] + acc[tt][3] * acc[tt][3]); }
#pragma unroll
        for (int o = 1; o < 64; o <<= 1)
#pragma unroll
            for (int tt = 0; tt < 8; ++tt) sq[tt] += __shfl_xor(sq[tt], o);
#pragma unroll
        for (int tt = 0; tt < 8; ++tt) {
            const float rstd = __builtin_amdgcn_rsqf(sq[tt] * (1.f / 256.f) + EPS);
            const f32x4 y = acc[tt] * rstd * lg + lb;
            u32x2 w; w.x = pk2(siluf_(y[0]), siluf_(y[1])); w.y = pk2(siluf_(y[2]), siluf_(y[3]));
            *(u32x2*)(MX + (size_t)(row0 + tt) * DM + 4 * lane) = w;
        }
    }
}

__global__ void __launch_bounds__(NWAVES * 64, 2) mega_fwd(Params Pk) {
    extern __shared__ __attribute__((aligned(16))) unsigned char lds_raw[];
    LAS unsigned char* lds = (LAS unsigned char*)lds_raw;
    cg::grid_group grid = cg::this_grid();
    const int tid = threadIdx.x, lane = tid & 63, wave = __builtin_amdgcn_readfirstlane(tid >> 6);
    constexpr int G = GRID_WG; const int bx = blockIdx.x;
    const int vb = (G % 8 == 0) ? (bx % 8) * (G / 8) + bx / 8 : bx;
    unsigned char* ws = kparams()->ws;
    float* ssq = (float*)(ws + WS_SSQ); LAS float* rsbuf = (LAS float*)(lds + RS_OFF);
    bf16* XB = (bf16*)(ws + WS_XB); bf16* AH = (bf16*)(ws + WS_A); bf16* MX = (bf16*)(ws + WS_MIX);

    if (tid < 4) ((LAS unsigned*)(lds + XB_OFF))[tid] = 0u;
    __syncthreads();
    const XcdBarrier xbar = xcd_barrier_post((unsigned*)(ws + WS_BAR), (volatile LAS unsigned*)(lds + XB_OFF));
#ifndef DIS_PRO
    for (int rep = 0; rep < REP_PRO; ++rep) { prologue(kparams(), lds, vb, G, wave, lane); __syncthreads(); }
#endif
    if (ws == nullptr) grid.sync();
    xcd_barrier(xbar);

#pragma unroll 1
    for (int l = 0; l < NL; ++l) {
        unsigned char* wl = ws + WS_W + (size_t)l * W_LAYER;
#pragma unroll 1
        for (int k = 0; k < 10; ++k) { const int st = (k < 6) ? k : (k == 6 ? 9 : k - 1);
            CPP P = kparams();
            int bxl = blockIdx.x; asm volatile("" : "+s"(bxl));
            unsigned* cnt = (unsigned*)(ws + WS_CNT) + 64 * (2 * l + ((st >= 5 && st != 9) ? 1 : 0));
            unsigned* cntO = (unsigned*)(ws + WS_CNT) + 64 * (4 + l);
            if (st == 0 || st == 6) {
                pg8::Gemm g{XB, (const bf16*)(wl + (st ? W_GU2 : W_GU1)), MROWS, 2 * DFF, DM};
                GuOrder S; S.init(MROWS, 2 * DFF, G, bxl); S.ssq = ssq; S.rsbuf = rsbuf; S.cnt = cnt; S.wait_cnt = st ? cntO : nullptr; S.samp_i = st ? 2 : 0;
                EpiSwiGLU E{AH, rsbuf};
                { int t_ = threadIdx.x; asm volatile("" : "+v"(t_)); rs_fill(S, ssq, rsbuf, t_); }
#ifndef DIS_GU
                pg8::gemm_phase<EpiSwiGLU, GuOrder, true, true>(lds, g, S, E);
#endif
            } else if (st == 1 || st == 2 || st == 5 || st == 7 || st == 8 || st == 9) {
                const bool first = (l == 0 && st <= 2), samp = (st == 1 || st == 7), isout = (st == 5 || st == 9);
                if (samp && bxl >= 240) {
                    if (threadIdx.x == 0) { unsigned sp = 0; while (__hip_atomic_load(cnt, __ATOMIC_RELAXED, __HIP_MEMORY_SCOPE_AGENT) < 88u && ++sp < (1u << 24)) __builtin_amdgcn_s_sleep(2);
                        __builtin_amdgcn_fence(__ATOMIC_ACQUIRE, "agent"); asm volatile("s_waitcnt vmcnt(0)" ::: "memory"); }
                    __syncthreads();
                }
                pg8::Gemm g{isout ? MX : AH, (const bf16*)(wl + (isout ? W_OUT : (st < 5 ? W_D1 : W_D2))), MROWS, DM, isout ? DM : DFF};
                RangeOrder S;
                S.pub = nullptr;
                if (samp) { S.init(NS, DM, 16, bxl - 240); S.pm0 = NP / 256; } else if (st == 9) { S.init(NS, DM, 16, (bxl >= 224 && bxl < 240) ? bxl - 224 : -1); S.pm0 = NP / 256; S.pub = cntO; } else { S.init(NP, DM, G, bxl); S.pm0 = 0; }
                const bool lastg = (l == NL - 1 && (st == 7 || st == 8));
                EpiResid E{first ? P->in[0] : nullptr, first ? P->in[1] : nullptr, lastg ? P->out : nullptr, XB, lastg ? nullptr : XB, ssq, isout ? 1.f : 0.5f};
#ifndef DIS_RES
                pg8::gemm_phase<EpiResid, RangeOrder, true, true>(lds, g, S, E);
#endif
            } else if (st == 3) {
                pg8::Gemm g{XB, (const bf16*)(wl + W_IN), MROWS, DIN, DM};
                { int t_ = threadIdx.x; asm volatile("" : "+v"(t_));
                  bf16* GLU = (bf16*)(ws + WS_GLU);
                  for (int i = bxl * (NWAVES * 64) + t_; i < 20 * 30 * 64; i += G * (NWAVES * 64)) {
                      const int c4 = i & 63, p = (i >> 6) % 30, sb = i / (64 * 30);
                      u32x2 w; w.x = 0u; w.y = 0u; int grow;
                      if (sb < 4) grow = sb * GLU_PB + p;
                      else { grow = GLU_SROW0 + (sb - 4) * 94 + p; const f32x4 c = *(const f32x4*)(P->in[2] + ((size_t)((l * 16 + (sb - 4)) * 30 + p)) * 256 + 4 * c4); w.x = pk2(c[0], c[1]); w.y = pk2(c[2], c[3]); }
                      *(u32x2*)(GLU + (size_t)grow * 256 + 4 * c4) = w; } }
                RsOrder S; S.init(MROWS, DIN, G, bxl); S.ssq = ssq; S.rsbuf = rsbuf;
                EpiMix E{rsbuf, P->in[19] + l * 64, P->in[20] + l * 64, ws, P->out, l, lds + VSCR_OFF};
                { int t_ = threadIdx.x; asm volatile("" : "+v"(t_)); rs_fill(S, ssq, rsbuf, t_); }
#ifndef DIS_IN
                pg8::gemm_phase<EpiMix, RsOrder, true, true>(lds, g, S, E);
#endif
                if (l == 0 && bxl >= 40) { int t_ = threadIdx.x; asm volatile("" : "+v"(t_)); convert_items(P, lds, PER_LAYER, 2 * PER_LAYER, bxl - 40, G - 40, __builtin_amdgcn_readfirstlane(t_ >> 6), t_ & 63);
                    convert_caches(P, 1, (bxl - 40) * (NWAVES * 64) + t_, (G - 40) * (NWAVES * 64)); }
            } else {
                for (int rep = 0; rep < REP_MIX; ++rep) {
                int tid_ = threadIdx.x; asm volatile("" : "+v"(tid_)); const int lane_ = tid_ & 63;
                LAS float* tblR = (LAS float*)(lds + BIAS_OFF) + wave * 260;
                for (int j = lane_; j < 256; j += 64) { const int rel = 191 - j; const int idx = (j == 255 || rel > 128) ? 256 : rel + 128; tblR[j] = (P->in[21][(size_t)(l * 8 + wave) * 257 + idx] - P->in[21][(size_t)(l * 8 + wave) * 257 + 256]) * LOG2E; }
                { LAS float* cwL0 = (LAS float*)(lds + CW_OFF);
                  for (int i = tid_; i < 31 * 256; i += NWAVES * 64) cwL0[i] = P->in[11][(size_t)l * 31 * 256 + i]; }
                asm volatile("s_waitcnt lgkmcnt(0)" ::: "memory");
                __syncthreads();
#ifndef DIS_ATTN
                const int vbm = (bxl % 8) * (G / 8) + bxl / 8;
                for (int sl = vbm; sl < 512; sl += G) {
                    int u0, u1 = 0, nu = 1;
                    if (sl < 480) u0 = (sl / 120) * 128 + 8 + (sl % 120);
                    else if (sl < 496) u0 = 512 + (sl - 480);
                    else { const int q = sl - 496, ub = (q >> 2) * 128, c1 = q & 3; u0 = ub + c1; u1 = ub + 7 - c1; nu = 2; }
#pragma unroll 1
                    for (int k = 0; k < nu; ++k) attn_unit(P, l, k ? u1 : u0, wave, lane_, tblR);
                }
#endif
                const int R = G, jr = bxl;
#ifndef DIS_GMLP
                if (jr >= 0) for (int k = jr; k < 272; k += R) gmlp_unit(P, l, k, wave, lane_, (LAS bf16*)lds);
#endif
#ifndef DIS_CONV
                { LAS float* cwL = (LAS float*)(lds + CW_OFF);
                  if (jr >= 0) conv_units(P, l, R - 1 - jr, R, wave, lane_, cwL); }
#endif
                __syncthreads(); }
            }
            if (!(l == NL - 1 && st == 8) && st != 0 && st != 6 && st != 9) for (int rep = 0; rep < REP_SYNC; ++rep) xcd_barrier(xbar);
        }
    }
}

extern "C" void kernel_launch(void* const* d_in, const int* in_sizes, int n_in, void* d_out, int out_size, void* d_ws, size_t ws_size, hipStream_t stream) {
    static int grid = 0;
    if (grid == 0) {
        if (n_in != 27 || (size_t)out_size != O_END || ws_size < WS_END) { fprintf(stderr, "kernel_launch: unexpected shapes n_in %d out %d ws %zu\n", n_in, out_size, ws_size); grid = -1; return; }
        int dev = 0, cus = 0, per_cu = 0;
        (void)hipGetDevice(&dev); (void)hipDeviceGetAttribute(&cus, hipDeviceAttributeMultiprocessorCount, dev);
        if (hipFuncSetAttribute((const void*)mega_fwd, hipFuncAttributeMaxDynamicSharedMemorySize, LDS_BYTES) != hipSuccess) { fprintf(stderr, "kernel_launch: hipFuncSetAttribute failed\n"); grid = -1; return; }
        if (hipOccupancyMaxActiveBlocksPerMultiprocessor(&per_cu, (const void*)mega_fwd, NWAVES * 64, LDS_BYTES) != hipSuccess || per_cu < 1) { fprintf(stderr, "kernel_launch: occupancy query gave %d\n", per_cu); per_cu = 1; }
        (void)hipGetLastError();
        grid = cus * per_cu;
        if (grid != GRID_WG) { fprintf(stderr, "kernel_launch: this build is for a co-resident grid of %d workgroups, the device offers %d; nothing launched\n", GRID_WG, grid); grid = -1; return; }
        fprintf(stderr, "kernel_launch: grid %d (cus %d x %d)\n", grid, cus, per_cu);
    }
    if (grid < 0) return;
    if (hipMemsetAsync((char*)d_ws + WS_BAR, 0, 16384 + 4096, stream) != hipSuccess) { fprintf(stderr, "kernel_launch: memset failed\n"); return; }
    Params p{};
    for (int i = 0; i < 27; ++i) p.in[i] = (const float*)d_in[i];
    p.out = (float*)d_out; p.ws = (unsigned char*)d_ws;
    void* args[] = {&p};
    hipError_t e = hipLaunchCooperativeKernel((const void*)mega_fwd, dim3(grid), dim3(NWAVES * 64), args, LDS_BYTES, stream);
    if (e != hipSuccess) fprintf(stderr, "kernel_launch: cooperative launch failed: %s (grid %d)\n", hipGetErrorString(e), grid);
}
```

```cpp
#include <hip/hip_runtime.h>
#include <hip/hip_cooperative_groups.h>
#include <cstdio>
#include <cstdint>
namespace cg = cooperative_groups;
namespace pg8 {
#define PG8_LAS __attribute__((address_space(3)))
typedef unsigned short bf16_t;
typedef short bf16x8 __attribute__((ext_vector_type(8)));
typedef float f32x4 __attribute__((ext_vector_type(4)));
typedef unsigned u32x4 __attribute__((ext_vector_type(4)));
constexpr int BM = 256, BK = 64, HALF = 128, HTB = HALF * BK * 2  , STAGE_BYTES = 8 * HTB, NXCD = 8, WGM = 8;

__host__ __device__ __forceinline__ int lds_byte(int r, int c) { const int st = (r >> 4) * 2 + (c >> 5), rr = r & 15, cc = c & 31, ob = rr * 64 + cc * 2; return st * 1024 + (ob ^ (((ob >> 9) & 1) << 5)); }
__host__ __device__ __forceinline__ void stage_rc(int b, int& R, int& C) { const int st = b / 1024, sb = b % 1024, swz = sb ^ (((sb >> 9) & 1) << 5); R = (st >> 1) * 16 + swz / 64; C = (st & 1) * 32 + (swz % 64) / 2; }
__host__ __device__ __forceinline__ int perm32(int rho) { const int n = rho >> 4, i = rho & 15; return 8 * (i >> 2) + 4 * n + (i & 3); }

struct Unit { int pm, pn, idx; };
struct Gemm { const bf16_t* A; const bf16_t* Bt; int M, N, K; };

struct StaticOrder {
    int nM, nN, nwg, G, c;
    __host__ __device__ void init(int M, int N, int G_, int c_) { nM = M / BM; nN = N / BM; nwg = nM * nN; G = G_; c = c_; }
    __host__ __device__ bool next(int i, Unit& u) const {
        const int L = i * G + c; if (L >= nwg) return false;
        int wgid = (int)L; { const int q = nwg / NXCD, r = nwg % NXCD, xcd = wgid % NXCD, off = wgid / NXCD; wgid = (xcd < r ? xcd * (q + 1) : r * (q + 1) + (xcd - r) * q) + off; }
        const int nig = WGM * nN, gid = wgid / nig, fm = gid * WGM, gsz = (nM - fm) < WGM ? (nM - fm) : WGM;
        u.pm = fm + ((wgid % nig) % gsz); u.pn = (wgid % nig) / gsz; u.idx = i; return true;
    }
    __device__ __forceinline__ void a_ready(const Unit&) const {}
    __device__ __forceinline__ void done(const Unit&) const {}
};

__device__ __forceinline__ unsigned cvt_pk_bf16(float lo, float hi) { unsigned r; asm volatile("v_cvt_pk_bf16_f32 %0, %1, %2" : "=v"(r) : "v"(lo), "v"(hi)); return r; }
typedef float f32x2 __attribute__((ext_vector_type(2)));
__device__ __forceinline__ f32x2 gelu_pk(f32x2 v) {
    const f32x2 av = __builtin_elementwise_abs(v), d = av * 0.2316418882f + 1.0f;
    f32x2 t; t.x = __builtin_amdgcn_rcpf(d.x); t.y = __builtin_amdgcn_rcpf(d.y);
    f32x2 q = t * 0.5307027145f + (-0.7265760135f); q = q * t + 0.7107068705f; q = q * t + (-0.142248368f); q = q * t + 0.127414796f; q = q * t;
    const f32x2 s = (v * v) * (-0.72134752044f);
    f32x2 e; e.x = __builtin_amdgcn_exp2f(s.x); e.y = __builtin_amdgcn_exp2f(s.y);
    const f32x2 m = v * (q * e), r = v - m;
    f32x2 o; o.x = v.x < 0.f ? m.x : r.x; o.y = v.y < 0.f ? m.y : r.y; return o;
}

template <int ACT  > struct EpiBf16 {
    static constexpr bool PERM = true, AFTER_DRAIN = false; static_assert(ACT == 0 || ACT == 1, "EpiBf16: ACT is 0 (none) or 1 (gelu_pk)");
    bf16_t* O; int ldc; const float* bias; int split_cols; size_t split_stride; float scale0;
    __device__ __forceinline__ void operator()(const f32x4 (&acc)[2][2][4][2], const Unit& u, int wr, int wc, int fr, int fq) const {
        const int row0 = u.pm * BM + wr * 64 + fr; int colt = u.pn * BM; bf16_t* base = O;
        float sc = 1.f; if (split_cols) { const int t = colt / split_cols; base += (size_t)t * split_stride; colt -= t * split_cols; if (t == 0) sc = scale0; }
        const int col0 = colt + wc * 32 + 8 * fq, bcol0 = u.pn * BM + wc * 32 + 8 * fq;
        f32x4 bv[2][2];
#pragma unroll
        for (int bj = 0; bj < 2; ++bj)
#pragma unroll
            for (int n = 0; n < 2; ++n) bv[bj][n] = bias ? *(const f32x4*)(bias + bcol0 + bj * HALF + 4 * n) : (f32x4){0.f, 0.f, 0.f, 0.f};
#pragma unroll
        for (int ai = 0; ai < 2; ++ai)
#pragma unroll
            for (int m = 0; m < 4; ++m) { bf16_t* rowp = base + (size_t)(row0 + ai * HALF + m * 16) * ldc + col0;
#pragma unroll
                for (int bj = 0; bj < 2; ++bj) { f32x4 v0 = acc[ai][bj][m][0] + bv[bj][0], v1 = acc[ai][bj][m][1] + bv[bj][1];
                    if (ACT == 1) { f32x2 a = gelu_pk((f32x2){v0[0], v0[1]}), b = gelu_pk((f32x2){v0[2], v0[3]}), c = gelu_pk((f32x2){v1[0], v1[1]}), d = gelu_pk((f32x2){v1[2], v1[3]});
                        v0 = (f32x4){a.x, a.y, b.x, b.y}; v1 = (f32x4){c.x, c.y, d.x, d.y}; }
                    v0 = v0 * sc; v1 = v1 * sc; u32x4 w; w.x = cvt_pk_bf16(v0[0], v0[1]); w.y = cvt_pk_bf16(v0[2], v0[3]); w.z = cvt_pk_bf16(v1[0], v1[1]); w.w = cvt_pk_bf16(v1[2], v1[3]);
                    *(u32x4*)(rowp + bj * HALF) = w; } }
    }
};
template <class Epi, class Sched, bool ALIGN_EPI = false, bool SP2 = false>
__device__ __forceinline__ void gemm_phase(PG8_LAS unsigned char* lds, const Gemm g, const Sched& S, const Epi& E) {
    int tid_ = threadIdx.x; asm volatile("" : "+v"(tid_));
    const int tid = tid_, wid = __builtin_amdgcn_readfirstlane(tid >> 6), lane = tid & 63, wr = wid >> 2, wc = wid & 3, fr = lane & 15, fq = lane >> 4;
    const int K = g.K, nt = K / BK;
    unsigned voffA[2], voffB[2];
#pragma unroll
    for (int i = 0; i < 2; ++i) { int R, C; stage_rc(tid * 16 + i * 8192, R, C); const int Rb = Epi::PERM ? ((R & ~31) + perm32(R & 31)) : R;
        voffA[i] = (unsigned)(R * K + C) * 2u; voffB[i] = (unsigned)(Rb * K + C) * 2u; }
    const size_t kstep = (size_t)(BK * 2);
    const size_t hstep = (size_t)HALF * K * 2;
    const size_t tstep = 2 * hstep;
    const unsigned ldsw = (unsigned)wid * 1024u;
    const int aoff = lds_byte(wr * 64 + fr, fq * 8), boff = lds_byte(wc * 32 + fr, fq * 8);
#define PG8_SA(b, h) (((b) * 2 + (h)) * HTB)
#define PG8_SB(b, h) ((4 + (b) * 2 + (h)) * HTB)
#define PG8_STAGE(bufoff, gbase, voff) do { _Pragma("unroll") for (int _i = 0; _i < 2; ++_i) \
        __builtin_amdgcn_global_load_lds((const unsigned*)((const char*)(gbase) + (voff)[_i]), (PG8_LAS unsigned*)(lds + (bufoff) + ldsw + _i * 8192), 16, 0, 0); } while (0)
#define PG8_LDA(dst, b, h) do { _Pragma("unroll") for (int m = 0; m < 4; ++m) _Pragma("unroll") for (int k = 0; k < 2; ++k) dst[m][k] = *(const PG8_LAS bf16x8*)(lds + PG8_SA(b, h) + aoff + m * 2048 + k * 1024); } while (0)
#define PG8_LDB(dst, b, h) do { _Pragma("unroll") for (int n = 0; n < 2; ++n) _Pragma("unroll") for (int k = 0; k < 2; ++k) dst[n][k] = *(const PG8_LAS bf16x8*)(lds + PG8_SB(b, h) + boff + n * 2048 + k * 1024); } while (0)
#define PG8_MMA(ai, bj, At, Bt) do { __builtin_amdgcn_s_setprio(1); _Pragma("unroll") for (int m = 0; m < 4; ++m) _Pragma("unroll") for (int n = 0; n < 2; ++n) _Pragma("unroll") for (int k = 0; k < 2; ++k) \
        acc[ai][bj][m][n] = __builtin_amdgcn_mfma_f32_16x16x32_bf16(Bt[n][k], At[m][k], acc[ai][bj][m][n], 0, 0, 0); __builtin_amdgcn_s_setprio(0); } while (0)
#define PG8_WAIT_V(n) asm volatile("s_waitcnt vmcnt(" #n ")" ::: "memory")
#define PG8_WAIT_L(n) asm volatile("s_waitcnt lgkmcnt(" #n ")" ::: "memory")
#define PG8_BAR __builtin_amdgcn_s_barrier()
#define PG8_SCHED __builtin_amdgcn_sched_barrier(0)
    Unit cur, nxt; int ui = 0;
    if (!S.next(0, cur)) return;
    f32x4 acc[2][2][4][2];
#pragma unroll
    for (int a = 0; a < 2; ++a)
#pragma unroll
        for (int b = 0; b < 2; ++b)
#pragma unroll
            for (int m = 0; m < 4; ++m)
#pragma unroll
                for (int n = 0; n < 2; ++n) acc[a][b][m][n] = (f32x4){0.f, 0.f, 0.f, 0.f};
    bf16x8 At[4][2], B0[2][2], B1[2][2];
    const char* cA = (const char*)g.A + (size_t)cur.pm * tstep; const char* cB = (const char*)g.Bt + (size_t)cur.pn * tstep;
    S.a_ready(cur);
    if constexpr (SP2) {
        PG8_STAGE(PG8_SB(0, 0), cB, voffB); PG8_STAGE(PG8_SB(0, 1), cB + hstep, voffB); PG8_STAGE(PG8_SA(0, 0), cA, voffA); PG8_STAGE(PG8_SA(0, 1), cA + hstep, voffA);
        if (wr == 1) PG8_BAR;
        PG8_WAIT_V(2); PG8_BAR;
        PG8_STAGE(PG8_SB(1, 0), cB + kstep, voffB); PG8_STAGE(PG8_SA(1, 0), cA + kstep, voffA); PG8_STAGE(PG8_SB(1, 1), cB + hstep + kstep, voffB);
        PG8_WAIT_V(6); PG8_BAR;
    } else {
        PG8_STAGE(PG8_SB(0, 0), cB, voffB); PG8_STAGE(PG8_SA(0, 0), cA, voffA); PG8_STAGE(PG8_SB(0, 1), cB + hstep, voffB); PG8_STAGE(PG8_SA(0, 1), cA + hstep, voffA);
        if (wr == 1) PG8_BAR;
        PG8_WAIT_V(4); PG8_BAR;
        PG8_STAGE(PG8_SB(1, 0), cB + kstep, voffB); PG8_STAGE(PG8_SA(1, 0), cA + kstep, voffA); PG8_STAGE(PG8_SB(1, 1), cB + hstep + kstep, voffB);
        PG8_WAIT_V(6); PG8_BAR;
    }
    for (;;) {
        const bool has_next = S.next(ui + 1, nxt);
        const char* nA = has_next ? (const char*)g.A + (size_t)nxt.pm * tstep : cA; const char* nB = has_next ? (const char*)g.Bt + (size_t)nxt.pn * tstep : cB;
        for (int t = 0; t < nt; t += 2) {
            const bool last = (t == nt - 2);
            const char* a1 = cA + (size_t)(t + 1) * kstep;
            const char* a2 = last ? nA : cA + (size_t)(t + 2) * kstep; const char* b2 = last ? nB : cB + (size_t)(t + 2) * kstep;
            const char* a3 = a2 + kstep; const char* b3 = b2 + kstep;
            if (last && has_next) S.a_ready(nxt);
            if constexpr (SP2) {
            PG8_LDB(B0, 0, 0); PG8_LDB(B1, 0, 1); PG8_SCHED; PG8_LDA(At, 0, 0); PG8_STAGE(PG8_SA(1, 1), a1 + hstep, voffA);
            PG8_WAIT_V(8); PG8_WAIT_L(0); PG8_BAR; PG8_MMA(0, 0, At, B0); PG8_MMA(0, 1, At, B1); PG8_BAR; PG8_SCHED;
            PG8_LDA(At, 0, 1); PG8_STAGE(PG8_SB(0, 0), b2, voffB); PG8_STAGE(PG8_SB(0, 1), b2 + hstep, voffB); PG8_STAGE(PG8_SA(0, 0), a2, voffA);
            PG8_WAIT_V(8); PG8_WAIT_L(0); PG8_BAR; PG8_MMA(1, 0, At, B0); PG8_MMA(1, 1, At, B1); PG8_BAR; PG8_SCHED;
            PG8_LDB(B0, 1, 0); PG8_LDB(B1, 1, 1); PG8_SCHED; PG8_LDA(At, 1, 0); PG8_STAGE(PG8_SA(0, 1), a2 + hstep, voffA);
            PG8_WAIT_V(8); PG8_WAIT_L(0); PG8_BAR; PG8_MMA(0, 0, At, B0); PG8_MMA(0, 1, At, B1); PG8_BAR; PG8_SCHED;
            PG8_LDA(At, 1, 1); PG8_STAGE(PG8_SB(1, 0), b3, voffB); PG8_STAGE(PG8_SB(1, 1), b3 + hstep, voffB); PG8_STAGE(PG8_SA(1, 0), a3, voffA);
            PG8_WAIT_V(8); PG8_WAIT_L(0); PG8_BAR; PG8_MMA(1, 0, At, B0); PG8_MMA(1, 1, At, B1); PG8_BAR; PG8_SCHED;
            } else {
            PG8_LDB(B0, 0, 0); PG8_SCHED; PG8_LDA(At, 0, 0); PG8_STAGE(PG8_SA(1, 1), a1 + hstep, voffA);
            PG8_WAIT_L(8); PG8_BAR; PG8_WAIT_L(0); PG8_MMA(0, 0, At, B0); PG8_BAR; PG8_SCHED;
            PG8_LDB(B1, 0, 1); PG8_STAGE(PG8_SB(0, 0), b2, voffB);
            PG8_BAR; PG8_WAIT_L(0); PG8_MMA(0, 1, At, B1); PG8_BAR;
            PG8_LDA(At, 0, 1); PG8_STAGE(PG8_SA(0, 0), a2, voffA);
            PG8_BAR; PG8_WAIT_L(0); PG8_MMA(1, 0, At, B0); PG8_BAR; PG8_SCHED;
            PG8_STAGE(PG8_SB(0, 1), b2 + hstep, voffB);
            PG8_WAIT_V(6); PG8_BAR; PG8_MMA(1, 1, At, B1); PG8_BAR;
            PG8_LDB(B0, 1, 0); PG8_SCHED; PG8_LDA(At, 1, 0); PG8_STAGE(PG8_SA(0, 1), a2 + hstep, voffA);
            PG8_WAIT_L(8); PG8_BAR; PG8_WAIT_L(0); PG8_MMA(0, 0, At, B0); PG8_BAR; PG8_SCHED;
            PG8_LDB(B1, 1, 1); PG8_STAGE(PG8_SB(1, 0), b3, voffB);
            PG8_BAR; PG8_WAIT_L(0); PG8_MMA(0, 1, At, B1); PG8_BAR;
            PG8_LDA(At, 1, 1); PG8_STAGE(PG8_SA(1, 0), a3, voffA);
            PG8_BAR; PG8_WAIT_L(0); PG8_MMA(1, 0, At, B0); PG8_BAR; PG8_SCHED;
            PG8_STAGE(PG8_SB(1, 1), b3 + hstep, voffB);
            PG8_WAIT_V(6); PG8_BAR; PG8_MMA(1, 1, At, B1); PG8_BAR;
            }
        }
        if constexpr (ALIGN_EPI) { if (wr == 0) PG8_BAR; }
        if constexpr (!Epi::AFTER_DRAIN) { E(acc, cur, wr, wc, fr, fq); S.done(cur); }
        if (!has_next) break;
#pragma unroll
        for (int a = 0; a < 2; ++a)
#pragma unroll
            for (int b = 0; b < 2; ++b)
#pragma unroll
                for (int m = 0; m < 4; ++m)
#pragma unroll
                    for (int n = 0; n < 2; ++n) acc[a][b][m][n] = (f32x4){0.f, 0.f, 0.f, 0.f};
        cur = nxt; cA = nA; cB = nB; ++ui;
        if constexpr (ALIGN_EPI) { if (wr == 1) PG8_BAR; }
    }
    PG8_WAIT_V(0);
    if constexpr (!ALIGN_EPI) { if (wr == 0) PG8_BAR; }
    PG8_BAR;
    if constexpr (Epi::AFTER_DRAIN) { E.fused(acc, cur, wr, wc, fr, fq, lds, wid, lane); S.done(cur); }
#undef PG8_SA
#undef PG8_SB
#undef PG8_STAGE
#undef PG8_LDA
#undef PG8_LDB
#undef PG8_MMA
#undef PG8_WAIT_V
#undef PG8_WAIT_L
#undef PG8_BAR
#undef PG8_SCHED
}
}
#define LAS __attribute__((address_space(3)))
#define XB_TMO      128
#define XB_XCNT(j)  (256  + 64 * (j))
#define XB_XSUB(j)  (1280 + 64 * (j))
#define XB_XGEN(j)  (2304 + 64 * (j))
#define XB_TOP      3328
#define XB_TOPGEN   3392
#define XCD_BAR_WORDS 3456
#define XB_SPIN_CAP (1u << 18)

__device__ __forceinline__ unsigned xb_ld(unsigned* p)              { return __hip_atomic_load(p, __ATOMIC_RELAXED, __HIP_MEMORY_SCOPE_AGENT); }
__device__ __forceinline__ unsigned xb_add(unsigned* p, unsigned v) { return __hip_atomic_fetch_add(p, v, __ATOMIC_RELAXED, __HIP_MEMORY_SCOPE_AGENT); }
__device__ __forceinline__ unsigned xb_xcc_id() { return (unsigned)__builtin_amdgcn_s_getreg((3 << 11) | 20) & 0xFu; }
#define XB_SPIN(cond, bar) do { unsigned _sp = 0; while (cond) { __builtin_amdgcn_s_sleep(1); \
    if ((++_sp & 255u) == 0u) { if (xb_ld(&(bar)[XB_TMO])) break; if (_sp > XB_SPIN_CAP) { atomicAdd(&(bar)[XB_TMO], 1u); break; } } } } while (0)

struct XcdBarrier {
    unsigned* bar; unsigned x;
    volatile LAS unsigned* st;
};

__device__ __forceinline__ XcdBarrier xcd_barrier_post(unsigned* bar, volatile LAS unsigned* st) {
    XcdBarrier b; b.bar = bar; b.x = xb_xcc_id(); b.st = st;
    if (threadIdx.x == 0) (void)xb_add(&bar[XB_XCNT(b.x)], 1u);
    return b;
}
__device__ __forceinline__ void xcd_barrier_complete(unsigned* bar, unsigned x, unsigned& nloc, unsigned& nx) {
    const unsigned G = gridDim.x * gridDim.y * gridDim.z;
    unsigned sum, cnt, mine, sp = 0u;
    for (;;) {
        sum = 0u; cnt = 0u; mine = 0u;
#pragma unroll
        for (unsigned j = 0; j < 16; ++j) { const unsigned c = xb_ld(&bar[XB_XCNT(j)]); sum += c; cnt += (c > 0u) ? 1u : 0u; mine = (j == x) ? c : mine; }
        if (sum == G) break;
        __builtin_amdgcn_s_sleep(1);
        if ((++sp & 255u) == 0u) { if (xb_ld(&bar[XB_TMO])) break; if (sp > XB_SPIN_CAP) { atomicAdd(&bar[XB_TMO], 1u); break; } }
    }
    nloc = mine > 0u ? mine : 1u; nx = cnt > 0u ? cnt : 1u;
}

__device__ __forceinline__ void xcd_barrier(const XcdBarrier& b) {
    asm volatile("s_waitcnt vmcnt(0)" ::: "memory");
    __syncthreads();
    if (threadIdx.x == 0) {
        unsigned* bar = b.bar; const unsigned bx_ = xb_xcc_id();
        __builtin_amdgcn_s_waitcnt(0);
        unsigned nloc = b.st[0], nx = b.st[1];
        if (nloc == 0u) { xcd_barrier_complete(bar, bx_, nloc, nx); b.st[0] = nloc; b.st[1] = nx; }
        const unsigned old = xb_add(&bar[XB_XSUB(bx_)], 1u);
        const unsigned gen = old / nloc;
        if (old + 1u == (gen + 1u) * nloc) {
            __builtin_amdgcn_fence(__ATOMIC_RELEASE, "agent");
            asm volatile("s_waitcnt vmcnt(0)" ::: "memory");
            const unsigned og = xb_add(&bar[XB_TOP], 1u);
            const unsigned tg = og / nx;
            if (og + 1u == (tg + 1u) * nx) xb_add(&bar[XB_TOPGEN], 1u);
            else XB_SPIN(xb_ld(&bar[XB_TOPGEN]) == tg, bar);
            __builtin_amdgcn_fence(__ATOMIC_ACQUIRE, "agent");
            xb_add(&bar[XB_XGEN(bx_)], 1u);
            asm volatile("s_waitcnt vmcnt(0)" ::: "memory");
        } else {
            XB_SPIN(xb_ld(&bar[XB_XGEN(bx_)]) == gen, bar);
            __builtin_amdgcn_fence(__ATOMIC_ACQUIRE, "agent");
            asm volatile("s_waitcnt vmcnt(0)" ::: "memory");
        }
    }
    __syncthreads();
}

#define GAS __attribute__((address_space(1)))
#define LAS __attribute__((address_space(3)))
typedef unsigned short bf16;
typedef float f32x4 __attribute__((ext_vector_type(4)));
typedef float f32x16 __attribute__((ext_vector_type(16)));
typedef short bf16x8 __attribute__((ext_vector_type(8)));
typedef short s16x4 __attribute__((ext_vector_type(4)));
typedef unsigned u32x4 __attribute__((ext_vector_type(4)));
typedef unsigned u32x2 __attribute__((ext_vector_type(2)));

#ifndef REP_MIX
#define REP_MIX 1
#endif
#ifndef REP_PRO
#define REP_PRO 1
#endif
#ifndef REP_SYNC
#define REP_SYNC 1
#endif
constexpr int NWAVES = 8;
constexpr int GRID_WG = 256;
constexpr int DM = 1024, NP = 32768, NS = 1024, MROWS = NP + NS, SEQ = 8192, DFF = 2816, DIN = 2560, NL = 2;
constexpr float EPS = 1e-6f;
constexpr float LOG2E = 1.4426950408889634f;
constexpr size_t MiB = 1u << 20;
constexpr size_t WS_W = 0;
constexpr size_t W_LAYER = 40 * MiB, W_GU1 = 0, W_D1 = 11 * MiB, W_IN = 16 * MiB + 512 * 1024, W_OUT = 21 * MiB + 512 * 1024, W_GU2 = 23 * MiB + 512 * 1024, W_D2 = 34 * MiB + 512 * 1024;
constexpr size_t WS_WTRIL = 80 * MiB;
constexpr size_t WS_BAR = 80 * MiB + 512 * 1024;
constexpr size_t WS_CNT = WS_BAR + 16384;
constexpr size_t WS_SSQ = 81 * MiB;
constexpr size_t WS_SK = 84 * MiB;
constexpr size_t WS_SVT = 102 * MiB;
constexpr size_t WS_XB = 120 * MiB;
constexpr size_t WS_MIX = 186 * MiB;
constexpr size_t WS_A = 252 * MiB;
constexpr size_t WS_GLU = WS_A, WS_U = WS_A + 17 * MiB, WS_VG = WS_A + 34 * MiB, WS_Q = WS_A + 51 * MiB, WS_PK = WS_A + 84 * MiB, WS_PVT = WS_A + 116 * MiB;
constexpr size_t WS_END = WS_A + 182 * MiB;
static_assert(WS_PVT + 32 * MiB <= WS_END, "overlay");
constexpr size_t O_YP = 0, O_YS = 33554432, O_PCS = O_YS + 1048576, O_PK = O_PCS + 61440, O_PV = O_PK + 2097152, O_SCS = O_PV + 2097152,
                 O_SK = O_SCS + 245760, O_SV = O_SK + 1048576, O_SG = O_SV + 1048576, O_END = O_SG + 524288;
constexpr int GLU_PB = SEQ + 30, GLU_SROW0 = 4 * GLU_PB;
constexpr int RING_BYTES = 131072, BIAS_OFF = RING_BYTES, RS_OFF = RING_BYTES + 8448, RS_UNITS = 12, XB_OFF = RS_OFF + RS_UNITS * 1024, VSCR_OFF = XB_OFF + 32, LDS_BYTES = 160256;

struct Params {
    const float* in[27];
    float* out; unsigned char* ws;
};
typedef const __attribute__((address_space(4))) Params* CPP;
__device__ __forceinline__ CPP kparams() { CPP q = (CPP)__builtin_amdgcn_kernarg_segment_ptr(); asm volatile("" : "+s"(q)); return q; }

__device__ __forceinline__ unsigned f2bf(float f) { unsigned u = __builtin_bit_cast(unsigned, f); return (u + 0x7fffu + ((u >> 16) & 1u)) >> 16; }
typedef __bf16 bf16x2_t __attribute__((ext_vector_type(2)));
typedef float f32x2_t __attribute__((ext_vector_type(2)));
__device__ __forceinline__ unsigned pk2(float lo, float hi) { const f32x2_t f = {lo, hi}; const bf16x2_t h = __builtin_convertvector(f, bf16x2_t); return __builtin_bit_cast(unsigned, h); }
__device__ __forceinline__ float bf2f(unsigned short b) { return __builtin_bit_cast(float, (unsigned)b << 16); }
__device__ __forceinline__ unsigned cvtpk(float lo, float hi) { return pk2(lo, hi); }
__device__ __forceinline__ float wave_sum(float v) {
#pragma unroll
    for (int o = 1; o < 64; o <<= 1) v += __shfl_xor(v, o);
    return v;
}
__device__ __forceinline__ float fast_exp2(float x) { return __builtin_amdgcn_exp2f(x); }
__device__ __forceinline__ float fast_rcp(float x) { return __builtin_amdgcn_rcpf(x); }
__device__ __forceinline__ float sigmoidf_(float x) { return fast_rcp(1.f + fast_exp2(-LOG2E * x)); }
__device__ __forceinline__ float siluf_(float x) { return x * sigmoidf_(x); }
__device__ __forceinline__ float gelu_tanh(float x) { const float t = 0.7978845608028654f * (x + 0.044715f * x * x * x); return x * sigmoidf_(2.f * t); }
__device__ __forceinline__ float row_rs(const float* ssq, int row) {
    const f32x4* p = (const f32x4*)(ssq + (size_t)row * 16);
    const f32x4 a = p[0], b = p[1], c = p[2], d = p[3];
    const f32x4 s = (a + b) + (c + d);
    return __builtin_amdgcn_rsqf(((s[0] + s[1]) + (s[2] + s[3])) * (1.f / 1024.f) + EPS);
}

struct RsOrder : pg8::StaticOrder {
    const float* ssq; LAS float* rsbuf;
    __device__ __forceinline__ void a_ready(const pg8::Unit&) const {}
};
template <class Sched>
__device__ __forceinline__ void rs_fill(const Sched& S, const float* ssq, LAS float* rsbuf, int tid) {
    int pms[RS_UNITS]; int nu = 0;
#pragma unroll
    for (int i = 0; i < RS_UNITS; ++i) { pg8::Unit u; const bool ok = S.next(i, u); pms[i] = ok ? u.pm : 0; nu += ok ? 1 : 0; }
    const int half = tid >> 8, rr = tid & 255;
#pragma unroll
    for (int b = 0; b < RS_UNITS / 2; b += 6) {
        f32x4 v[6][4];
#pragma unroll
        for (int k = 0; k < 6; ++k) { const int ui = 2 * (b + k) + half; const int pm = half ? pms[2 * (b + k) + 1] : pms[2 * (b + k)];
            const f32x4* p = (const f32x4*)(ssq + ((size_t)pm * 256 + rr) * 16);
            if (ui < nu) { v[k][0] = p[0]; v[k][1] = p[1]; v[k][2] = p[2]; v[k][3] = p[3]; } }
#pragma unroll
        for (int k = 0; k < 6; ++k) { const int ui = 2 * (b + k) + half;
            if (ui < nu) { const f32x4 s4 = (v[k][0] + v[k][1]) + (v[k][2] + v[k][3]); rsbuf[ui * 256 + rr] = __builtin_amdgcn_rsqf(((s4[0] + s4[1]) + (s4[2] + s4[3])) * (1.f / 1024.f) + EPS); } }
    }
    __syncthreads();
}
struct GuOrder : RsOrder {
    unsigned* cnt;
    const unsigned* wait_cnt;
    int samp_i;
    __device__ __forceinline__ bool next(int i, pg8::Unit& u) const {
        int L;
        if (c < 240) { L = i * 240 + c; if (L >= 2760) return false; }
        else { if (i >= 9) return false; L = 2760 + (c - 240) + 16 * i; }
        u.idx = i;
        const int s0 = 240 * samp_i;
        if (L >= s0 && L < s0 + 88) { const int q = L - s0; u.pm = 128 + q / 22; u.pn = q % 22; return true; }
        int wgid = (L < s0) ? L : L - 88; { const int xcd = wgid % 8, off = wgid / 8; wgid = xcd * 352 + off; }
        const int gid = wgid / 176, rem = wgid % 176;
        u.pm = gid * 8 + (rem % 8); u.pn = rem / 8; return true;
    }
    __device__ __forceinline__ void a_ready(const pg8::Unit& u) const {
        if (wait_cnt != nullptr && u.pm >= 128) {
            if (threadIdx.x < 64) { unsigned sp = 0; while ((unsigned)__builtin_amdgcn_readfirstlane(__hip_atomic_load(wait_cnt, __ATOMIC_RELAXED, __HIP_MEMORY_SCOPE_AGENT)) < 16u && ++sp < (1u << 22)) __builtin_amdgcn_s_sleep(2);
                __builtin_amdgcn_fence(__ATOMIC_ACQUIRE, "agent"); }
            asm volatile("s_waitcnt vmcnt(0)" ::: "memory");
            __builtin_amdgcn_s_barrier();
            if (threadIdx.x < 256) rsbuf[u.idx * 256 + threadIdx.x] = row_rs(ssq, u.pm * 256 + threadIdx.x);
        }
    }
    __device__ __forceinline__ void done(const pg8::Unit& u) const {
        if (u.pm >= 128) {
            asm volatile("s_waitcnt vmcnt(0)" ::: "memory");
            __builtin_amdgcn_s_barrier();
            if (threadIdx.x == 0) { __builtin_amdgcn_fence(__ATOMIC_RELEASE, "agent"); asm volatile("s_waitcnt vmcnt(0)" ::: "memory");
                __hip_atomic_fetch_add(cnt, 1u, __ATOMIC_RELAXED, __HIP_MEMORY_SCOPE_AGENT); }
        }
    }
};
struct RangeOrder : pg8::StaticOrder {
    int pm0; unsigned* pub;
    __device__ __forceinline__ bool next(int i, pg8::Unit& u) const { if (c < 0) return false; if (!pg8::StaticOrder::next(i, u)) return false; u.pm += pm0; return true; }
    __device__ __forceinline__ void done(const pg8::Unit&) const {
        if (pub != nullptr) {
            asm volatile("s_waitcnt vmcnt(0)" ::: "memory");
            __builtin_amdgcn_s_barrier();
            if (threadIdx.x == 0) { __builtin_amdgcn_fence(__ATOMIC_RELEASE, "agent"); asm volatile("s_waitcnt vmcnt(0)" ::: "memory");
                __hip_atomic_fetch_add(pub, 1u, __ATOMIC_RELAXED, __HIP_MEMORY_SCOPE_AGENT); }
        }
    }
};
struct EpiSwiGLU {
    static constexpr bool PERM = true, AFTER_DRAIN = false;
    bf16* O; const LAS float* rsbuf;
    __device__ __forceinline__ void operator()(const pg8::f32x4 (&acc)[2][2][4][2], const pg8::Unit& u, int wr, int wc, int fr, int fq) const {
        const int row0 = u.pm * 256 + wr * 64 + fr, col0 = u.pn * 128 + wc * 32 + 8 * fq;
#pragma unroll
        for (int ai = 0; ai < 2; ++ai)
#pragma unroll
            for (int m = 0; m < 4; ++m) {
                const int row = row0 + ai * 128 + m * 16;
                const float rs = rsbuf[u.idx * 256 + (row & 255)];
                float h[8];
#pragma unroll
                for (int n = 0; n < 2; ++n)
#pragma unroll
                    for (int e = 0; e < 4; ++e) { const float g = acc[ai][0][m][n][e] * rs, up = acc[ai][1][m][n][e] * rs; h[4 * n + e] = siluf_(g) * up; }
                u32x4 w; w.x = cvtpk(h[0], h[1]); w.y = cvtpk(h[2], h[3]); w.z = cvtpk(h[4], h[5]); w.w = cvtpk(h[6], h[7]);
                *(u32x4*)(O + (size_t)row * DFF + col0) = w;
            }
    }
};
struct EpiResid {
    static constexpr bool PERM = true, AFTER_DRAIN = false;
    const float* bp; const float* bs; float* X; const bf16* XBr; bf16* XB; float* ssq; float alpha;
    __device__ __forceinline__ void operator()(const pg8::f32x4 (&acc)[2][2][4][2], const pg8::Unit& u, int wr, int wc, int fr, int fq) const {
        const int row0 = u.pm * 256 + wr * 64 + fr, col0 = u.pn * 256 + wc * 32 + 8 * fq;
        const float* base = (u.pm * 256 < NP) ? bp : (bs - (size_t)NP * DM);
        if (bp == nullptr) {
            u32x4 q[2][4][2];
#pragma unroll
            for (int ai = 0; ai < 2; ++ai)
#pragma unroll
                for (int m = 0; m < 4; ++m)
#pragma unroll
                    for (int bj = 0; bj < 2; ++bj) q[ai][m][bj] = *(const u32x4*)(XBr + (size_t)(row0 + ai * 128 + m * 16) * DM + col0 + bj * 128);
#pragma unroll
            for (int ai = 0; ai < 2; ++ai)
#pragma unroll
                for (int m = 0; m < 4; ++m) {
                    const int row = row0 + ai * 128 + m * 16;
                    float ss = 0.f;
#pragma unroll
                    for (int bj = 0; bj < 2; ++bj) {
                        const size_t off = (size_t)row * DM + col0 + bj * 128;
                        const u32x4 qq = q[ai][m][bj];
                        const f32x4 b0 = (f32x4){__builtin_bit_cast(float, qq.x << 16), __builtin_bit_cast(float, qq.x & 0xffff0000u), __builtin_bit_cast(float, qq.y << 16), __builtin_bit_cast(float, qq.y & 0xffff0000u)};
                        const f32x4 b1 = (f32x4){__builtin_bit_cast(float, qq.z << 16), __builtin_bit_cast(float, qq.z & 0xffff0000u), __builtin_bit_cast(float, qq.w << 16), __builtin_bit_cast(float, qq.w & 0xffff0000u)};
                        const f32x4 v0 = b0 + acc[ai][bj][m][0] * alpha, v1 = b1 + acc[ai][bj][m][1] * alpha;
                        if (X != nullptr) { *(f32x4*)(X + off) = v0; *(f32x4*)(X + off + 4) = v1; }
                        if (XB != nullptr) {
                            u32x4 w; w.x = cvtpk(v0[0], v0[1]); w.y = cvtpk(v0[2], v0[3]); w.z = cvtpk(v1[0], v1[1]); w.w = cvtpk(v1[2], v1[3]);
                            *(u32x4*)(XB + off) = w;
                            ss += (v0[0] * v0[0] + v0[1] * v0[1]) + (v0[2] * v0[2] + v0[3] * v0[3]) + (v1[0] * v1[0] + v1[1] * v1[1]) + (v1[2] * v1[2] + v1[3] * v1[3]); }
                    }
                    if (XB != nullptr) { ss += __shfl_xor(ss, 16); ss += __shfl_xor(ss, 32);
                        if (fq == 0) ssq[(size_t)row * 16 + 4 * u.pn + wc] = ss; }
                }
            return;
        }
#pragma unroll
        for (int ai = 0; ai < 2; ++ai) {
            f32x4 fb[4][2][2];
#pragma unroll
            for (int m = 0; m < 4; ++m)
#pragma unroll
                for (int bj = 0; bj < 2; ++bj) { const float* p = base + (size_t)(row0 + ai * 128 + m * 16) * DM + col0 + bj * 128; fb[m][bj][0] = *(const f32x4*)p; fb[m][bj][1] = *(const f32x4*)(p + 4); }
#pragma unroll
            for (int m = 0; m < 4; ++m) {
                const int row = row0 + ai * 128 + m * 16;
                float ss = 0.f;
#pragma unroll
                for (int bj = 0; bj < 2; ++bj) {
                    const size_t off = (size_t)row * DM + col0 + bj * 128;
                    const f32x4 v0 = fb[m][bj][0] + acc[ai][bj][m][0] * alpha, v1 = fb[m][bj][1] + acc[ai][bj][m][1] * alpha;
                    u32x4 w; w.x = cvtpk(v0[0], v0[1]); w.y = cvtpk(v0[2], v0[3]); w.z = cvtpk(v1[0], v1[1]); w.w = cvtpk(v1[2], v1[3]);
                    *(u32x4*)(XB + off) = w;
                    ss += (v0[0] * v0[0] + v0[1] * v0[1]) + (v0[2] * v0[2] + v0[3] * v0[3]) + (v1[0] * v1[0] + v1[1] * v1[1]) + (v1[2] * v1[2] + v1[3] * v1[3]);
                }
                ss += __shfl_xor(ss, 16); ss += __shfl_xor(ss, 32);
                if (fq == 0) ssq[(size_t)row * 16 + 4 * u.pn + wc] = ss;
            }
        }
    }
};
struct EpiMix {
    static constexpr bool PERM = true, AFTER_DRAIN = false;
    const LAS float* rsbuf; const float* qg; const float* kg; unsigned char* ws; float* out; int l; LAS unsigned char* vscr;
    __device__ __forceinline__ void operator()(const pg8::f32x4 (&acc)[2][2][4][2], const pg8::Unit& u, int wr, int wc, int fr, int fq) const {
        bf16* const GLU = (bf16*)(ws + WS_GLU); bf16* const U = (bf16*)(ws + WS_U); bf16* const VG = (bf16*)(ws + WS_VG); bf16* const Q = (bf16*)(ws + WS_Q);
        bf16* const PK = (bf16*)(ws + WS_PK); bf16* const PVT = (bf16*)(ws + WS_PVT);
        bf16* const SK = (bf16*)(ws + WS_SK) + (size_t)l * 16 * 576 * 512; bf16* const SVT = (bf16*)(ws + WS_SVT) + (size_t)l * 16 * 512 * 576;
        float* const o_pcs = out + O_PCS + (size_t)l * 4 * 30 * 256; float* const o_pk = out + O_PK + (size_t)l * 4 * 512 * 512; float* const o_pv = out + O_PV + (size_t)l * 4 * 512 * 512;
        float* const o_scs = out + O_SCS + (size_t)l * 16 * 30 * 256; float* const o_sk = out + O_SK + (size_t)l * 16 * 64 * 512; float* const o_sv = out + O_SV + (size_t)l * 16 * 64 * 512;
        const int row0 = u.pm * 256 + wr * 64 + fr, pn = u.pn;
        const bool samp = (u.pm * 256 >= NP);
        if (pn < 2) {
            const int ch0 = pn * 128 + wc * 32 + 8 * fq;
#pragma unroll
            for (int ai = 0; ai < 2; ++ai)
#pragma unroll
                for (int m = 0; m < 4; ++m) {
                    const int row = row0 + ai * 128 + m * 16; const float rs = rsbuf[u.idx * 256 + (row & 255)];
                    float h[8];
#pragma unroll
                    for (int n = 0; n < 2; ++n)
#pragma unroll
                        for (int e = 0; e < 4; ++e) h[4 * n + e] = (acc[ai][0][m][n][e] * rs) * sigmoidf_(acc[ai][1][m][n][e] * rs);
                    u32x4 w; w.x = cvtpk(h[0], h[1]); w.y = cvtpk(h[2], h[3]); w.z = cvtpk(h[4], h[5]); w.w = cvtpk(h[6], h[7]);
                    { const int grow = samp ? (GLU_SROW0 + ((row - NP) >> 6) * 94 + 30 + ((row - NP) & 63)) : ((row >> 13) * GLU_PB + 30 + (row & 8191));
                      *(u32x4*)(GLU + (size_t)grow * 256 + ch0) = w; }
                    float* dst = nullptr;
                    if (!samp) { const int b = row >> 13, t = row & 8191; if (t >= SEQ - 30) dst = o_pcs + ((size_t)(b * 30 + (t - (SEQ - 30)))) * 256 + ch0; }
                    else { const int rr = row - NP, b = rr >> 6, t = rr & 63; if (t >= 34) dst = o_scs + ((size_t)(b * 30 + (t - 34))) * 256 + ch0; }
                    if (dst) { *(f32x4*)dst = (f32x4){h[0], h[1], h[2], h[3]}; *(f32x4*)(dst + 4) = (f32x4){h[4], h[5], h[6], h[7]}; }
                }
        } else if (pn < 4) {
            bf16* O = (pn == 2) ? U : VG;
#pragma unroll
            for (int ai = 0; ai < 2; ++ai)
#pragma unroll
                for (int m = 0; m < 4; ++m) {
                    const int row = row0 + ai * 128 + m * 16; const float rs = rsbuf[u.idx * 256 + (row & 255)];
#pragma unroll
                    for (int bj = 0; bj < 2; ++bj) {
                        float h[8];
#pragma unroll
                        for (int n = 0; n < 2; ++n)
#pragma unroll
                            for (int e = 0; e < 4; ++e) h[4 * n + e] = gelu_tanh(acc[ai][bj][m][n][e] * rs);
                        u32x4 w; w.x = cvtpk(h[0], h[1]); w.y = cvtpk(h[2], h[3]); w.z = cvtpk(h[4], h[5]); w.w = cvtpk(h[6], h[7]);
                        *(u32x4*)(O + (size_t)row * 256 + bj * 128 + wc * 32 + 8 * fq) = w;
                    }
                }
        } else if (pn < 8) {
            const bool isq = pn < 6;
            const int head = 4 * ((pn - 4) & 1) + wc;
            const float* gp = isq ? qg : kg;
            const float sc = isq ? 0.125f * LOG2E : 1.f;
            float gn[2][8];
#pragma unroll
            for (int bj = 0; bj < 2; ++bj) { const f32x4 ga = *(const f32x4*)(gp + 32 * bj + 8 * fq) * sc, gb = *(const f32x4*)(gp + 32 * bj + 8 * fq + 4) * sc;
#pragma unroll
                for (int j = 0; j < 4; ++j) { gn[bj][j] = ga[j]; gn[bj][4 + j] = gb[j]; } }
#pragma unroll
            for (int ai = 0; ai < 2; ++ai)
#pragma unroll
                for (int m = 0; m < 4; ++m) {
                    const int row = row0 + ai * 128 + m * 16; const float rs = rsbuf[u.idx * 256 + (row & 255)];
                    float z[2][8]; float ss = 0.f;
#pragma unroll
                    for (int bj = 0; bj < 2; ++bj)
#pragma unroll
                        for (int n = 0; n < 2; ++n)
#pragma unroll
                            for (int e = 0; e < 4; ++e) { const float v = acc[ai][bj][m][n][e] * rs; z[bj][4 * n + e] = v; ss += v * v; }
                    ss += __shfl_xor(ss, 16); ss += __shfl_xor(ss, 32);
                    const float inv = __builtin_amdgcn_rsqf(ss * (1.f / 64.f) + EPS);
#pragma unroll
                    for (int bj = 0; bj < 2; ++bj)
#pragma unroll
                        for (int j = 0; j < 8; ++j) z[bj][j] = z[bj][j] * inv * gn[bj][j];
                    bf16* dstb; float* dstf = nullptr;
                    if (isq) dstb = Q + (size_t)row * 512 + head * 64;
                    else if (!samp) { dstb = PK + ((size_t)(head * 1024 + (row >> 5)) * 256 + (row & 31)) * 8; const int b = row >> 13, t = row & 8191; if (t >= SEQ - 512) dstf = o_pk + ((size_t)(b * 512 + (t - (SEQ - 512))) * 8 + head) * 64; }
                    else { const int rr = row - NP, b = rr >> 6, t = rr & 63; dstb = SK + (size_t)b * 294912 + ((size_t)(head * 18 + 16 + (t >> 5)) * 256 + (t & 31)) * 8; dstf = o_sk + ((size_t)(b * 64 + t) * 8 + head) * 64; }
#pragma unroll
                    for (int bj = 0; bj < 2; ++bj) {
                        u32x4 w; w.x = cvtpk(z[bj][0], z[bj][1]); w.y = cvtpk(z[bj][2], z[bj][3]); w.z = cvtpk(z[bj][4], z[bj][5]); w.w = cvtpk(z[bj][6], z[bj][7]);
                        *(u32x4*)(dstb + (isq ? 32 * bj + 8 * fq : ((2 * bj + (fq >> 1)) * 2 + (fq & 1)) * 256)) = w;
                        if (dstf) { *(f32x4*)(dstf + 32 * bj + 8 * fq) = (f32x4){z[bj][0], z[bj][1], z[bj][2], z[bj][3]}; *(f32x4*)(dstf + 32 * bj + 8 * fq + 4) = (f32x4){z[bj][4], z[bj][5], z[bj][6], z[bj][7]}; }
                    }
                }
        } else {
#pragma unroll
            for (int ai = 0; ai < 2; ++ai)
#pragma unroll
                for (int m = 0; m < 4; ++m) {
                    const int row = row0 + ai * 128 + m * 16; const float rs = rsbuf[u.idx * 256 + (row & 255)];
                    bf16* dstb; float* dstf = nullptr;
                    const int rowg = row - fr;
                    if (!samp) { dstb = PVT + (size_t)(rowg >> 5) * 2048 + ((rowg >> 4) & 1) * 512; const int b = row >> 13, t = row & 8191; if (t >= SEQ - 512) dstf = o_pv + (size_t)(b * 512 + (t - (SEQ - 512))) * 512; }
                    else { const int rr = rowg - NP, b = rr >> 6, t0 = rr & 63, t = (row - NP) & 63; dstb = SVT + (size_t)b * 294912 + (size_t)(16 + (t0 >> 5)) * 2048 + ((t0 >> 4) & 1) * 512; dstf = o_sv + (size_t)(b * 64 + t) * 512; }
                    const size_t hstride = samp ? (size_t)18 * 2048 : (size_t)1024 * 2048;
                    LAS unsigned short* sc = (LAS unsigned short*)(vscr + (wr * 4 + wc) * 1024);
                    const int ln = fq * 16 + fr;
#pragma unroll
                    for (int bj = 0; bj < 2; ++bj) {
                        const int c0 = (pn - 8) * 256 + bj * 128 + wc * 32 + 8 * fq;
                        float z[8];
#pragma unroll
                        for (int n = 0; n < 2; ++n)
#pragma unroll
                            for (int e = 0; e < 4; ++e) z[4 * n + e] = acc[ai][bj][m][n][e] * rs;
#pragma unroll
                        for (int j = 0; j < 8; j += 2) { const unsigned p = pk2(z[j], z[j + 1]); sc[(8 * fq + j) * 16 + fr] = (unsigned short)(p & 0xffffu); sc[(8 * fq + j + 1) * 16 + fr] = (unsigned short)(p >> 16); }
                        asm volatile("s_waitcnt lgkmcnt(0)" ::: "memory");
                        { const int ch = ln & 31, hx = ln >> 5;
                          const u32x2 lo = *(const LAS u32x2*)(sc + ch * 16 + 4 * hx), hh = *(const LAS u32x2*)(sc + ch * 16 + 8 + 4 * hx);
                          const int cw0 = (pn - 8) * 256 + bj * 128 + wc * 32;
                          u32x4 w; w.x = lo.x; w.y = lo.y; w.z = hh.x; w.w = hh.y;
                          *(u32x4*)(dstb + (size_t)(cw0 >> 6) * hstride + ((cw0 >> 5) & 1) * 1024 + hx * 256 + ch * 8) = w; }
                        asm volatile("s_waitcnt lgkmcnt(0)" ::: "memory");
                        if (dstf) { *(f32x4*)(dstf + c0) = (f32x4){z[0], z[1], z[2], z[3]}; *(f32x4*)(dstf + c0 + 4) = (f32x4){z[4], z[5], z[6], z[7]}; }
                    }
                }
        }
    }
};

struct TItem { const float* W; const float* gain; bf16* WT; int N, pitch, drow, k0, n0; };
__device__ __forceinline__ int win_dst_row(int n0) {
    if (n0 < 256) return 256 * (n0 >> 7) + (n0 & 127);
    if (n0 < 512) { const int ch = n0 - 256; return 256 * (ch >> 7) + 128 + (ch & 127); }
    if (n0 < 1024) return n0;
    if (n0 < 2048) { const int k = (n0 >= 1536); const int c = n0 - 1024 - 512 * k, head = c >> 6, d = c & 63; return 256 * (4 + 2 * k + (head >> 2)) + 128 * (d >> 5) + 32 * (head & 3) + (d & 31); }
    return n0;
}
constexpr int PER_LAYER = 10240, NW_ITEMS = NL * PER_LAYER, NV_ITEMS = 0, NT_ITEMS = NW_ITEMS + NV_ITEMS;
__device__ __forceinline__ TItem decode_item(CPP P, int it) {
    TItem d; unsigned char* ws = P->ws;
    if (it < NW_ITEMS) {
        const int l = it / PER_LAYER, r = it % PER_LAYER;
        unsigned char* wl = ws + WS_W + (size_t)l * W_LAYER;
        if (r < 8448) {
            const int mi = r / 1408, rr = r % 1408, ffn = mi / 3, kind = mi % 3;
            if (kind < 2) {
                const int nb = rr % 88, kb = rr / 88; d.n0 = 32 * nb; d.k0 = 64 * kb;
                d.W = P->in[(ffn ? 24 : 6) + kind] + (size_t)l * DM * DFF; d.gain = P->in[ffn ? 23 : 5] + l * DM; d.N = DFF;
                d.WT = (bf16*)(wl + (ffn ? W_GU2 : W_GU1)); d.pitch = DM; d.drow = 256 * (d.n0 >> 7) + 128 * kind + (d.n0 & 127);
            } else {
                const int nb = rr % 32, kb = rr / 32; d.n0 = 32 * nb; d.k0 = 64 * kb;
                d.W = P->in[ffn ? 26 : 8] + (size_t)l * DFF * DM; d.gain = nullptr; d.N = DM;
                d.WT = (bf16*)(wl + (ffn ? W_D2 : W_D1)); d.pitch = DFF; d.drow = d.n0;
            }
        } else if (r < 8448 + 1280) {
            const int rr = r - 8448, nb = rr % 80, kb = rr / 80; d.n0 = 32 * nb; d.k0 = 64 * kb;
            d.W = P->in[10] + (size_t)l * DM * DIN; d.gain = P->in[9] + l * DM; d.N = DIN; d.WT = (bf16*)(wl + W_IN); d.pitch = DM; d.drow = win_dst_row(d.n0);
        } else {
            const int rr = r - 8448 - 1280, nb = rr % 32, kb = rr / 32; d.n0 = 32 * nb; d.k0 = 64 * kb;
            d.W = P->in[22] + (size_t)l * DM * DM; d.gain = nullptr; d.N = DM; d.WT = (bf16*)(wl + W_OUT); d.pitch = DM; d.drow = d.n0;
        }
    } else {
        const int r = it - NW_ITEMS, lb = r >> 7, rr = r & 127, nb = rr & 15, kb = rr >> 4;
        d.n0 = 32 * nb; d.k0 = 64 * kb; d.W = P->in[4] + (size_t)lb * 512 * 512; d.gain = nullptr; d.N = 512;
        d.WT = (bf16*)(ws + WS_SVT) + (size_t)lb * 512 * 576; d.pitch = 576; d.drow = d.n0;
    }
    return d;
}
__device__ __forceinline__ void item_load(const TItem& d, int lane, float (&v)[32]) {
    const float* p = d.W + (size_t)(d.k0 + (lane >> 5)) * d.N + d.n0 + (lane & 31);
#pragma unroll
    for (int i = 0; i < 32; ++i) v[i] = p[(size_t)(2 * i) * d.N];
}
__device__ __forceinline__ void item_store(const TItem& d, int lane, const float (&v)[32], LAS float* scr) {
#pragma unroll
    for (int i = 0; i < 32; ++i) scr[(2 * i + (lane >> 5)) * 33 + (lane & 31)] = v[i];
    asm volatile("s_waitcnt lgkmcnt(0)" ::: "memory");
    const int c = lane & 7;
    f32x4 g0 = (f32x4){1.f, 1.f, 1.f, 1.f}, g1 = g0;
    if (d.gain) { g0 = *(const f32x4*)(d.gain + d.k0 + 8 * c); g1 = *(const f32x4*)(d.gain + d.k0 + 8 * c + 4); }
#pragma unroll
    for (int j = 0; j < 4; ++j) { const int n = (lane >> 3) + 8 * j; const LAS float* s = scr + (8 * c) * 33 + n;
        u32x4 o; o.x = pk2(s[0 * 33] * g0[0], s[1 * 33] * g0[1]); o.y = pk2(s[2 * 33] * g0[2], s[3 * 33] * g0[3]); o.z = pk2(s[4 * 33] * g1[0], s[5 * 33] * g1[1]); o.w = pk2(s[6 * 33] * g1[2], s[7 * 33] * g1[3]);
        *(u32x4*)(d.WT + (size_t)(d.drow + n) * d.pitch + d.k0 + 8 * c) = o; }
    asm volatile("s_waitcnt lgkmcnt(0)" ::: "memory");
}
__device__ __forceinline__ void convert_caches(CPP P, int l, int gt, int NGT) {
    unsigned char* ws = P->ws;
    bf16* SK = (bf16*)(ws + WS_SK); bf16* SV = (bf16*)(ws + WS_SVT);
    for (int i0 = gt; i0 < 16 * 512 * 64; i0 += 4 * NGT) {
        f32x4 a[4], b[4];
#pragma unroll
        for (int q = 0; q < 4; ++q) { const int i = i0 + q * NGT; const int ii = i < 16 * 512 * 64 ? i : i0; const int c8 = ii & 63, s_ = (ii >> 6) & 511, lb = l * 16 + (ii >> 15);
            const f32x4* srck = (const f32x4*)(P->in[3] + ((size_t)(lb * 512 + s_)) * 512 + 8 * c8); a[q] = srck[0]; b[q] = srck[1]; }
#pragma unroll
        for (int q = 0; q < 4; ++q) { const int i = i0 + q * NGT;
            if (i < 16 * 512 * 64) { const int c8 = i & 63, s_ = (i >> 6) & 511, lb = l * 16 + (i >> 15), head = c8 >> 3, d0 = (c8 & 7) * 8;
                u32x4 w; w.x = pk2(a[q][0], a[q][1]); w.y = pk2(a[q][2], a[q][3]); w.z = pk2(b[q][0], b[q][1]); w.w = pk2(b[q][2], b[q][3]);
                *(u32x4*)(SK + (size_t)lb * 294912 + (size_t)(head * 18 + (s_ >> 5)) * 2048 + ((((d0 >> 4) * 2 + ((d0 >> 3) & 1)) * 32) + (s_ & 31)) * 8) = w; } }
    }
    for (int i0 = gt; i0 < 16 * 64 * 512; i0 += 2 * NGT) {
        float v[2][8];
#pragma unroll
        for (int q = 0; q < 2; ++q) { const int i = i0 + q * NGT; const int ii = i < 16 * 64 * 512 ? i : i0; const int ch = ii & 511, kg = (ii >> 9) & 63, lb = l * 16 + (ii >> 15), kb = kg >> 2, sx = (kg >> 1) & 1, hx = kg & 1;
            const float* src = P->in[4] + ((size_t)(lb * 512 + 32 * kb + 16 * sx + 4 * hx)) * 512 + ch;
#pragma unroll
            for (int j = 0; j < 8; ++j) v[q][j] = src[(size_t)(8 * (j >> 2) + (j & 3)) * 512]; }
#pragma unroll
        for (int q = 0; q < 2; ++q) { const int i = i0 + q * NGT;
            if (i < 16 * 64 * 512) { const int ch = i & 511, kg = (i >> 9) & 63, lb = l * 16 + (i >> 15), kb = kg >> 2, sx = (kg >> 1) & 1, hx = kg & 1, head = ch >> 6, d = ch & 63;
                u32x4 w; w.x = pk2(v[q][0], v[q][1]); w.y = pk2(v[q][2], v[q][3]); w.z = pk2(v[q][4], v[q][5]); w.w = pk2(v[q][6], v[q][7]);
                *(u32x4*)(SV + (size_t)lb * 294912 + (size_t)(head * 18 + kb) * 2048 + (((((d >> 5) * 2 + sx) * 2 + hx) * 32) + (d & 31)) * 8) = w; } }
    }
}
__device__ __forceinline__ void convert_items(CPP P, LAS unsigned char* lds, int it0, int it1, int worker, int nworkers, int wave, int lane) {
    LAS float* scr = (LAS float*)(lds + wave * 16384);
    const int gw = it0 + worker * NWAVES + wave, NGW = nworkers * NWAVES;
    if (gw < it1) {
        TItem cur = decode_item(P, gw); float v[32]; item_load(cur, lane, v);
#pragma unroll 1
        for (int it = gw; it < it1; it += NGW) {
            const int nx = it + NGW; const bool has = nx < it1;
            TItem nd = decode_item(P, has ? nx : it); float vn[32];
            if (has) item_load(nd, lane, vn);
            item_store(cur, lane, v, scr);
            if (has) {
#pragma unroll
                for (int i = 0; i < 32; ++i) v[i] = vn[i];
                cur = nd; }
        }
    }
}
__device__ __forceinline__ void prologue(CPP P, LAS unsigned char* lds, int vb, int G, int wave, int lane) {
    LAS float* scr = (LAS float*)(lds + wave * 16384);
    const int gw = vb * NWAVES + wave, NGW = G * NWAVES;
    unsigned char* ws = P->ws;
    convert_items(P, lds, 0, PER_LAYER, vb, G, wave, lane);
    bf16* XB = (bf16*)(ws + WS_XB); float* ssq = (float*)(ws + WS_SSQ);
    for (int m0 = gw; m0 < MROWS; m0 += 4 * NGW) {
        f32x4 a[4][4];
#pragma unroll
        for (int q = 0; q < 4; ++q) { const int m = m0 + q * NGW; const int mm = m < MROWS ? m : m0;
            const float* xr = (mm < NP) ? P->in[0] + (size_t)mm * DM : P->in[1] + (size_t)(mm - NP) * DM;
#pragma unroll
            for (int j = 0; j < 4; ++j) a[q][j] = ((const f32x4*)xr)[lane + 64 * j]; }
#pragma unroll
        for (int q = 0; q < 4; ++q) { const int m = m0 + q * NGW;
            if (m < MROWS) { float s0 = 0.f;
#pragma unroll
                for (int j = 0; j < 4; ++j) { s0 += (a[q][j][0] * a[q][j][0] + a[q][j][1] * a[q][j][1]) + (a[q][j][2] * a[q][j][2] + a[q][j][3] * a[q][j][3]);
                    u32x2 w; w.x = pk2(a[q][j][0], a[q][j][1]); w.y = pk2(a[q][j][2], a[q][j][3]); ((u32x2*)(XB + (size_t)m * DM))[lane + 64 * j] = w; }
                s0 += __shfl_xor(s0, 16); s0 += __shfl_xor(s0, 32);
                if (lane < 16) ssq[(size_t)m * 16 + lane] = s0; } }
    }
    const int gt = vb * (NWAVES * 64) + wave * 64 + lane, NGT = G * NWAVES * 64;
    bf16* WT = (bf16*)(ws + WS_WTRIL);
    for (int i = gt; i < NL * 4 * 128 * 128; i += NGT) { const int s = i & 127, t = (i >> 7) & 127; WT[i] = (bf16)(s <= t ? f2bf(P->in[17][i]) : 0u); }
    convert_caches(P, 0, gt, NGT);
}

#define MFMA32(a, b, c) __builtin_amdgcn_mfma_f32_32x32x16_bf16((a), (b), (c), 0, 0, 0)
template <int KH>
__device__ __forceinline__ void attn_block(const bf16x8 (&Kf)[4], const bf16x8 (&Vf)[2][2], const bf16x8 (&Qf)[2][4], f32x16 (&O)[2][2], float (&mrun)[2], float (&lsum)[2],
                                           int delta, int r, int hi, const LAS float* tblR) {
    f32x16 S[2];
    if (delta >= 3) {
#pragma unroll
        for (int qb = 0; qb < 2; ++qb)
#pragma unroll
            for (int i = 0; i < 16; ++i) S[qb][i] = 0.f; }
    else {
#pragma unroll
        for (int qb = 0; qb < 2; ++qb) { const LAS float* tp = tblR + (191 - (64 * delta + (32 * qb + r) - (32 * KH + 4 * hi)));
#pragma unroll
            for (int i = 0; i < 16; ++i) S[qb][i] = tp[(i & 3) + 8 * (i >> 2)]; } }
#pragma unroll
    for (int kk = 0; kk < 4; ++kk)
#pragma unroll
        for (int qb = 0; qb < 2; ++qb) S[qb] = MFMA32(Kf[kk], Qf[qb][kk], S[qb]);
    float mx[2], mnew[2], alpha[2];
#pragma unroll
    for (int qb = 0; qb < 2; ++qb) { float m = fmaxf(fmaxf(S[qb][0], S[qb][1]), fmaxf(S[qb][2], S[qb][3]));
#pragma unroll
        for (int i = 4; i < 16; i += 2) m = fmaxf(m, fmaxf(S[qb][i], S[qb][i + 1]));
        mx[qb] = m; }
#pragma unroll
    for (int qb = 0; qb < 2; ++qb) mx[qb] = fmaxf(mx[qb], __shfl_xor(mx[qb], 32));
#pragma unroll
    for (int qb = 0; qb < 2; ++qb) { mnew[qb] = fmaxf(mrun[qb], mx[qb]); alpha[qb] = fast_exp2(mrun[qb] - mnew[qb]); mrun[qb] = mnew[qb]; }
#pragma unroll
    for (int i = 0; i < 16; ++i)
#pragma unroll
        for (int qb = 0; qb < 2; ++qb) S[qb][i] = fast_exp2(S[qb][i] - mnew[qb]);
#pragma unroll
    for (int qb = 0; qb < 2; ++qb) {
        const float ps = (((S[qb][0] + S[qb][1]) + (S[qb][2] + S[qb][3])) + ((S[qb][4] + S[qb][5]) + (S[qb][6] + S[qb][7]))) + (((S[qb][8] + S[qb][9]) + (S[qb][10] + S[qb][11])) + ((S[qb][12] + S[qb][13]) + (S[qb][14] + S[qb][15])));
        lsum[qb] = lsum[qb] * alpha[qb] + ps; }
    if (__builtin_amdgcn_ballot_w64(alpha[0] != 1.f || alpha[1] != 1.f) != 0ull) {
#pragma unroll
        for (int qb = 0; qb < 2; ++qb)
#pragma unroll
            for (int db = 0; db < 2; ++db)
#pragma unroll
                for (int i = 0; i < 16; ++i) O[db][qb][i] *= alpha[qb]; }
    bf16x8 Pf[2][2];
#pragma unroll
    for (int qb = 0; qb < 2; ++qb)
#pragma unroll
        for (int s = 0; s < 2; ++s) { u32x4 w; w.x = pk2(S[qb][8 * s], S[qb][8 * s + 1]); w.y = pk2(S[qb][8 * s + 2], S[qb][8 * s + 3]); w.z = pk2(S[qb][8 * s + 4], S[qb][8 * s + 5]); w.w = pk2(S[qb][8 * s + 6], S[qb][8 * s + 7]); Pf[qb][s] = __builtin_bit_cast(bf16x8, w); }
#pragma unroll
    for (int s = 0; s < 2; ++s)
#pragma unroll
        for (int qb = 0; qb < 2; ++qb)
#pragma unroll
            for (int db = 0; db < 2; ++db) O[db][qb] = MFMA32(Vf[db][s], Pf[qb][s], O[db][qb]);
}
__device__ __forceinline__ void attn_unit(CPP P, int l, int u, int wave, int lane, const LAS float* tblR) {
    unsigned char* ws = P->ws;
    const int h = wave, r = lane & 31, hi = lane >> 5;
    const bf16* Kb0; const bf16* Vb0; int ntiles, row0;
    int cm = 0;
    if (u < 512) { const int b = u >> 7, c = u & 127; cm = c % 9; row0 = b * SEQ + 64 * c; ntiles = (c < 8 ? c : 8) + 1; const int kbg0 = (row0 - 64 * (ntiles - 1)) >> 5;
        Kb0 = (const bf16*)(ws + WS_PK) + (size_t)(h * 1024 + kbg0) * 2048; Vb0 = (const bf16*)(ws + WS_PVT) + (size_t)(h * 1024 + kbg0) * 2048; }
    else { const int b = u - 512; row0 = NP + 64 * b; ntiles = 9;
        Kb0 = (const bf16*)(ws + WS_SK) + (size_t)(l * 16 + b) * 294912 + (size_t)(h * 18) * 2048; Vb0 = (const bf16*)(ws + WS_SVT) + (size_t)(l * 16 + b) * 294912 + (size_t)(h * 18) * 2048; }
    const bf16* Qp = (const bf16*)(ws + WS_Q) + (size_t)row0 * 512 + h * 64;
    bf16x8 Qf[2][4];
#pragma unroll
    for (int qb = 0; qb < 2; ++qb)
#pragma unroll
        for (int kk = 0; kk < 4; ++kk) Qf[qb][kk] = *(const bf16x8*)(Qp + (size_t)(32 * qb + r) * 512 + 16 * kk + 8 * hi);
    f32x16 O[2][2];
#pragma unroll
    for (int a = 0; a < 2; ++a)
#pragma unroll
        for (int b = 0; b < 2; ++b)
#pragma unroll
            for (int i = 0; i < 16; ++i) O[a][b][i] = 0.f;
    float mrun[2] = {-1e30f, -1e30f}, lsum[2] = {0.f, 0.f};
#define ATT_LOAD_K(kb_, Kd) do { const bf16* kp_ = Kb0 + (size_t)(kb_) * 2048 + (hi * 32 + r) * 8; \
        _Pragma("unroll") for (int kk = 0; kk < 4; ++kk) Kd[kk] = *(const bf16x8*)(kp_ + kk * 512); } while (0)
#define ATT_LOAD_V(kb_, Vd) do { const bf16* vp_ = Vb0 + (size_t)(kb_) * 2048 + (hi * 32 + r) * 8; \
        _Pragma("unroll") for (int db = 0; db < 2; ++db) _Pragma("unroll") for (int s_ = 0; s_ < 2; ++s_) Vd[db][s_] = *(const bf16x8*)(vp_ + (db * 2 + s_) * 512); } while (0)
    const bool full = (ntiles == 9);
#define ATT_TILE_OF(t_) (full ? 8 - ((cm - (t_) + 9) % 9) : (t_))
    bf16x8 K0[4], K1[4], Vc[2][2];
    int ti = ATT_TILE_OF(0);
    ATT_LOAD_K(2 * ti, K0);
#pragma unroll 1
    for (int t = 0; t < ntiles; ++t) {
        const int delta = (ntiles - 1) - ti;
        ATT_LOAD_K(2 * ti + 1, K1); ATT_LOAD_V(2 * ti, Vc);
        attn_block<0>(K0, Vc, Qf, O, mrun, lsum, delta, r, hi, tblR);
        const int tn = (t + 1 < ntiles) ? ATT_TILE_OF(t + 1) : ti;
        ATT_LOAD_K(2 * tn, K0); ATT_LOAD_V(2 * ti + 1, Vc);
        attn_block<1>(K1, Vc, Qf, O, mrun, lsum, delta, r, hi, tblR);
        ti = tn;
    }
#undef ATT_TILE_OF
#undef ATT_LOAD_K
#undef ATT_LOAD_V
    bf16* MX = (bf16*)(ws + WS_MIX);
#pragma unroll
    for (int qb = 0; qb < 2; ++qb) {
        const float lt = lsum[qb] + __shfl_xor(lsum[qb], 32), inv = 1.f / lt;
        bf16* orow = MX + (size_t)(row0 + 32 * qb + r) * DM + 512 + h * 64;
#pragma unroll
        for (int db = 0; db < 2; ++db)
#pragma unroll
            for (int g = 0; g < 4; ++g) { u32x2 w; w.x = pk2(O[db][qb][4 * g] * inv, O[db][qb][4 * g + 1] * inv); w.y = pk2(O[db][qb][4 * g + 2] * inv, O[db][qb][4 * g + 3] * inv);
                *(u32x2*)(orow + 32 * db + 8 * g + 4 * hi) = w; }
    }
}
constexpr int VPITCH = 136;
__device__ __forceinline__ void gmlp_unit(CPP P, int l, int g, int wave, int lane, LAS bf16* vnT) {
    unsigned char* ws = P->ws;
    const bool samp = g >= 256;
    const int row0 = samp ? NP + 64 * (g - 256) : 128 * g, T = samp ? 64 : 128;
    const bf16* VG = (const bf16*)(ws + WS_VG);
    const f32x4 gg = *(const f32x4*)(P->in[15] + l * 256 + 4 * lane), bb = *(const f32x4*)(P->in[16] + l * 256 + 4 * lane);
    const int h = wave >> 1, th = wave & 1, r = lane & 31, hi = lane >> 5;
    const int nks = (th == 0) ? 4 : 8;
    const bf16* Wp = (const bf16*)(ws + WS_WTRIL) + ((size_t)(l * 4 + h) * 128) * 128;
    bf16x8 Bw[8][2];
    if (64 * th < T) {
#pragma unroll
        for (int ks = 0; ks < 8; ++ks)
#pragma unroll
            for (int tb = 0; tb < 2; ++tb) if (ks < nks) Bw[ks][tb] = *(const bf16x8*)(Wp + (size_t)(64 * th + 32 * tb + r) * 128 + 16 * ks + 8 * hi);
    }
    {
        const int nq = T >> 3;
        u32x2 raw[16];
#pragma unroll
        for (int q = 0; q < 16; ++q) if (q < nq) raw[q] = *(const u32x2*)(VG + (size_t)(row0 + 4 * wave + 32 * (q >> 2) + (q & 3)) * 256 + 4 * lane);
        f32x4 x[16]; float sm[16], sq[16];
#pragma unroll
        for (int q = 0; q < 16; ++q) if (q < nq) { x[q] = (f32x4){__builtin_bit_cast(float, raw[q].x << 16), __builtin_bit_cast(float, raw[q].x & 0xffff0000u), __builtin_bit_cast(float, raw[q].y << 16), __builtin_bit_cast(float, raw[q].y & 0xffff0000u)};
            sm[q] = (x[q][0] + x[q][1]) + (x[q][2] + x[q][3]); }
#pragma unroll
        for (int o = 1; o < 64; o <<= 1)
#pragma unroll
            for (int q = 0; q < 16; ++q) if (q < nq) sm[q] += __shfl_xor(sm[q], o);
#pragma unroll
        for (int q = 0; q < 16; ++q) if (q < nq) { x[q] = x[q] - sm[q] * (1.f / 256.f); sq[q] = (x[q][0] * x[q][0] + x[q][1] * x[q][1]) + (x[q][2] * x[q][2] + x[q][3] * x[q][3]); }
#pragma unroll
        for (int o = 1; o < 64; o <<= 1)
#pragma unroll
            for (int q = 0; q < 16; ++q) if (q < nq) sq[q] += __shfl_xor(sq[q], o);
#pragma unroll
        for (int q = 0; q < 16; ++q) if (q < nq) { const float rstd = __builtin_amdgcn_rsqf(sq[q] * (1.f / 256.f) + EPS); const f32x4 y = x[q] * rstd * gg + bb; const int t = 4 * wave + 32 * (q >> 2) + (q & 3);
            if (samp) *(f32x4*)(P->out + O_SG + ((size_t)((l * 16 + (g - 256)) * 64 + t)) * 256 + 4 * lane) = y;
            const unsigned p01 = pk2(y[0], y[1]), p23 = pk2(y[2], y[3]);
            vnT[(4 * lane + 0) * VPITCH + t] = (bf16)(p01 & 0xffffu); vnT[(4 * lane + 1) * VPITCH + t] = (bf16)(p01 >> 16);
            vnT[(4 * lane + 2) * VPITCH + t] = (bf16)(p23 & 0xffffu); vnT[(4 * lane + 3) * VPITCH + t] = (bf16)(p23 >> 16); }
    }
    __syncthreads();
    if (64 * th < T) {
        f32x16 acc[2][2];
#pragma unroll
        for (int a = 0; a < 2; ++a)
#pragma unroll
            for (int b = 0; b < 2; ++b)
#pragma unroll
                for (int i = 0; i < 16; ++i) acc[a][b][i] = 0.f;
#pragma unroll
        for (int ks = 0; ks < 8; ++ks) if (ks < nks) {
            bf16x8 A[2];
#pragma unroll
            for (int db = 0; db < 2; ++db) A[db] = *(const LAS bf16x8*)(vnT + (h * 64 + 32 * db + r) * VPITCH + 16 * ks + 8 * hi);
#pragma unroll
            for (int db = 0; db < 2; ++db)
#pragma unroll
                for (int tb = 0; tb < 2; ++tb) acc[db][tb] = MFMA32(A[db], Bw[ks][tb], acc[db][tb]);
        }
        const bf16* U = (const bf16*)(ws + WS_U); bf16* MX = (bf16*)(ws + WS_MIX);
#pragma unroll
        for (int tb = 0; tb < 2; ++tb) {
            const int t = 64 * th + 32 * tb + r, row = row0 + t;
            const float bias = P->in[18][(l * 4 + h) * 128 + t];
#pragma unroll
            for (int db = 0; db < 2; ++db)
#pragma unroll
                for (int g4 = 0; g4 < 4; ++g4) { const int d = 32 * db + 8 * g4 + 4 * hi;
                    const u32x2 uu = *(const u32x2*)(U + (size_t)row * 256 + h * 64 + d);
                    const float u0 = __builtin_bit_cast(float, uu.x << 16), u1 = __builtin_bit_cast(float, uu.x & 0xffff0000u), u2 = __builtin_bit_cast(float, uu.y << 16), u3 = __builtin_bit_cast(float, uu.y & 0xffff0000u);
                    u32x2 w; w.x = pk2((acc[db][tb][4 * g4] + bias) * u0, (acc[db][tb][4 * g4 + 1] + bias) * u1); w.y = pk2((acc[db][tb][4 * g4 + 2] + bias) * u2, (acc[db][tb][4 * g4 + 3] + bias) * u3);
                    *(u32x2*)(MX + (size_t)row * DM + 256 + h * 64 + d) = w; }
        }
    }
    __syncthreads();
}
constexpr int CW_OFF = 73728;
__device__ __forceinline__ void conv_units(CPP P, int l, int first, int stride, int wave, int lane, const LAS float* cwL) {
    unsigned char* ws = P->ws;
    const f32x4 cb = *(const f32x4*)(P->in[12] + l * 256 + 4 * lane), lg = *(const f32x4*)(P->in[13] + l * 256 + 4 * lane), lb = *(const f32x4*)(P->in[14] + l * 256 + 4 * lane);
    const bf16* GLU = (const bf16*)(ws + WS_GLU); bf16* MX = (bf16*)(ws + WS_MIX);
    const LAS f32x4* cw = (const LAS f32x4*)cwL + lane;
    for (int tile = first; tile < 528; tile += stride) {
        const int row0 = 64 * tile + 8 * wave;
        const int grow0 = (tile >= 512) ? (GLU_SROW0 + (tile - 512) * 94 + 8 * wave) : ((tile >> 7) * GLU_PB + (tile & 127) * 64 + 8 * wave);
        f32x4 acc[8];
#pragma unroll
        for (int tt = 0; tt < 8; ++tt) acc[tt] = cb;
        u32x2 xr[38];
#pragma unroll
        for (int j = 0; j < 38; ++j) xr[j] = *(const u32x2*)(GLU + (size_t)(grow0 + j) * 256 + 4 * lane);
        __builtin_amdgcn_sched_barrier(0);
        f32x4 wv[31];
#pragma unroll
        for (int j = 0; j < 38; ++j) {
            const u32x2 w = xr[j];
            const f32x4 x = (f32x4){__builtin_bit_cast(float, w.x << 16), __builtin_bit_cast(float, w.x & 0xffff0000u), __builtin_bit_cast(float, w.y << 16), __builtin_bit_cast(float, w.y & 0xffff0000u)};
            if (j <= 30) wv[j] = cw[j * 64];
#pragma unroll
            for (int tt = 0; tt < 8; ++tt) { const int tap = j - tt; if (tap >= 0 && tap <= 30) acc[tt] += wv[tap] * x; }
            __builtin_amdgcn_sched_barrier(0);
        }
        float sm[8], sq[8];
#pragma unroll
        for (int tt = 0; tt < 8; ++tt) sm[tt] = (acc[tt][0] + acc[tt][1]) + (acc[tt][2] + acc[tt][3]);
#pragma unroll
        for (int o = 1; o < 64; o <<= 1)
#pragma unroll
            for (int tt = 0; tt < 8; ++tt) sm[tt] += __shfl_xor(sm[tt], o);
#pragma unroll
        for (int tt = 0; tt < 8; ++tt) { acc[tt] = acc[tt] - sm[tt] * (1.f / 256.f); sq[tt] = (acc[tt][0] * acc[tt][0] + acc[tt][1] * acc[tt][1]) + (acc[tt][2] * acc[tt][2] + acc[tt][3] * acc[tt][3]); }
#pragma unroll
        for (int o = 1; o < 64; o <<= 1)
#pragma unroll
            for (int tt = 0; tt < 8; ++tt) sq[tt] += __shfl_xor(sq[tt], o);
#pragma unroll
        for (int tt = 0; tt < 8; ++tt) {
            const float rstd = __builtin_amdgcn_rsqf(sq[tt] * (1.f / 256.f) + EPS);
            const f32x4 y = acc[tt] * rstd * lg + lb;
            u32x2 w; w.x = pk2(siluf_(y[0]), siluf_(y[1])); w.y = pk2(siluf_(y[2]), siluf_(y[3]));
            *(u32x2*)(MX + (size_t)(row0 + tt) * DM + 4 * lane) = w;
        }
    }
}

__global__ void __launch_bounds__(NWAVES * 64, 2) mega_fwd(Params Pk) {
    extern __shared__ __attribute__((aligned(16))) unsigned char lds_raw[];
    LAS unsigned char* lds = (LAS unsigned char*)lds_raw;
    cg::grid_group grid = cg::this_grid();
    const int tid = threadIdx.x, lane = tid & 63, wave = __builtin_amdgcn_readfirstlane(tid >> 6);
    constexpr int G = GRID_WG; const int bx = blockIdx.x;
    const int vb = (G % 8 == 0) ? (bx % 8) * (G / 8) + bx / 8 : bx;
    unsigned char* ws = kparams()->ws;
    float* ssq = (float*)(ws + WS_SSQ); LAS float* rsbuf = (LAS float*)(lds + RS_OFF);
    bf16* XB = (bf16*)(ws + WS_XB); bf16* AH = (bf16*)(ws + WS_A); bf16* MX = (bf16*)(ws + WS_MIX);

    if (tid < 4) ((LAS unsigned*)(lds + XB_OFF))[tid] = 0u;
    __syncthreads();
    const XcdBarrier xbar = xcd_barrier_post((unsigned*)(ws + WS_BAR), (volatile LAS unsigned*)(lds + XB_OFF));
#ifndef DIS_PRO
    for (int rep = 0; rep < REP_PRO; ++rep) { prologue(kparams(), lds, vb, G, wave, lane); __syncthreads(); }
#endif
    if (ws == nullptr) grid.sync();
    xcd_barrier(xbar);

#pragma unroll 1
    for (int l = 0; l < NL; ++l) {
        unsigned char* wl = ws + WS_W + (size_t)l * W_LAYER;
#pragma unroll 1
        for (int k = 0; k < 10; ++k) { const int st = (k < 6) ? k : (k == 6 ? 9 : k - 1);
            CPP P = kparams();
            int bxl = blockIdx.x; asm volatile("" : "+s"(bxl));
            unsigned* cnt = (unsigned*)(ws + WS_CNT) + 64 * (2 * l + ((st >= 5 && st != 9) ? 1 : 0));
            unsigned* cntO = (unsigned*)(ws + WS_CNT) + 64 * (4 + l);
            if (st == 0 || st == 6) {
                pg8::Gemm g{XB, (const bf16*)(wl + (st ? W_GU2 : W_GU1)), MROWS, 2 * DFF, DM};
                GuOrder S; S.init(MROWS, 2 * DFF, G, bxl); S.ssq = ssq; S.rsbuf = rsbuf; S.cnt = cnt; S.wait_cnt = st ? cntO : nullptr; S.samp_i = st ? 2 : 0;
                EpiSwiGLU E{AH, rsbuf};
                { int t_ = threadIdx.x; asm volatile("" : "+v"(t_)); rs_fill(S, ssq, rsbuf, t_); }
#ifndef DIS_GU
                pg8::gemm_phase<EpiSwiGLU, GuOrder, true, true>(lds, g, S, E);
#endif
            } else if (st == 1 || st == 2 || st == 5 || st == 7 || st == 8 || st == 9) {
                const bool first = (l == 0 && st <= 2), samp = (st == 1 || st == 7), isout = (st == 5 || st == 9);
                if (samp && bxl >= 240) {
                    if (threadIdx.x == 0) { unsigned sp = 0; while (__hip_atomic_load(cnt, __ATOMIC_RELAXED, __HIP_MEMORY_SCOPE_AGENT) < 88u && ++sp < (1u << 24)) __builtin_amdgcn_s_sleep(2);
                        __builtin_amdgcn_fence(__ATOMIC_ACQUIRE, "agent"); asm volatile("s_waitcnt vmcnt(0)" ::: "memory"); }
                    __syncthreads();
                }
                pg8::Gemm g{isout ? MX : AH, (const bf16*)(wl + (isout ? W_OUT : (st < 5 ? W_D1 : W_D2))), MROWS, DM, isout ? DM : DFF};
                RangeOrder S;
                S.pub = nullptr;
                if (samp) { S.init(NS, DM, 16, bxl - 240); S.pm0 = NP / 256; } else if (st == 9) { S.init(NS, DM, 16, (bxl >= 224 && bxl < 240) ? bxl - 224 : -1); S.pm0 = NP / 256; S.pub = cntO; } else { S.init(NP, DM, G, bxl); S.pm0 = 0; }
                const bool lastg = (l == NL - 1 && (st == 7 || st == 8));
                EpiResid E{first ? P->in[0] : nullptr, first ? P->in[1] : nullptr, lastg ? P->out : nullptr, XB, lastg ? nullptr : XB, ssq, isout ? 1.f : 0.5f};
#ifndef DIS_RES
                pg8::gemm_phase<EpiResid, RangeOrder, true, true>(lds, g, S, E);
#endif
            } else if (st == 3) {
                pg8::Gemm g{XB, (const bf16*)(wl + W_IN), MROWS, DIN, DM};
                { int t_ = threadIdx.x; asm volatile("" : "+v"(t_));
                  bf16* GLU = (bf16*)(ws + WS_GLU);
                  for (int i = bxl * (NWAVES * 64) + t_; i < 20 * 30 * 64; i += G * (NWAVES * 64)) {
                      const int c4 = i & 63, p = (i >> 6) % 30, sb = i / (64 * 30);
                      u32x2 w; w.x = 0u; w.y = 0u; int grow;
                      if (sb < 4) grow = sb * GLU_PB + p;
                      else { grow = GLU_SROW0 + (sb - 4) * 94 + p; const f32x4 c = *(const f32x4*)(P->in[2] + ((size_t)((l * 16 + (sb - 4)) * 30 + p)) * 256 + 4 * c4); w.x = pk2(c[0], c[1]); w.y = pk2(c[2], c[3]); }
                      *(u32x2*)(GLU + (size_t)grow * 256 + 4 * c4) = w; } }
                RsOrder S; S.init(MROWS, DIN, G, bxl); S.ssq = ssq; S.rsbuf = rsbuf;
                EpiMix E{rsbuf, P->in[19] + l * 64, P->in[20] + l * 64, ws, P->out, l, lds + VSCR_OFF};
                { int t_ = threadIdx.x; asm volatile("" : "+v"(t_)); rs_fill(S, ssq, rsbuf, t_); }
#ifndef DIS_IN
                pg8::gemm_phase<EpiMix, RsOrder, true, true>(lds, g, S, E);
#endif
                if (l == 0 && bxl >= 40) { int t_ = threadIdx.x; asm volatile("" : "+v"(t_)); convert_items(P, lds, PER_LAYER, 2 * PER_LAYER, bxl - 40, G - 40, __builtin_amdgcn_readfirstlane(t_ >> 6), t_ & 63);
                    convert_caches(P, 1, (bxl - 40) * (NWAVES * 64) + t_, (G - 40) * (NWAVES * 64)); }
            } else {
                for (int rep = 0; rep < REP_MIX; ++rep) {
                int tid_ = threadIdx.x; asm volatile("" : "+v"(tid_)); const int lane_ = tid_ & 63;
                LAS float* tblR = (LAS float*)(lds + BIAS_OFF) + wave * 260;
                for (int j = lane_; j < 256; j += 64) { const int rel = 191 - j; const int idx = (j == 255 || rel > 128) ? 256 : rel + 128; tblR[j] = (P->in[21][(size_t)(l * 8 + wave) * 257 + idx] - P->in[21][(size_t)(l * 8 + wave) * 257 + 256]) * LOG2E; }
                { LAS float* cwL0 = (LAS float*)(lds + CW_OFF);
                  for (int i = tid_; i < 31 * 256; i += NWAVES * 64) cwL0[i] = P->in[11][(size_t)l * 31 * 256 + i]; }
                asm volatile("s_waitcnt lgkmcnt(0)" ::: "memory");
                __syncthreads();
#ifndef DIS_ATTN
                const int vbm = (bxl % 8) * (G / 8) + bxl / 8;
                if (wave >= 4) __builtin_amdgcn_s_sleep(24);
                for (int sl = vbm; sl < 512; sl += G) {
                    int u0, u1 = 0, nu = 1;
                    if (sl < 480) u0 = (sl / 120) * 128 + 8 + (sl % 120);
                    else if (sl < 496) u0 = 512 + (sl - 480);
                    else { const int q = sl - 496, ub = (q >> 2) * 128, c1 = q & 3; u0 = ub + c1; u1 = ub + 7 - c1; nu = 2; }
#pragma unroll 1
                    for (int k = 0; k < nu; ++k) attn_unit(P, l, k ? u1 : u0, wave, lane_, tblR);
                }
#endif
                const int R = G, jr = bxl;
#ifndef DIS_GMLP
                if (jr >= 0) for (int k = jr; k < 272; k += R) gmlp_unit(P, l, k, wave, lane_, (LAS bf16*)lds);
#endif
#ifndef DIS_CONV
                { LAS float* cwL = (LAS float*)(lds + CW_OFF);
                  if (jr >= 0) conv_units(P, l, R - 1 - jr, R, wave, lane_, cwL); }
#endif
                __syncthreads(); }
            }
            if (!(l == NL - 1 && st == 8) && st != 0 && st != 6 && st != 9) for (int rep = 0; rep < REP_SYNC; ++rep) xcd_barrier(xbar);
        }
    }
}

extern "C" void kernel_launch(void* const* d_in, const int* in_sizes, int n_in, void* d_out, int out_size, void* d_ws, size_t ws_size, hipStream_t stream) {
    static int grid = 0;
    if (grid == 0) {
        if (n_in != 27 || (size_t)out_size != O_END || ws_size < WS_END) { fprintf(stderr, "kernel_launch: unexpected shapes n_in %d out %d ws %zu\n", n_in, out_size, ws_size); grid = -1; return; }
        int dev = 0, cus = 0, per_cu = 0;
        (void)hipGetDevice(&dev); (void)hipDeviceGetAttribute(&cus, hipDeviceAttributeMultiprocessorCount, dev);
        if (hipFuncSetAttribute((const void*)mega_fwd, hipFuncAttributeMaxDynamicSharedMemorySize, LDS_BYTES) != hipSuccess) { fprintf(stderr, "kernel_launch: hipFuncSetAttribute failed\n"); grid = -1; return; }
        if (hipOccupancyMaxActiveBlocksPerMultiprocessor(&per_cu, (const void*)mega_fwd, NWAVES * 64, LDS_BYTES) != hipSuccess || per_cu < 1) { fprintf(stderr, "kernel_launch: occupancy query gave %d\n", per_cu); per_cu = 1; }
        (void)hipGetLastError();
        grid = cus * per_cu;
        if (grid != GRID_WG) { fprintf(stderr, "kernel_launch: this build is for a co-resident grid of %d workgroups, the device offers %d; nothing launched\n", GRID_WG, grid); grid = -1; return; }
        fprintf(stderr, "kernel_launch: grid %d (cus %d x %d)\n", grid, cus, per_cu);
    }
    if (grid < 0) return;
    if (hipMemsetAsync((char*)d_ws + WS_BAR, 0, 16384 + 4096, stream) != hipSuccess) { fprintf(stderr, "kernel_launch: memset failed\n"); return; }
    Params p{};
    for (int i = 0; i < 27; ++i) p.in[i] = (const float*)d_in[i];
    p.out = (float*)d_out; p.ws = (unsigned char*)d_ws;
    void* args[] = {&p};
    hipError_t e = hipLaunchCooperativeKernel((const void*)mega_fwd, dim3(grid), dim3(NWAVES * 64), args, LDS_BYTES, stream);
    if (e != hipSuccess) fprintf(stderr, "kernel_launch: cooperative launch failed: %s (grid %d)\n", hipGetErrorString(e), grid);
}
```

```cpp
#include <hip/hip_runtime.h>
#include <hip/hip_cooperative_groups.h>
#include <cstdio>
#include <cstdint>
namespace cg = cooperative_groups;
namespace pg8 {
#define PG8_LAS __attribute__((address_space(3)))
typedef unsigned short bf16_t;
typedef short bf16x8 __attribute__((ext_vector_type(8)));
typedef float f32x4 __attribute__((ext_vector_type(4)));
typedef unsigned u32x4 __attribute__((ext_vector_type(4)));
constexpr int BM = 256, BK = 64, HALF = 128, HTB = HALF * BK * 2  , STAGE_BYTES = 8 * HTB, NXCD = 8, WGM = 8;

__host__ __device__ __forceinline__ int lds_byte(int r, int c) { const int st = (r >> 4) * 2 + (c >> 5), rr = r & 15, cc = c & 31, ob = rr * 64 + cc * 2; return st * 1024 + (ob ^ (((ob >> 9) & 1) << 5)); }
__host__ __device__ __forceinline__ void stage_rc(int b, int& R, int& C) { const int st = b / 1024, sb = b % 1024, swz = sb ^ (((sb >> 9) & 1) << 5); R = (st >> 1) * 16 + swz / 64; C = (st & 1) * 32 + (swz % 64) / 2; }
__host__ __device__ __forceinline__ int perm32(int rho) { const int n = rho >> 4, i = rho & 15; return 8 * (i >> 2) + 4 * n + (i & 3); }

struct Unit { int pm, pn, idx; };
struct Gemm { const bf16_t* A; const bf16_t* Bt; int M, N, K; };

struct StaticOrder {
    int nM, nN, nwg, G, c;
    __host__ __device__ void init(int M, int N, int G_, int c_) { nM = M / BM; nN = N / BM; nwg = nM * nN; G = G_; c = c_; }
    __host__ __device__ bool next(int i, Unit& u) const {
        const int L = i * G + c; if (L >= nwg) return false;
        int wgid = (int)L; { const int q = nwg / NXCD, r = nwg % NXCD, xcd = wgid % NXCD, off = wgid / NXCD; wgid = (xcd < r ? xcd * (q + 1) : r * (q + 1) + (xcd - r) * q) + off; }
        const int nig = WGM * nN, gid = wgid / nig, fm = gid * WGM, gsz = (nM - fm) < WGM ? (nM - fm) : WGM;
        u.pm = fm + ((wgid % nig) % gsz); u.pn = (wgid % nig) / gsz; u.idx = i; return true;
    }
    __device__ __forceinline__ void a_ready(const Unit&) const {}
    __device__ __forceinline__ void done(const Unit&) const {}
};

__device__ __forceinline__ unsigned cvt_pk_bf16(float lo, float hi) { unsigned r; asm volatile("v_cvt_pk_bf16_f32 %0, %1, %2" : "=v"(r) : "v"(lo), "v"(hi)); return r; }
typedef float f32x2 __attribute__((ext_vector_type(2)));
__device__ __forceinline__ f32x2 gelu_pk(f32x2 v) {
    const f32x2 av = __builtin_elementwise_abs(v), d = av * 0.2316418882f + 1.0f;
    f32x2 t; t.x = __builtin_amdgcn_rcpf(d.x); t.y = __builtin_amdgcn_rcpf(d.y);
    f32x2 q = t * 0.5307027145f + (-0.7265760135f); q = q * t + 0.7107068705f; q = q * t + (-0.142248368f); q = q * t + 0.127414796f; q = q * t;
    const f32x2 s = (v * v) * (-0.72134752044f);
    f32x2 e; e.x = __builtin_amdgcn_exp2f(s.x); e.y = __builtin_amdgcn_exp2f(s.y);
    const f32x2 m = v * (q * e), r = v - m;
    f32x2 o; o.x = v.x < 0.f ? m.x : r.x; o.y = v.y < 0.f ? m.y : r.y; return o;
}

template <int ACT  > struct EpiBf16 {
    static constexpr bool PERM = true, AFTER_DRAIN = false; static_assert(ACT == 0 || ACT == 1, "EpiBf16: ACT is 0 (none) or 1 (gelu_pk)");
    bf16_t* O; int ldc; const float* bias; int split_cols; size_t split_stride; float scale0;
    __device__ __forceinline__ void operator()(const f32x4 (&acc)[2][2][4][2], const Unit& u, int wr, int wc, int fr, int fq) const {
        const int row0 = u.pm * BM + wr * 64 + fr; int colt = u.pn * BM; bf16_t* base = O;
        float sc = 1.f; if (split_cols) { const int t = colt / split_cols; base += (size_t)t * split_stride; colt -= t * split_cols; if (t == 0) sc = scale0; }
        const int col0 = colt + wc * 32 + 8 * fq, bcol0 = u.pn * BM + wc * 32 + 8 * fq;
        f32x4 bv[2][2];
#pragma unroll
        for (int bj = 0; bj < 2; ++bj)
#pragma unroll
            for (int n = 0; n < 2; ++n) bv[bj][n] = bias ? *(const f32x4*)(bias + bcol0 + bj * HALF + 4 * n) : (f32x4){0.f, 0.f, 0.f, 0.f};
#pragma unroll
        for (int ai = 0; ai < 2; ++ai)
#pragma unroll
            for (int m = 0; m < 4; ++m) { bf16_t* rowp = base + (size_t)(row0 + ai * HALF + m * 16) * ldc + col0;
#pragma unroll
                for (int bj = 0; bj < 2; ++bj) { f32x4 v0 = acc[ai][bj][m][0] + bv[bj][0], v1 = acc[ai][bj][m][1] + bv[bj][1];
                    if (ACT == 1) { f32x2 a = gelu_pk((f32x2){v0[0], v0[1]}), b = gelu_pk((f32x2){v0[2], v0[3]}), c = gelu_pk((f32x2){v1[0], v1[1]}), d = gelu_pk((f32x2){v1[2], v1[3]});
                        v0 = (f32x4){a.x, a.y, b.x, b.y}; v1 = (f32x4){c.x, c.y, d.x, d.y}; }
                    v0 = v0 * sc; v1 = v1 * sc; u32x4 w; w.x = cvt_pk_bf16(v0[0], v0[1]); w.y = cvt_pk_bf16(v0[2], v0[3]); w.z = cvt_pk_bf16(v1[0], v1[1]); w.w = cvt_pk_bf16(v1[2], v1[3]);
                    *(u32x4*)(rowp + bj * HALF) = w; } }
    }
};
template <class Epi, class Sched, bool ALIGN_EPI = false, bool SP2 = false>
__device__ __forceinline__ void gemm_phase(PG8_LAS unsigned char* lds, const Gemm g, const Sched& S, const Epi& E) {
    int tid_ = threadIdx.x; asm volatile("" : "+v"(tid_));
    const int tid = tid_, wid = __builtin_amdgcn_readfirstlane(tid >> 6), lane = tid & 63, wr = wid >> 2, wc = wid & 3, fr = lane & 15, fq = lane >> 4;
    const int K = g.K, nt = K / BK;
    unsigned voffA[2], voffB[2];
#pragma unroll
    for (int i = 0; i < 2; ++i) { int R, C; stage_rc(tid * 16 + i * 8192, R, C); const int Rb = Epi::PERM ? ((R & ~31) + perm32(R & 31)) : R;
        voffA[i] = (unsigned)(R * K + C) * 2u; voffB[i] = (unsigned)(Rb * K + C) * 2u; }
    const size_t kstep = (size_t)(BK * 2);
    const size_t hstep = (size_t)HALF * K * 2;
    const size_t tstep = 2 * hstep;
    const unsigned ldsw = (unsigned)wid * 1024u;
    const int aoff = lds_byte(wr * 64 + fr, fq * 8), boff = lds_byte(wc * 32 + fr, fq * 8);
#define PG8_SA(b, h) (((b) * 2 + (h)) * HTB)
#define PG8_SB(b, h) ((4 + (b) * 2 + (h)) * HTB)
#define PG8_STAGE(bufoff, gbase, voff) do { _Pragma("unroll") for (int _i = 0; _i < 2; ++_i) \
        __builtin_amdgcn_global_load_lds((const unsigned*)((const char*)(gbase) + (voff)[_i]), (PG8_LAS unsigned*)(lds + (bufoff) + ldsw + _i * 8192), 16, 0, 0); } while (0)
#define PG8_LDA(dst, b, h) do { _Pragma("unroll") for (int m = 0; m < 4; ++m) _Pragma("unroll") for (int k = 0; k < 2; ++k) dst[m][k] = *(const PG8_LAS bf16x8*)(lds + PG8_SA(b, h) + aoff + m * 2048 + k * 1024); } while (0)
#define PG8_LDB(dst, b, h) do { _Pragma("unroll") for (int n = 0; n < 2; ++n) _Pragma("unroll") for (int k = 0; k < 2; ++k) dst[n][k] = *(const PG8_LAS bf16x8*)(lds + PG8_SB(b, h) + boff + n * 2048 + k * 1024); } while (0)
#define PG8_MMA(ai, bj, At, Bt) do { __builtin_amdgcn_s_setprio(1); _Pragma("unroll") for (int m = 0; m < 4; ++m) _Pragma("unroll") for (int n = 0; n < 2; ++n) _Pragma("unroll") for (int k = 0; k < 2; ++k) \
        acc[ai][bj][m][n] = __builtin_amdgcn_mfma_f32_16x16x32_bf16(Bt[n][k], At[m][k], acc[ai][bj][m][n], 0, 0, 0); __builtin_amdgcn_s_setprio(0); } while (0)
#define PG8_WAIT_V(n) asm volatile("s_waitcnt vmcnt(" #n ")" ::: "memory")
#define PG8_WAIT_L(n) asm volatile("s_waitcnt lgkmcnt(" #n ")" ::: "memory")
#define PG8_BAR __builtin_amdgcn_s_barrier()
#define PG8_SCHED __builtin_amdgcn_sched_barrier(0)
    Unit cur, nxt; int ui = 0;
    if (!S.next(0, cur)) return;
    f32x4 acc[2][2][4][2];
#pragma unroll
    for (int a = 0; a < 2; ++a)
#pragma unroll
        for (int b = 0; b < 2; ++b)
#pragma unroll
            for (int m = 0; m < 4; ++m)
#pragma unroll
                for (int n = 0; n < 2; ++n) acc[a][b][m][n] = (f32x4){0.f, 0.f, 0.f, 0.f};
    bf16x8 At[4][2], B0[2][2], B1[2][2];
    const char* cA = (const char*)g.A + (size_t)cur.pm * tstep; const char* cB = (const char*)g.Bt + (size_t)cur.pn * tstep;
    S.a_ready(cur);
    if constexpr (SP2) {
        PG8_STAGE(PG8_SB(0, 0), cB, voffB); PG8_STAGE(PG8_SB(0, 1), cB + hstep, voffB); PG8_STAGE(PG8_SA(0, 0), cA, voffA); PG8_STAGE(PG8_SA(0, 1), cA + hstep, voffA);
        if (wr == 1) PG8_BAR;
        PG8_WAIT_V(2); PG8_BAR;
        PG8_STAGE(PG8_SB(1, 0), cB + kstep, voffB); PG8_STAGE(PG8_SA(1, 0), cA + kstep, voffA); PG8_STAGE(PG8_SB(1, 1), cB + hstep + kstep, voffB);
        PG8_WAIT_V(6); PG8_BAR;
    } else {
        PG8_STAGE(PG8_SB(0, 0), cB, voffB); PG8_STAGE(PG8_SA(0, 0), cA, voffA); PG8_STAGE(PG8_SB(0, 1), cB + hstep, voffB); PG8_STAGE(PG8_SA(0, 1), cA + hstep, voffA);
        if (wr == 1) PG8_BAR;
        PG8_WAIT_V(4); PG8_BAR;
        PG8_STAGE(PG8_SB(1, 0), cB + kstep, voffB); PG8_STAGE(PG8_SA(1, 0), cA + kstep, voffA); PG8_STAGE(PG8_SB(1, 1), cB + hstep + kstep, voffB);
        PG8_WAIT_V(6); PG8_BAR;
    }
    for (;;) {
        const bool has_next = S.next(ui + 1, nxt);
        const char* nA = has_next ? (const char*)g.A + (size_t)nxt.pm * tstep : cA; const char* nB = has_next ? (const char*)g.Bt + (size_t)nxt.pn * tstep : cB;
        for (int t = 0; t < nt; t += 2) {
            const bool last = (t == nt - 2);
            const char* a1 = cA + (size_t)(t + 1) * kstep;
            const char* a2 = last ? nA : cA + (size_t)(t + 2) * kstep; const char* b2 = last ? nB : cB + (size_t)(t + 2) * kstep;
            const char* a3 = a2 + kstep; const char* b3 = b2 + kstep;
            if (last && has_next) S.a_ready(nxt);
            if constexpr (SP2) {
            PG8_LDB(B0, 0, 0); PG8_LDB(B1, 0, 1); PG8_SCHED; PG8_LDA(At, 0, 0); PG8_STAGE(PG8_SA(1, 1), a1 + hstep, voffA);
            PG8_WAIT_V(8); PG8_WAIT_L(0); PG8_BAR; PG8_MMA(0, 0, At, B0); PG8_MMA(0, 1, At, B1); PG8_BAR; PG8_SCHED;
            PG8_LDA(At, 0, 1); PG8_STAGE(PG8_SB(0, 0), b2, voffB); PG8_STAGE(PG8_SB(0, 1), b2 + hstep, voffB); PG8_STAGE(PG8_SA(0, 0), a2, voffA);
            PG8_WAIT_V(8); PG8_WAIT_L(0); PG8_BAR; PG8_MMA(1, 0, At, B0); PG8_MMA(1, 1, At, B1); PG8_BAR; PG8_SCHED;
            PG8_LDB(B0, 1, 0); PG8_LDB(B1, 1, 1); PG8_SCHED; PG8_LDA(At, 1, 0); PG8_STAGE(PG8_SA(0, 1), a2 + hstep, voffA);
            PG8_WAIT_V(8); PG8_WAIT_L(0); PG8_BAR; PG8_MMA(0, 0, At, B0); PG8_MMA(0, 1, At, B1); PG8_BAR; PG8_SCHED;
            PG8_LDA(At, 1, 1); PG8_STAGE(PG8_SB(1, 0), b3, voffB); PG8_STAGE(PG8_SB(1, 1), b3 + hstep, voffB); PG8_STAGE(PG8_SA(1, 0), a3, voffA);
            PG8_WAIT_V(8); PG8_WAIT_L(0); PG8_BAR; PG8_MMA(1, 0, At, B0); PG8_MMA(1, 1, At, B1); PG8_BAR; PG8_SCHED;
            } else {
            PG8_LDB(B0, 0, 0); PG8_SCHED; PG8_LDA(At, 0, 0); PG8_STAGE(PG8_SA(1, 1), a1 + hstep, voffA);
            PG8_WAIT_L(8); PG8_BAR; PG8_WAIT_L(0); PG8_MMA(0, 0, At, B0); PG8_BAR; PG8_SCHED;
            PG8_LDB(B1, 0, 1); PG8_STAGE(PG8_SB(0, 0), b2, voffB);
            PG8_BAR; PG8_WAIT_L(0); PG8_MMA(0, 1, At, B1); PG8_BAR;
            PG8_LDA(At, 0, 1); PG8_STAGE(PG8_SA(0, 0), a2, voffA);
            PG8_BAR; PG8_WAIT_L(0); PG8_MMA(1, 0, At, B0); PG8_BAR; PG8_SCHED;
            PG8_STAGE(PG8_SB(0, 1), b2 + hstep, voffB);
            PG8_WAIT_V(6); PG8_BAR; PG8_MMA(1, 1, At, B1); PG8_BAR;
            PG8_LDB(B0, 1, 0); PG8_SCHED; PG8_LDA(At, 1, 0); PG8_STAGE(PG8_SA(0, 1), a2 + hstep, voffA);
            PG8_WAIT_L(8); PG8_BAR; PG8_WAIT_L(0); PG8_MMA(0, 0, At, B0); PG8_BAR; PG8_SCHED;
            PG8_LDB(B1, 1, 1); PG8_STAGE(PG8_SB(1, 0), b3, voffB);
            PG8_BAR; PG8_WAIT_L(0); PG8_MMA(0, 1, At, B1); PG8_BAR;
            PG8_LDA(At, 1, 1); PG8_STAGE(PG8_SA(1, 0), a3, voffA);
            PG8_BAR; PG8_WAIT_L(0); PG8_MMA(1, 0, At, B0); PG8_BAR; PG8_SCHED;
            PG8_STAGE(PG8_SB(1, 1), b3 + hstep, voffB);
            PG8_WAIT_V(6); PG8_BAR; PG8_MMA(1, 1, At, B1); PG8_BAR;
            }
        }
        if constexpr (ALIGN_EPI) { if (wr == 0) PG8_BAR; }
        if constexpr (!Epi::AFTER_DRAIN) { E(acc, cur, wr, wc, fr, fq); S.done(cur); }
        if (!has_next) break;
#pragma unroll
        for (int a = 0; a < 2; ++a)
#pragma unroll
            for (int b = 0; b < 2; ++b)
#pragma unroll
                for (int m = 0; m < 4; ++m)
#pragma unroll
                    for (int n = 0; n < 2; ++n) acc[a][b][m][n] = (f32x4){0.f, 0.f, 0.f, 0.f};
        cur = nxt; cA = nA; cB = nB; ++ui;
        if constexpr (ALIGN_EPI) { if (wr == 1) PG8_BAR; }
    }
    PG8_WAIT_V(0);
    if constexpr (!ALIGN_EPI) { if (wr == 0) PG8_BAR; }
    PG8_BAR;
    if constexpr (Epi::AFTER_DRAIN) { E.fused(acc, cur, wr, wc, fr, fq, lds, wid, lane); S.done(cur); }
#undef PG8_SA
#undef PG8_SB
#undef PG8_STAGE
#undef PG8_LDA
#undef PG8_LDB
#undef PG8_MMA
#undef PG8_WAIT_V
#undef PG8_WAIT_L
#undef PG8_BAR
#undef PG8_SCHED
}
}
#define LAS __attribute__((address_space(3)))
#define XB_TMO      128
#define XB_XCNT(j)  (256  + 64 * (j))
#define XB_XSUB(j)  (1280 + 64 * (j))
#define XB_XGEN(j)  (2304 + 64 * (j))
#define XB_TOP      3328
#define XB_TOPGEN   3392
#define XCD_BAR_WORDS 3456
#define XB_SPIN_CAP (1u << 18)

__device__ __forceinline__ unsigned xb_ld(unsigned* p)              { return __hip_atomic_load(p, __ATOMIC_RELAXED, __HIP_MEMORY_SCOPE_AGENT); }
__device__ __forceinline__ unsigned xb_add(unsigned* p, unsigned v) { return __hip_atomic_fetch_add(p, v, __ATOMIC_RELAXED, __HIP_MEMORY_SCOPE_AGENT); }
__device__ __forceinline__ unsigned xb_xcc_id() { return (unsigned)__builtin_amdgcn_s_getreg((3 << 11) | 20) & 0xFu; }
#define XB_SPIN(cond, bar) do { unsigned _sp = 0; while (cond) { __builtin_amdgcn_s_sleep(1); \
    if ((++_sp & 255u) == 0u) { if (xb_ld(&(bar)[XB_TMO])) break; if (_sp > XB_SPIN_CAP) { atomicAdd(&(bar)[XB_TMO], 1u); break; } } } } while (0)

struct XcdBarrier {
    unsigned* bar; unsigned x;
    volatile LAS unsigned* st;
};

__device__ __forceinline__ XcdBarrier xcd_barrier_post(unsigned* bar, volatile LAS unsigned* st) {
    XcdBarrier b; b.bar = bar; b.x = xb_xcc_id(); b.st = st;
    if (threadIdx.x == 0) (void)xb_add(&bar[XB_XCNT(b.x)], 1u);
    return b;
}
__device__ __forceinline__ void xcd_barrier_complete(unsigned* bar, unsigned x, unsigned& nloc, unsigned& nx) {
    const unsigned G = gridDim.x * gridDim.y * gridDim.z;
    unsigned sum, cnt, mine, sp = 0u;
    for (;;) {
        sum = 0u; cnt = 0u; mine = 0u;
#pragma unroll
        for (unsigned j = 0; j < 16; ++j) { const unsigned c = xb_ld(&bar[XB_XCNT(j)]); sum += c; cnt += (c > 0u) ? 1u : 0u; mine = (j == x) ? c : mine; }
        if (sum == G) break;
        __builtin_amdgcn_s_sleep(1);
        if ((++sp & 255u) == 0u) { if (xb_ld(&bar[XB_TMO])) break; if (sp > XB_SPIN_CAP) { atomicAdd(&bar[XB_TMO], 1u); break; } }
    }
    nloc = mine > 0u ? mine : 1u; nx = cnt > 0u ? cnt : 1u;
}

__device__ __forceinline__ void xcd_barrier(const XcdBarrier& b) {
    asm volatile("s_waitcnt vmcnt(0)" ::: "memory");
    __syncthreads();
    if (threadIdx.x == 0) {
        unsigned* bar = b.bar; const unsigned bx_ = xb_xcc_id();
        __builtin_amdgcn_s_waitcnt(0);
        unsigned nloc = b.st[0], nx = b.st[1];
        if (nloc == 0u) { xcd_barrier_complete(bar, bx_, nloc, nx); b.st[0] = nloc; b.st[1] = nx; }
        const unsigned old = xb_add(&bar[XB_XSUB(bx_)], 1u);
        const unsigned gen = old / nloc;
        if (old + 1u == (gen + 1u) * nloc) {
            __builtin_amdgcn_fence(__ATOMIC_RELEASE, "agent");
            asm volatile("s_waitcnt vmcnt(0)" ::: "memory");
            const unsigned og = xb_add(&bar[XB_TOP], 1u);
            const unsigned tg = og / nx;
            if (og + 1u == (tg + 1u) * nx) xb_add(&bar[XB_TOPGEN], 1u);
            else XB_SPIN(xb_ld(&bar[XB_TOPGEN]) == tg, bar);
            __builtin_amdgcn_fence(__ATOMIC_ACQUIRE, "agent");
            xb_add(&bar[XB_XGEN(bx_)], 1u);
            asm volatile("s_waitcnt vmcnt(0)" ::: "memory");
        } else {
            XB_SPIN(xb_ld(&bar[XB_XGEN(bx_)]) == gen, bar);
            __builtin_amdgcn_fence(__ATOMIC_ACQUIRE, "agent");
            asm volatile("s_waitcnt vmcnt(0)" ::: "memory");
        }
    }
    __syncthreads();
}

#define GAS __attribute__((address_space(1)))
#define LAS __attribute__((address_space(3)))
typedef unsigned short bf16;
typedef float f32x4 __attribute__((ext_vector_type(4)));
typedef float f32x16 __attribute__((ext_vector_type(16)));
typedef short bf16x8 __attribute__((ext_vector_type(8)));
typedef short s16x4 __attribute__((ext_vector_type(4)));
typedef unsigned u32x4 __attribute__((ext_vector_type(4)));
typedef unsigned u32x2 __attribute__((ext_vector_type(2)));

#ifndef REP_MIX
#define REP_MIX 1
#endif
#ifndef REP_PRO
#define REP_PRO 1
#endif
#ifndef REP_SYNC
#define REP_SYNC 1
#endif
constexpr int NWAVES = 8;
constexpr int GRID_WG = 256;
constexpr int DM = 1024, NP = 32768, NS = 1024, MROWS = NP + NS, SEQ = 8192, DFF = 2816, DIN = 2560, NL = 2;
constexpr float EPS = 1e-6f;
constexpr float LOG2E = 1.4426950408889634f;
constexpr size_t MiB = 1u << 20;
constexpr size_t WS_W = 0;
constexpr size_t W_LAYER = 40 * MiB, W_GU1 = 0, W_D1 = 11 * MiB, W_IN = 16 * MiB + 512 * 1024, W_OUT = 21 * MiB + 512 * 1024, W_GU2 = 23 * MiB + 512 * 1024, W_D2 = 34 * MiB + 512 * 1024;
constexpr size_t WS_WTRIL = 80 * MiB;
constexpr size_t WS_BAR = 80 * MiB + 512 * 1024;
constexpr size_t WS_CNT = WS_BAR + 16384;
constexpr size_t WS_SSQ = 81 * MiB;
constexpr size_t WS_SK = 84 * MiB;
constexpr size_t WS_SVT = 102 * MiB;
constexpr size_t WS_XB = 120 * MiB;
constexpr size_t WS_MIX = 186 * MiB;
constexpr size_t WS_A = 252 * MiB;
constexpr size_t WS_GLU = WS_A, WS_U = WS_A + 17 * MiB, WS_VG = WS_A + 34 * MiB, WS_Q = WS_A + 51 * MiB, WS_PK = WS_A + 84 * MiB, WS_PVT = WS_A + 116 * MiB;
constexpr size_t WS_END = WS_A + 182 * MiB;
static_assert(WS_PVT + 32 * MiB <= WS_END, "overlay");
constexpr size_t O_YP = 0, O_YS = 33554432, O_PCS = O_YS + 1048576, O_PK = O_PCS + 61440, O_PV = O_PK + 2097152, O_SCS = O_PV + 2097152,
                 O_SK = O_SCS + 245760, O_SV = O_SK + 1048576, O_SG = O_SV + 1048576, O_END = O_SG + 524288;
constexpr int GLU_PB = SEQ + 30, GLU_SROW0 = 4 * GLU_PB;
constexpr int RING_BYTES = 131072, BIAS_OFF = RING_BYTES, RS_OFF = RING_BYTES + 8448, RS_UNITS = 12, XB_OFF = RS_OFF + RS_UNITS * 1024, VSCR_OFF = XB_OFF + 32, LDS_BYTES = 160256;

struct Params {
    const float* in[27];
    float* out; unsigned char* ws;
};
typedef const __attribute__((address_space(4))) Params* CPP;
__device__ __forceinline__ CPP kparams() { CPP q = (CPP)__builtin_amdgcn_kernarg_segment_ptr(); asm volatile("" : "+s"(q)); return q; }

__device__ __forceinline__ unsigned f2bf(float f) { unsigned u = __builtin_bit_cast(unsigned, f); return (u + 0x7fffu + ((u >> 16) & 1u)) >> 16; }
typedef __bf16 bf16x2_t __attribute__((ext_vector_type(2)));
typedef float f32x2_t __attribute__((ext_vector_type(2)));
__device__ __forceinline__ unsigned pk2(float lo, float hi) { const f32x2_t f = {lo, hi}; const bf16x2_t h = __builtin_convertvector(f, bf16x2_t); return __builtin_bit_cast(unsigned, h); }
__device__ __forceinline__ float bf2f(unsigned short b) { return __builtin_bit_cast(float, (unsigned)b << 16); }
__device__ __forceinline__ unsigned cvtpk(float lo, float hi) { return pk2(lo, hi); }
__device__ __forceinline__ float wave_sum(float v) {
#pragma unroll
    for (int o = 1; o < 64; o <<= 1) v += __shfl_xor(v, o);
    return v;
}
__device__ __forceinline__ float fast_exp2(float x) { return __builtin_amdgcn_exp2f(x); }
__device__ __forceinline__ float fast_rcp(float x) { return __builtin_amdgcn_rcpf(x); }
__device__ __forceinline__ float sigmoidf_(float x) { return fast_rcp(1.f + fast_exp2(-LOG2E * x)); }
__device__ __forceinline__ float siluf_(float x) { return x * sigmoidf_(x); }
__device__ __forceinline__ float gelu_tanh(float x) { const float t = 0.7978845608028654f * (x + 0.044715f * x * x * x); return x * sigmoidf_(2.f * t); }
__device__ __forceinline__ float row_rs(const float* ssq, int row) {
    const f32x4* p = (const f32x4*)(ssq + (size_t)row * 16);
    const f32x4 a = p[0], b = p[1], c = p[2], d = p[3];
    const f32x4 s = (a + b) + (c + d);
    return __builtin_amdgcn_rsqf(((s[0] + s[1]) + (s[2] + s[3])) * (1.f / 1024.f) + EPS);
}

struct RsOrder : pg8::StaticOrder {
    const float* ssq; LAS float* rsbuf;
    __device__ __forceinline__ void a_ready(const pg8::Unit&) const {}
};
template <class Sched>
__device__ __forceinline__ void rs_fill(const Sched& S, const float* ssq, LAS float* rsbuf, int tid) {
    int pms[RS_UNITS]; int nu = 0;
#pragma unroll
    for (int i = 0; i < RS_UNITS; ++i) { pg8::Unit u; const bool ok = S.next(i, u); pms[i] = ok ? u.pm : 0; nu += ok ? 1 : 0; }
    const int half = tid >> 8, rr = tid & 255;
#pragma unroll
    for (int b = 0; b < RS_UNITS / 2; b += 6) {
        f32x4 v[6][4];
#pragma unroll
        for (int k = 0; k < 6; ++k) { const int ui = 2 * (b + k) + half; const int pm = half ? pms[2 * (b + k) + 1] : pms[2 * (b + k)];
            const f32x4* p = (const f32x4*)(ssq + ((size_t)pm * 256 + rr) * 16);
            if (ui < nu) { v[k][0] = p[0]; v[k][1] = p[1]; v[k][2] = p[2]; v[k][3] = p[3]; } }
#pragma unroll
        for (int k = 0; k < 6; ++k) { const int ui = 2 * (b + k) + half;
            if (ui < nu) { const f32x4 s4 = (v[k][0] + v[k][1]) + (v[k][2] + v[k][3]); rsbuf[ui * 256 + rr] = __builtin_amdgcn_rsqf(((s4[0] + s4[1]) + (s4[2] + s4[3])) * (1.f / 1024.f) + EPS); } }
    }
    __syncthreads();
}
struct GuOrder : RsOrder {
    unsigned* cnt;
    const unsigned* wait_cnt;
    int samp_i;
    __device__ __forceinline__ bool next(int i, pg8::Unit& u) const {
        int L;
        if (c < 240) { L = i * 240 + c; if (L >= 2760) return false; }
        else { if (i >= 9) return false; L = 2760 + (c - 240) + 16 * i; }
        u.idx = i;
        const int s0 = 240 * samp_i;
        if (L >= s0 && L < s0 + 88) { const int q = L - s0; u.pm = 128 + q / 22; u.pn = q % 22; return true; }
        int wgid = (L < s0) ? L : L - 88; { const int xcd = wgid % 8, off = wgid / 8; wgid = xcd * 352 + off; }
        const int gid = wgid / 176, rem = wgid % 176;
        u.pm = gid * 8 + (rem % 8); u.pn = rem / 8; return true;
    }
    __device__ __forceinline__ void a_ready(const pg8::Unit& u) const {
        if (wait_cnt != nullptr && u.pm >= 128) {
            if (threadIdx.x < 64) { unsigned sp = 0; while ((unsigned)__builtin_amdgcn_readfirstlane(__hip_atomic_load(wait_cnt, __ATOMIC_RELAXED, __HIP_MEMORY_SCOPE_AGENT)) < 16u && ++sp < (1u << 22)) __builtin_amdgcn_s_sleep(2);
                __builtin_amdgcn_fence(__ATOMIC_ACQUIRE, "agent"); }
            asm volatile("s_waitcnt vmcnt(0)" ::: "memory");
            __builtin_amdgcn_s_barrier();
            if (threadIdx.x < 256) rsbuf[u.idx * 256 + threadIdx.x] = row_rs(ssq, u.pm * 256 + threadIdx.x);
        }
    }
    __device__ __forceinline__ void done(const pg8::Unit& u) const {
        if (u.pm >= 128) {
            asm volatile("s_waitcnt vmcnt(0)" ::: "memory");
            __builtin_amdgcn_s_barrier();
            if (threadIdx.x == 0) { __builtin_amdgcn_fence(__ATOMIC_RELEASE, "agent"); asm volatile("s_waitcnt vmcnt(0)" ::: "memory");
                __hip_atomic_fetch_add(cnt, 1u, __ATOMIC_RELAXED, __HIP_MEMORY_SCOPE_AGENT); }
        }
    }
};
struct RangeOrder : pg8::StaticOrder {
    int pm0; unsigned* pub;
    __device__ __forceinline__ bool next(int i, pg8::Unit& u) const { if (c < 0) return false; if (!pg8::StaticOrder::next(i, u)) return false; u.pm += pm0; return true; }
    __device__ __forceinline__ void done(const pg8::Unit&) const {
        if (pub != nullptr) {
            asm volatile("s_waitcnt vmcnt(0)" ::: "memory");
            __builtin_amdgcn_s_barrier();
            if (threadIdx.x == 0) { __builtin_amdgcn_fence(__ATOMIC_RELEASE, "agent"); asm volatile("s_waitcnt vmcnt(0)" ::: "memory");
                __hip_atomic_fetch_add(pub, 1u, __ATOMIC_RELAXED, __HIP_MEMORY_SCOPE_AGENT); }
        }
    }
};
struct EpiSwiGLU {
    static constexpr bool PERM = true, AFTER_DRAIN = false;
    bf16* O; const LAS float* rsbuf;
    __device__ __forceinline__ void operator()(const pg8::f32x4 (&acc)[2][2][4][2], const pg8::Unit& u, int wr, int wc, int fr, int fq) const {
        const int row0 = u.pm * 256 + wr * 64 + fr, col0 = u.pn * 128 + wc * 32 + 8 * fq;
#pragma unroll
        for (int ai = 0; ai < 2; ++ai)
#pragma unroll
            for (int mp = 0; mp < 4; mp += 2) {
                float e[2][8], t[2][8]; float c1[2], r2[2];
#pragma unroll
                for (int q = 0; q < 2; ++q) { const float rs = rsbuf[u.idx * 256 + ((row0 + ai * 128 + (mp + q) * 16) & 255)]; c1[q] = -LOG2E * rs; r2[q] = rs * rs; }
#pragma unroll
                for (int q = 0; q < 2; ++q)
#pragma unroll
                    for (int n = 0; n < 2; ++n)
#pragma unroll
                        for (int k = 0; k < 4; ++k) { const float g = acc[ai][0][mp + q][n][k]; e[q][4 * n + k] = fast_exp2(g * c1[q]); t[q][4 * n + k] = (g * acc[ai][1][mp + q][n][k]) * r2[q]; }
#pragma unroll
                for (int q = 0; q < 2; ++q)
#pragma unroll
                    for (int j = 0; j < 8; ++j) e[q][j] = fast_rcp(1.f + e[q][j]);
#pragma unroll
                for (int q = 0; q < 2; ++q) {
                    u32x4 w; w.x = cvtpk(t[q][0] * e[q][0], t[q][1] * e[q][1]); w.y = cvtpk(t[q][2] * e[q][2], t[q][3] * e[q][3]); w.z = cvtpk(t[q][4] * e[q][4], t[q][5] * e[q][5]); w.w = cvtpk(t[q][6] * e[q][6], t[q][7] * e[q][7]);
                    *(u32x4*)(O + (size_t)(row0 + ai * 128 + (mp + q) * 16) * DFF + col0) = w; }
            }
    }
};
struct EpiResid {
    static constexpr bool PERM = true, AFTER_DRAIN = false;
    const float* bp; const float* bs; float* X; const bf16* XBr; bf16* XB; float* ssq; float alpha;
    __device__ __forceinline__ void operator()(const pg8::f32x4 (&acc)[2][2][4][2], const pg8::Unit& u, int wr, int wc, int fr, int fq) const {
        const int row0 = u.pm * 256 + wr * 64 + fr, col0 = u.pn * 256 + wc * 32 + 8 * fq;
        const float* base = (u.pm * 256 < NP) ? bp : (bs - (size_t)NP * DM);
        if (bp == nullptr) {
            u32x4 q[2][4][2];
#pragma unroll
            for (int ai = 0; ai < 2; ++ai)
#pragma unroll
                for (int m = 0; m < 4; ++m)
#pragma unroll
                    for (int bj = 0; bj < 2; ++bj) q[ai][m][bj] = *(const u32x4*)(XBr + (size_t)(row0 + ai * 128 + m * 16) * DM + col0 + bj * 128);
#pragma unroll
            for (int ai = 0; ai < 2; ++ai)
#pragma unroll
                for (int m = 0; m < 4; ++m) {
                    const int row = row0 + ai * 128 + m * 16;
                    float ss = 0.f;
#pragma unroll
                    for (int bj = 0; bj < 2; ++bj) {
                        const size_t off = (size_t)row * DM + col0 + bj * 128;
                        const u32x4 qq = q[ai][m][bj];
                        const f32x4 b0 = (f32x4){__builtin_bit_cast(float, qq.x << 16), __builtin_bit_cast(float, qq.x & 0xffff0000u), __builtin_bit_cast(float, qq.y << 16), __builtin_bit_cast(float, qq.y & 0xffff0000u)};
                        const f32x4 b1 = (f32x4){__builtin_bit_cast(float, qq.z << 16), __builtin_bit_cast(float, qq.z & 0xffff0000u), __builtin_bit_cast(float, qq.w << 16), __builtin_bit_cast(float, qq.w & 0xffff0000u)};
                        const f32x4 v0 = b0 + acc[ai][bj][m][0] * alpha, v1 = b1 + acc[ai][bj][m][1] * alpha;
                        if (X != nullptr) { *(f32x4*)(X + off) = v0; *(f32x4*)(X + off + 4) = v1; }
                        if (XB != nullptr) {
                            u32x4 w; w.x = cvtpk(v0[0], v0[1]); w.y = cvtpk(v0[2], v0[3]); w.z = cvtpk(v1[0], v1[1]); w.w = cvtpk(v1[2], v1[3]);
                            *(u32x4*)(XB + off) = w;
                            ss += (v0[0] * v0[0] + v0[1] * v0[1]) + (v0[2] * v0[2] + v0[3] * v0[3]) + (v1[0] * v1[0] + v1[1] * v1[1]) + (v1[2] * v1[2] + v1[3] * v1[3]); }
                    }
                    if (XB != nullptr) { ss += __shfl_xor(ss, 16); ss += __shfl_xor(ss, 32);
                        if (fq == 0) ssq[(size_t)row * 16 + 4 * u.pn + wc] = ss; }
                }
            return;
        }
#pragma unroll
        for (int ai = 0; ai < 2; ++ai) {
            f32x4 fb[4][2][2];
#pragma unroll
            for (int m = 0; m < 4; ++m)
#pragma unroll
                for (int bj = 0; bj < 2; ++bj) { const float* p = base + (size_t)(row0 + ai * 128 + m * 16) * DM + col0 + bj * 128; fb[m][bj][0] = *(const f32x4*)p; fb[m][bj][1] = *(const f32x4*)(p + 4); }
#pragma unroll
            for (int m = 0; m < 4; ++m) {
                const int row = row0 + ai * 128 + m * 16;
                float ss = 0.f;
#pragma unroll
                for (int bj = 0; bj < 2; ++bj) {
                    const size_t off = (size_t)row * DM + col0 + bj * 128;
                    const f32x4 v0 = fb[m][bj][0] + acc[ai][bj][m][0] * alpha, v1 = fb[m][bj][1] + acc[ai][bj][m][1] * alpha;
                    u32x4 w; w.x = cvtpk(v0[0], v0[1]); w.y = cvtpk(v0[2], v0[3]); w.z = cvtpk(v1[0], v1[1]); w.w = cvtpk(v1[2], v1[3]);
                    *(u32x4*)(XB + off) = w;
                    ss += (v0[0] * v0[0] + v0[1] * v0[1]) + (v0[2] * v0[2] + v0[3] * v0[3]) + (v1[0] * v1[0] + v1[1] * v1[1]) + (v1[2] * v1[2] + v1[3] * v1[3]);
                }
                ss += __shfl_xor(ss, 16); ss += __shfl_xor(ss, 32);
                if (fq == 0) ssq[(size_t)row * 16 + 4 * u.pn + wc] = ss;
            }
        }
    }
};
struct EpiMix {
    static constexpr bool PERM = true, AFTER_DRAIN = false;
    const LAS float* rsbuf; const float* qg; const float* kg; unsigned char* ws; float* out; int l; LAS unsigned char* vscr;
    __device__ __forceinline__ void operator()(const pg8::f32x4 (&acc)[2][2][4][2], const pg8::Unit& u, int wr, int wc, int fr, int fq) const {
        bf16* const GLU = (bf16*)(ws + WS_GLU); bf16* const U = (bf16*)(ws + WS_U); bf16* const VG = (bf16*)(ws + WS_VG); bf16* const Q = (bf16*)(ws + WS_Q);
        bf16* const PK = (bf16*)(ws + WS_PK); bf16* const PVT = (bf16*)(ws + WS_PVT);
        bf16* const SK = (bf16*)(ws + WS_SK) + (size_t)l * 16 * 576 * 512; bf16* const SVT = (bf16*)(ws + WS_SVT) + (size_t)l * 16 * 512 * 576;
        float* const o_pcs = out + O_PCS + (size_t)l * 4 * 30 * 256; float* const o_pk = out + O_PK + (size_t)l * 4 * 512 * 512; float* const o_pv = out + O_PV + (size_t)l * 4 * 512 * 512;
        float* const o_scs = out + O_SCS + (size_t)l * 16 * 30 * 256; float* const o_sk = out + O_SK + (size_t)l * 16 * 64 * 512; float* const o_sv = out + O_SV + (size_t)l * 16 * 64 * 512;
        const int row0 = u.pm * 256 + wr * 64 + fr, pn = u.pn;
        const bool samp = (u.pm * 256 >= NP);
        if (pn < 2) {
            const int ch0 = pn * 128 + wc * 32 + 8 * fq;
#pragma unroll
            for (int ai = 0; ai < 2; ++ai)
#pragma unroll
                for (int m = 0; m < 4; ++m) {
                    const int row = row0 + ai * 128 + m * 16; const float rs = rsbuf[u.idx * 256 + (row & 255)];
                    float h[8];
#pragma unroll
                    for (int n = 0; n < 2; ++n)
#pragma unroll
                        for (int e = 0; e < 4; ++e) h[4 * n + e] = (acc[ai][0][m][n][e] * rs) * sigmoidf_(acc[ai][1][m][n][e] * rs);
                    u32x4 w; w.x = cvtpk(h[0], h[1]); w.y = cvtpk(h[2], h[3]); w.z = cvtpk(h[4], h[5]); w.w = cvtpk(h[6], h[7]);
                    { const int grow = samp ? (GLU_SROW0 + ((row - NP) >> 6) * 94 + 30 + ((row - NP) & 63)) : ((row >> 13) * GLU_PB + 30 + (row & 8191));
                      *(u32x4*)(GLU + (size_t)grow * 256 + ch0) = w; }
                    float* dst = nullptr;
                    if (!samp) { const int b = row >> 13, t = row & 8191; if (t >= SEQ - 30) dst = o_pcs + ((size_t)(b * 30 + (t - (SEQ - 30)))) * 256 + ch0; }
                    else { const int rr = row - NP, b = rr >> 6, t = rr & 63; if (t >= 34) dst = o_scs + ((size_t)(b * 30 + (t - 34))) * 256 + ch0; }
                    if (dst) { *(f32x4*)dst = (f32x4){h[0], h[1], h[2], h[3]}; *(f32x4*)(dst + 4) = (f32x4){h[4], h[5], h[6], h[7]}; }
                }
        } else if (pn < 4) {
            bf16* O = (pn == 2) ? U : VG;
#pragma unroll
            for (int ai = 0; ai < 2; ++ai)
#pragma unroll
                for (int m = 0; m < 4; ++m) {
                    const int row = row0 + ai * 128 + m * 16; const float rs = rsbuf[u.idx * 256 + (row & 255)];
#pragma unroll
                    for (int bj = 0; bj < 2; ++bj) {
                        float h[8];
#pragma unroll
                        for (int n = 0; n < 2; ++n)
#pragma unroll
                            for (int e = 0; e < 4; ++e) h[4 * n + e] = gelu_tanh(acc[ai][bj][m][n][e] * rs);
                        u32x4 w; w.x = cvtpk(h[0], h[1]); w.y = cvtpk(h[2], h[3]); w.z = cvtpk(h[4], h[5]); w.w = cvtpk(h[6], h[7]);
                        *(u32x4*)(O + (size_t)row * 256 + bj * 128 + wc * 32 + 8 * fq) = w;
                    }
                }
        } else if (pn < 8) {
            const bool isq = pn < 6;
            const int head = 4 * ((pn - 4) & 1) + wc;
            const float* gp = isq ? qg : kg;
            const float sc = isq ? 0.125f * LOG2E : 1.f;
            float gn[2][8];
#pragma unroll
            for (int bj = 0; bj < 2; ++bj) { const f32x4 ga = *(const f32x4*)(gp + 32 * bj + 8 * fq) * sc, gb = *(const f32x4*)(gp + 32 * bj + 8 * fq + 4) * sc;
#pragma unroll
                for (int j = 0; j < 4; ++j) { gn[bj][j] = ga[j]; gn[bj][4 + j] = gb[j]; } }
#pragma unroll
            for (int ai = 0; ai < 2; ++ai)
#pragma unroll
                for (int m = 0; m < 4; ++m) {
                    const int row = row0 + ai * 128 + m * 16; const float rs = rsbuf[u.idx * 256 + (row & 255)];
                    float z[2][8]; float ss = 0.f;
#pragma unroll
                    for (int bj = 0; bj < 2; ++bj)
#pragma unroll
                        for (int n = 0; n < 2; ++n)
#pragma unroll
                            for (int e = 0; e < 4; ++e) { const float v = acc[ai][bj][m][n][e] * rs; z[bj][4 * n + e] = v; ss += v * v; }
                    ss += __shfl_xor(ss, 16); ss += __shfl_xor(ss, 32);
                    const float inv = __builtin_amdgcn_rsqf(ss * (1.f / 64.f) + EPS);
#pragma unroll
                    for (int bj = 0; bj < 2; ++bj)
#pragma unroll
                        for (int j = 0; j < 8; ++j) z[bj][j] = z[bj][j] * inv * gn[bj][j];
                    bf16* dstb; float* dstf = nullptr;
                    if (isq) dstb = Q + (size_t)row * 512 + head * 64;
                    else if (!samp) { dstb = PK + ((size_t)(head * 1024 + (row >> 5)) * 256 + (row & 31)) * 8; const int b = row >> 13, t = row & 8191; if (t >= SEQ - 512) dstf = o_pk + ((size_t)(b * 512 + (t - (SEQ - 512))) * 8 + head) * 64; }
                    else { const int rr = row - NP, b = rr >> 6, t = rr & 63; dstb = SK + (size_t)b * 294912 + ((size_t)(head * 18 + 16 + (t >> 5)) * 256 + (t & 31)) * 8; dstf = o_sk + ((size_t)(b * 64 + t) * 8 + head) * 64; }
#pragma unroll
                    for (int bj = 0; bj < 2; ++bj) {
                        u32x4 w; w.x = cvtpk(z[bj][0], z[bj][1]); w.y = cvtpk(z[bj][2], z[bj][3]); w.z = cvtpk(z[bj][4], z[bj][5]); w.w = cvtpk(z[bj][6], z[bj][7]);
                        *(u32x4*)(dstb + (isq ? 32 * bj + 8 * fq : ((2 * bj + (fq >> 1)) * 2 + (fq & 1)) * 256)) = w;
                        if (dstf) { *(f32x4*)(dstf + 32 * bj + 8 * fq) = (f32x4){z[bj][0], z[bj][1], z[bj][2], z[bj][3]}; *(f32x4*)(dstf + 32 * bj + 8 * fq + 4) = (f32x4){z[bj][4], z[bj][5], z[bj][6], z[bj][7]}; }
                    }
                }
        } else {
#pragma unroll
            for (int ai = 0; ai < 2; ++ai)
#pragma unroll
                for (int m = 0; m < 4; ++m) {
                    const int row = row0 + ai * 128 + m * 16; const float rs = rsbuf[u.idx * 256 + (row & 255)];
                    bf16* dstb; float* dstf = nullptr;
                    const int rowg = row - fr;
                    if (!samp) { dstb = PVT + (size_t)(rowg >> 5) * 2048 + ((rowg >> 4) & 1) * 512; const int b = row >> 13, t = row & 8191; if (t >= SEQ - 512) dstf = o_pv + (size_t)(b * 512 + (t - (SEQ - 512))) * 512; }
                    else { const int rr = rowg - NP, b = rr >> 6, t0 = rr & 63, t = (row - NP) & 63; dstb = SVT + (size_t)b * 294912 + (size_t)(16 + (t0 >> 5)) * 2048 + ((t0 >> 4) & 1) * 512; dstf = o_sv + (size_t)(b * 64 + t) * 512; }
                    const size_t hstride = samp ? (size_t)18 * 2048 : (size_t)1024 * 2048;
                    LAS unsigned short* sc = (LAS unsigned short*)(vscr + (wr * 4 + wc) * 1024);
                    const int ln = fq * 16 + fr;
#pragma unroll
                    for (int bj = 0; bj < 2; ++bj) {
                        const int c0 = (pn - 8) * 256 + bj * 128 + wc * 32 + 8 * fq;
                        float z[8];
#pragma unroll
                        for (int n = 0; n < 2; ++n)
#pragma unroll
                            for (int e = 0; e < 4; ++e) z[4 * n + e] = acc[ai][bj][m][n][e] * rs;
#pragma unroll
                        for (int j = 0; j < 8; j += 2) { const unsigned p = pk2(z[j], z[j + 1]); sc[(8 * fq + j) * 16 + fr] = (unsigned short)(p & 0xffffu); sc[(8 * fq + j + 1) * 16 + fr] = (unsigned short)(p >> 16); }
                        asm volatile("s_waitcnt lgkmcnt(0)" ::: "memory");
                        { const int ch = ln & 31, hx = ln >> 5;
                          const u32x2 lo = *(const LAS u32x2*)(sc + ch * 16 + 4 * hx), hh = *(const LAS u32x2*)(sc + ch * 16 + 8 + 4 * hx);
                          const int cw0 = (pn - 8) * 256 + bj * 128 + wc * 32;
                          u32x4 w; w.x = lo.x; w.y = lo.y; w.z = hh.x; w.w = hh.y;
                          *(u32x4*)(dstb + (size_t)(cw0 >> 6) * hstride + ((cw0 >> 5) & 1) * 1024 + hx * 256 + ch * 8) = w; }
                        asm volatile("s_waitcnt lgkmcnt(0)" ::: "memory");
                        if (dstf) { *(f32x4*)(dstf + c0) = (f32x4){z[0], z[1], z[2], z[3]}; *(f32x4*)(dstf + c0 + 4) = (f32x4){z[4], z[5], z[6], z[7]}; }
                    }
                }
        }
    }
};

struct TItem { const float* W; const float* gain; bf16* WT; int N, pitch, drow, k0, n0; };
__device__ __forceinline__ int win_dst_row(int n0) {
    if (n0 < 256) return 256 * (n0 >> 7) + (n0 & 127);
    if (n0 < 512) { const int ch = n0 - 256; return 256 * (ch >> 7) + 128 + (ch & 127); }
    if (n0 < 1024) return n0;
    if (n0 < 2048) { const int k = (n0 >= 1536); const int c = n0 - 1024 - 512 * k, head = c >> 6, d = c & 63; return 256 * (4 + 2 * k + (head >> 2)) + 128 * (d >> 5) + 32 * (head & 3) + (d & 31); }
    return n0;
}
constexpr int PER_LAYER = 10240, NW_ITEMS = NL * PER_LAYER, NV_ITEMS = 0, NT_ITEMS = NW_ITEMS + NV_ITEMS;
__device__ __forceinline__ TItem decode_item(CPP P, int it) {
    TItem d; unsigned char* ws = P->ws;
    if (it < NW_ITEMS) {
        const int l = it / PER_LAYER, r = it % PER_LAYER;
        unsigned char* wl = ws + WS_W + (size_t)l * W_LAYER;
        if (r < 8448) {
            const int mi = r / 1408, rr = r % 1408, ffn = mi / 3, kind = mi % 3;
            if (kind < 2) {
                const int nb = rr % 88, kb = rr / 88; d.n0 = 32 * nb; d.k0 = 64 * kb;
                d.W = P->in[(ffn ? 24 : 6) + kind] + (size_t)l * DM * DFF; d.gain = P->in[ffn ? 23 : 5] + l * DM; d.N = DFF;
                d.WT = (bf16*)(wl + (ffn ? W_GU2 : W_GU1)); d.pitch = DM; d.drow = 256 * (d.n0 >> 7) + 128 * kind + (d.n0 & 127);
            } else {
                const int nb = rr % 32, kb = rr / 32; d.n0 = 32 * nb; d.k0 = 64 * kb;
                d.W = P->in[ffn ? 26 : 8] + (size_t)l * DFF * DM; d.gain = nullptr; d.N = DM;
                d.WT = (bf16*)(wl + (ffn ? W_D2 : W_D1)); d.pitch = DFF; d.drow = d.n0;
            }
        } else if (r < 8448 + 1280) {
            const int rr = r - 8448, nb = rr % 80, kb = rr / 80; d.n0 = 32 * nb; d.k0 = 64 * kb;
            d.W = P->in[10] + (size_t)l * DM * DIN; d.gain = P->in[9] + l * DM; d.N = DIN; d.WT = (bf16*)(wl + W_IN); d.pitch = DM; d.drow = win_dst_row(d.n0);
        } else {
            const int rr = r - 8448 - 1280, nb = rr % 32, kb = rr / 32; d.n0 = 32 * nb; d.k0 = 64 * kb;
            d.W = P->in[22] + (size_t)l * DM * DM; d.gain = nullptr; d.N = DM; d.WT = (bf16*)(wl + W_OUT); d.pitch = DM; d.drow = d.n0;
        }
    } else {
        const int r = it - NW_ITEMS, lb = r >> 7, rr = r & 127, nb = rr & 15, kb = rr >> 4;
        d.n0 = 32 * nb; d.k0 = 64 * kb; d.W = P->in[4] + (size_t)lb * 512 * 512; d.gain = nullptr; d.N = 512;
        d.WT = (bf16*)(ws + WS_SVT) + (size_t)lb * 512 * 576; d.pitch = 576; d.drow = d.n0;
    }
    return d;
}
__device__ __forceinline__ void item_load(const TItem& d, int lane, float (&v)[32]) {
    const float* p = d.W + (size_t)(d.k0 + (lane >> 5)) * d.N + d.n0 + (lane & 31);
#pragma unroll
    for (int i = 0; i < 32; ++i) v[i] = p[(size_t)(2 * i) * d.N];
}
__device__ __forceinline__ void item_store(const TItem& d, int lane, const float (&v)[32], LAS float* scr) {
#pragma unroll
    for (int i = 0; i < 32; ++i) scr[(2 * i + (lane >> 5)) * 33 + (lane & 31)] = v[i];
    asm volatile("s_waitcnt lgkmcnt(0)" ::: "memory");
    const int c = lane & 7;
    f32x4 g0 = (f32x4){1.f, 1.f, 1.f, 1.f}, g1 = g0;
    if (d.gain) { g0 = *(const f32x4*)(d.gain + d.k0 + 8 * c); g1 = *(const f32x4*)(d.gain + d.k0 + 8 * c + 4); }
#pragma unroll
    for (int j = 0; j < 4; ++j) { const int n = (lane >> 3) + 8 * j; const LAS float* s = scr + (8 * c) * 33 + n;
        u32x4 o; o.x = pk2(s[0 * 33] * g0[0], s[1 * 33] * g0[1]); o.y = pk2(s[2 * 33] * g0[2], s[3 * 33] * g0[3]); o.z = pk2(s[4 * 33] * g1[0], s[5 * 33] * g1[1]); o.w = pk2(s[6 * 33] * g1[2], s[7 * 33] * g1[3]);
        *(u32x4*)(d.WT + (size_t)(d.drow + n) * d.pitch + d.k0 + 8 * c) = o; }
    asm volatile("s_waitcnt lgkmcnt(0)" ::: "memory");
}
__device__ __forceinline__ void convert_caches(CPP P, int l, int gt, int NGT) {
    unsigned char* ws = P->ws;
    bf16* SK = (bf16*)(ws + WS_SK); bf16* SV = (bf16*)(ws + WS_SVT);
    for (int i0 = gt; i0 < 16 * 512 * 64; i0 += 4 * NGT) {
        f32x4 a[4], b[4];
#pragma unroll
        for (int q = 0; q < 4; ++q) { const int i = i0 + q * NGT; const int ii = i < 16 * 512 * 64 ? i : i0; const int c8 = ii & 63, s_ = (ii >> 6) & 511, lb = l * 16 + (ii >> 15);
            const f32x4* srck = (const f32x4*)(P->in[3] + ((size_t)(lb * 512 + s_)) * 512 + 8 * c8); a[q] = srck[0]; b[q] = srck[1]; }
#pragma unroll
        for (int q = 0; q < 4; ++q) { const int i = i0 + q * NGT;
            if (i < 16 * 512 * 64) { const int c8 = i & 63, s_ = (i >> 6) & 511, lb = l * 16 + (i >> 15), head = c8 >> 3, d0 = (c8 & 7) * 8;
                u32x4 w; w.x = pk2(a[q][0], a[q][1]); w.y = pk2(a[q][2], a[q][3]); w.z = pk2(b[q][0], b[q][1]); w.w = pk2(b[q][2], b[q][3]);
                *(u32x4*)(SK + (size_t)lb * 294912 + (size_t)(head * 18 + (s_ >> 5)) * 2048 + ((((d0 >> 4) * 2 + ((d0 >> 3) & 1)) * 32) + (s_ & 31)) * 8) = w; } }
    }
    for (int i0 = gt; i0 < 16 * 64 * 512; i0 += 2 * NGT) {
        float v[2][8];
#pragma unroll
        for (int q = 0; q < 2; ++q) { const int i = i0 + q * NGT; const int ii = i < 16 * 64 * 512 ? i : i0; const int ch = ii & 511, kg = (ii >> 9) & 63, lb = l * 16 + (ii >> 15), kb = kg >> 2, sx = (kg >> 1) & 1, hx = kg & 1;
            const float* src = P->in[4] + ((size_t)(lb * 512 + 32 * kb + 16 * sx + 4 * hx)) * 512 + ch;
#pragma unroll
            for (int j = 0; j < 8; ++j) v[q][j] = src[(size_t)(8 * (j >> 2) + (j & 3)) * 512]; }
#pragma unroll
        for (int q = 0; q < 2; ++q) { const int i = i0 + q * NGT;
            if (i < 16 * 64 * 512) { const int ch = i & 511, kg = (i >> 9) & 63, lb = l * 16 + (i >> 15), kb = kg >> 2, sx = (kg >> 1) & 1, hx = kg & 1, head = ch >> 6, d = ch & 63;
                u32x4 w; w.x = pk2(v[q][0], v[q][1]); w.y = pk2(v[q][2], v[q][3]); w.z = pk2(v[q][4], v[q][5]); w.w = pk2(v[q][6], v[q][7]);
                *(u32x4*)(SV + (size_t)lb * 294912 + (size_t)(head * 18 + kb) * 2048 + (((((d >> 5) * 2 + sx) * 2 + hx) * 32) + (d & 31)) * 8) = w; } }
    }
}
__device__ __forceinline__ void convert_items(CPP P, LAS unsigned char* lds, int it0, int it1, int worker, int nworkers, int wave, int lane) {
    LAS float* scr = (LAS float*)(lds + wave * 16384);
    const int gw = it0 + worker * NWAVES + wave, NGW = nworkers * NWAVES;
    if (gw < it1) {
        TItem cur = decode_item(P, gw); float v[32]; item_load(cur, lane, v);
#pragma unroll 1
        for (int it = gw; it < it1; it += NGW) {
            const int nx = it + NGW; const bool has = nx < it1;
            TItem nd = decode_item(P, has ? nx : it); float vn[32];
            if (has) item_load(nd, lane, vn);
            item_store(cur, lane, v, scr);
            if (has) {
#pragma unroll
                for (int i = 0; i < 32; ++i) v[i] = vn[i];
                cur = nd; }
        }
    }
}
__device__ __forceinline__ void prologue(CPP P, LAS unsigned char* lds, int vb, int G, int wave, int lane) {
    LAS float* scr = (LAS float*)(lds + wave * 16384);
    const int gw = vb * NWAVES + wave, NGW = G * NWAVES;
    unsigned char* ws = P->ws;
    convert_items(P, lds, 0, PER_LAYER, vb, G, wave, lane);
    bf16* XB = (bf16*)(ws + WS_XB); float* ssq = (float*)(ws + WS_SSQ);
    for (int m0 = gw; m0 < MROWS; m0 += 4 * NGW) {
        f32x4 a[4][4];
#pragma unroll
        for (int q = 0; q < 4; ++q) { const int m = m0 + q * NGW; const int mm = m < MROWS ? m : m0;
            const float* xr = (mm < NP) ? P->in[0] + (size_t)mm * DM : P->in[1] + (size_t)(mm - NP) * DM;
#pragma unroll
            for (int j = 0; j < 4; ++j) a[q][j] = ((const f32x4*)xr)[lane + 64 * j]; }
#pragma unroll
        for (int q = 0; q < 4; ++q) { const int m = m0 + q * NGW;
            if (m < MROWS) { float s0 = 0.f;
#pragma unroll
                for (int j = 0; j < 4; ++j) { s0 += (a[q][j][0] * a[q][j][0] + a[q][j][1] * a[q][j][1]) + (a[q][j][2] * a[q][j][2] + a[q][j][3] * a[q][j][3]);
                    u32x2 w; w.x = pk2(a[q][j][0], a[q][j][1]); w.y = pk2(a[q][j][2], a[q][j][3]); ((u32x2*)(XB + (size_t)m * DM))[lane + 64 * j] = w; }
                s0 += __shfl_xor(s0, 16); s0 += __shfl_xor(s0, 32);
                if (lane < 16) ssq[(size_t)m * 16 + lane] = s0; } }
    }
    const int gt = vb * (NWAVES * 64) + wave * 64 + lane, NGT = G * NWAVES * 64;
    bf16* WT = (bf16*)(ws + WS_WTRIL);
    for (int i = gt; i < NL * 4 * 128 * 128; i += NGT) { const int s = i & 127, t = (i >> 7) & 127; WT[i] = (bf16)(s <= t ? f2bf(P->in[17][i]) : 0u); }
    convert_caches(P, 0, gt, NGT);
}

#define MFMA32(a, b, c) __builtin_amdgcn_mfma_f32_32x32x16_bf16((a), (b), (c), 0, 0, 0)
template <int KH>
__device__ __forceinline__ void attn_block(const bf16x8 (&Kf)[4], const bf16x8 (&Vf)[2][2], const bf16x8 (&Qf)[2][4], f32x16 (&O)[2][2], float (&mrun)[2], float (&lsum)[2],
                                           int delta, int r, int hi, const LAS float* tblR) {
    f32x16 S[2];
    if (delta >= 3) {
#pragma unroll
        for (int qb = 0; qb < 2; ++qb)
#pragma unroll
            for (int i = 0; i < 16; ++i) S[qb][i] = 0.f; }
    else {
#pragma unroll
        for (int qb = 0; qb < 2; ++qb) { const LAS float* tp = tblR + (191 - (64 * delta + (32 * qb + r) - (32 * KH + 4 * hi)));
#pragma unroll
            for (int i = 0; i < 16; ++i) S[qb][i] = tp[(i & 3) + 8 * (i >> 2)]; } }
#pragma unroll
    for (int kk = 0; kk < 4; ++kk)
#pragma unroll
        for (int qb = 0; qb < 2; ++qb) S[qb] = MFMA32(Kf[kk], Qf[qb][kk], S[qb]);
    float mx[2], mnew[2], alpha[2];
#pragma unroll
    for (int qb = 0; qb < 2; ++qb) { float m = fmaxf(fmaxf(S[qb][0], S[qb][1]), fmaxf(S[qb][2], S[qb][3]));
#pragma unroll
        for (int i = 4; i < 16; i += 2) m = fmaxf(m, fmaxf(S[qb][i], S[qb][i + 1]));
        mx[qb] = m; }
#pragma unroll
    for (int qb = 0; qb < 2; ++qb) mx[qb] = fmaxf(mx[qb], __shfl_xor(mx[qb], 32));
#pragma unroll
    for (int qb = 0; qb < 2; ++qb) { mnew[qb] = fmaxf(mrun[qb], mx[qb]); alpha[qb] = fast_exp2(mrun[qb] - mnew[qb]); mrun[qb] = mnew[qb]; }
#pragma unroll
    for (int i = 0; i < 16; ++i)
#pragma unroll
        for (int qb = 0; qb < 2; ++qb) S[qb][i] = fast_exp2(S[qb][i] - mnew[qb]);
#pragma unroll
    for (int qb = 0; qb < 2; ++qb) {
        const float ps = (((S[qb][0] + S[qb][1]) + (S[qb][2] + S[qb][3])) + ((S[qb][4] + S[qb][5]) + (S[qb][6] + S[qb][7]))) + (((S[qb][8] + S[qb][9]) + (S[qb][10] + S[qb][11])) + ((S[qb][12] + S[qb][13]) + (S[qb][14] + S[qb][15])));
        lsum[qb] = lsum[qb] * alpha[qb] + ps; }
    if (__builtin_amdgcn_ballot_w64(alpha[0] != 1.f || alpha[1] != 1.f) != 0ull) {
#pragma unroll
        for (int qb = 0; qb < 2; ++qb)
#pragma unroll
            for (int db = 0; db < 2; ++db)
#pragma unroll
                for (int i = 0; i < 16; ++i) O[db][qb][i] *= alpha[qb]; }
    bf16x8 Pf[2][2];
#pragma unroll
    for (int qb = 0; qb < 2; ++qb)
#pragma unroll
        for (int s = 0; s < 2; ++s) { u32x4 w; w.x = pk2(S[qb][8 * s], S[qb][8 * s + 1]); w.y = pk2(S[qb][8 * s + 2], S[qb][8 * s + 3]); w.z = pk2(S[qb][8 * s + 4], S[qb][8 * s + 5]); w.w = pk2(S[qb][8 * s + 6], S[qb][8 * s + 7]); Pf[qb][s] = __builtin_bit_cast(bf16x8, w); }
#pragma unroll
    for (int s = 0; s < 2; ++s)
#pragma unroll
        for (int qb = 0; qb < 2; ++qb)
#pragma unroll
            for (int db = 0; db < 2; ++db) O[db][qb] = MFMA32(Vf[db][s], Pf[qb][s], O[db][qb]);
}
__device__ __forceinline__ void attn_unit(CPP P, int l, int u, int wave, int lane, const LAS float* tblR) {
    unsigned char* ws = P->ws;
    const int h = wave, r = lane & 31, hi = lane >> 5;
    const bf16* Kb0; const bf16* Vb0; int ntiles, row0;
    int cm = 0;
    if (u < 512) { const int b = u >> 7, c = u & 127; cm = c % 9; row0 = b * SEQ + 64 * c; ntiles = (c < 8 ? c : 8) + 1; const int kbg0 = (row0 - 64 * (ntiles - 1)) >> 5;
        Kb0 = (const bf16*)(ws + WS_PK) + (size_t)(h * 1024 + kbg0) * 2048; Vb0 = (const bf16*)(ws + WS_PVT) + (size_t)(h * 1024 + kbg0) * 2048; }
    else { const int b = u - 512; row0 = NP + 64 * b; ntiles = 9;
        Kb0 = (const bf16*)(ws + WS_SK) + (size_t)(l * 16 + b) * 294912 + (size_t)(h * 18) * 2048; Vb0 = (const bf16*)(ws + WS_SVT) + (size_t)(l * 16 + b) * 294912 + (size_t)(h * 18) * 2048; }
    const bf16* Qp = (const bf16*)(ws + WS_Q) + (size_t)row0 * 512 + h * 64;
    bf16x8 Qf[2][4];
#pragma unroll
    for (int qb = 0; qb < 2; ++qb)
#pragma unroll
        for (int kk = 0; kk < 4; ++kk) Qf[qb][kk] = *(const bf16x8*)(Qp + (size_t)(32 * qb + r) * 512 + 16 * kk + 8 * hi);
    f32x16 O[2][2];
#pragma unroll
    for (int a = 0; a < 2; ++a)
#pragma unroll
        for (int b = 0; b < 2; ++b)
#pragma unroll
            for (int i = 0; i < 16; ++i) O[a][b][i] = 0.f;
    float mrun[2] = {-1e30f, -1e30f}, lsum[2] = {0.f, 0.f};
#define ATT_LOAD_K(kb_, Kd) do { const bf16* kp_ = Kb0 + (size_t)(kb_) * 2048 + (hi * 32 + r) * 8; \
        _Pragma("unroll") for (int kk = 0; kk < 4; ++kk) Kd[kk] = *(const bf16x8*)(kp_ + kk * 512); } while (0)
#define ATT_LOAD_V(kb_, Vd) do { const bf16* vp_ = Vb0 + (size_t)(kb_) * 2048 + (hi * 32 + r) * 8; \
        _Pragma("unroll") for (int db = 0; db < 2; ++db) _Pragma("unroll") for (int s_ = 0; s_ < 2; ++s_) Vd[db][s_] = *(const bf16x8*)(vp_ + (db * 2 + s_) * 512); } while (0)
    const bool full = (ntiles == 9);
#define ATT_TILE_OF(t_) (full ? 8 - ((cm - (t_) + 9) % 9) : (t_))
    bf16x8 K0[4], K1[4], Vc[2][2];
    int ti = ATT_TILE_OF(0);
    ATT_LOAD_K(2 * ti, K0);
#pragma unroll 1
    for (int t = 0; t < ntiles; ++t) {
        const int delta = (ntiles - 1) - ti;
        ATT_LOAD_K(2 * ti + 1, K1); ATT_LOAD_V(2 * ti, Vc);
        attn_block<0>(K0, Vc, Qf, O, mrun, lsum, delta, r, hi, tblR);
        const int tn = (t + 1 < ntiles) ? ATT_TILE_OF(t + 1) : ti;
        ATT_LOAD_K(2 * tn, K0); ATT_LOAD_V(2 * ti + 1, Vc);
        attn_block<1>(K1, Vc, Qf, O, mrun, lsum, delta, r, hi, tblR);
        ti = tn;
    }
#undef ATT_TILE_OF
#undef ATT_LOAD_K
#undef ATT_LOAD_V
    bf16* MX = (bf16*)(ws + WS_MIX);
#pragma unroll
    for (int qb = 0; qb < 2; ++qb) {
        const float lt = lsum[qb] + __shfl_xor(lsum[qb], 32), inv = 1.f / lt;
        bf16* orow = MX + (size_t)(row0 + 32 * qb + r) * DM + 512 + h * 64;
#pragma unroll
        for (int db = 0; db < 2; ++db)
#pragma unroll
            for (int g = 0; g < 4; ++g) { u32x2 w; w.x = pk2(O[db][qb][4 * g] * inv, O[db][qb][4 * g + 1] * inv); w.y = pk2(O[db][qb][4 * g + 2] * inv, O[db][qb][4 * g + 3] * inv);
                *(u32x2*)(orow + 32 * db + 8 * g + 4 * hi) = w; }
    }
}
constexpr int VPITCH = 136;
__device__ __forceinline__ void gmlp_unit(CPP P, int l, int g, int wave, int lane, LAS bf16* vnT) {
    unsigned char* ws = P->ws;
    const bool samp = g >= 256;
    const int row0 = samp ? NP + 64 * (g - 256) : 128 * g, T = samp ? 64 : 128;
    const bf16* VG = (const bf16*)(ws + WS_VG);
    const f32x4 gg = *(const f32x4*)(P->in[15] + l * 256 + 4 * lane), bb = *(const f32x4*)(P->in[16] + l * 256 + 4 * lane);
    const int h = wave >> 1, th = wave & 1, r = lane & 31, hi = lane >> 5;
    const int nks = (th == 0) ? 4 : 8;
    const bf16* Wp = (const bf16*)(ws + WS_WTRIL) + ((size_t)(l * 4 + h) * 128) * 128;
    bf16x8 Bw[8][2];
    if (64 * th < T) {
#pragma unroll
        for (int ks = 0; ks < 8; ++ks)
#pragma unroll
            for (int tb = 0; tb < 2; ++tb) if (ks < nks) Bw[ks][tb] = *(const bf16x8*)(Wp + (size_t)(64 * th + 32 * tb + r) * 128 + 16 * ks + 8 * hi);
    }
    {
        const int nq = T >> 3;
        u32x2 raw[16];
#pragma unroll
        for (int q = 0; q < 16; ++q) if (q < nq) raw[q] = *(const u32x2*)(VG + (size_t)(row0 + 4 * wave + 32 * (q >> 2) + (q & 3)) * 256 + 4 * lane);
        f32x4 x[16]; float sm[16], sq[16];
#pragma unroll
        for (int q = 0; q < 16; ++q) if (q < nq) { x[q] = (f32x4){__builtin_bit_cast(float, raw[q].x << 16), __builtin_bit_cast(float, raw[q].x & 0xffff0000u), __builtin_bit_cast(float, raw[q].y << 16), __builtin_bit_cast(float, raw[q].y & 0xffff0000u)};
            sm[q] = (x[q][0] + x[q][1]) + (x[q][2] + x[q][3]); }
#pragma unroll
        for (int o = 1; o < 64; o <<= 1)
#pragma unroll
            for (int q = 0; q < 16; ++q) if (q < nq) sm[q] += __shfl_xor(sm[q], o);
#pragma unroll
        for (int q = 0; q < 16; ++q) if (q < nq) { x[q] = x[q] - sm[q] * (1.f / 256.f); sq[q] = (x[q][0] * x[q][0] + x[q][1] * x[q][1]) + (x[q][2] * x[q][2] + x[q][3] * x[q][3]); }
#pragma unroll
        for (int o = 1; o < 64; o <<= 1)
#pragma unroll
            for (int q = 0; q < 16; ++q) if (q < nq) sq[q] += __shfl_xor(sq[q], o);
#pragma unroll
        for (int q = 0; q < 16; ++q) if (q < nq) { const float rstd = __builtin_amdgcn_rsqf(sq[q] * (1.f / 256.f) + EPS); const f32x4 y = x[q] * rstd * gg + bb; const int t = 4 * wave + 32 * (q >> 2) + (q & 3);
            if (samp) *(f32x4*)(P->out + O_SG + ((size_t)((l * 16 + (g - 256)) * 64 + t)) * 256 + 4 * lane) = y;
            const unsigned p01 = pk2(y[0], y[1]), p23 = pk2(y[2], y[3]);
            vnT[(4 * lane + 0) * VPITCH + t] = (bf16)(p01 & 0xffffu); vnT[(4 * lane + 1) * VPITCH + t] = (bf16)(p01 >> 16);
            vnT[(4 * lane + 2) * VPITCH + t] = (bf16)(p23 & 0xffffu); vnT[(4 * lane + 3) * VPITCH + t] = (bf16)(p23 >> 16); }
    }
    __syncthreads();
    if (64 * th < T) {
        f32x16 acc[2][2];
#pragma unroll
        for (int a = 0; a < 2; ++a)
#pragma unroll
            for (int b = 0; b < 2; ++b)
#pragma unroll
                for (int i = 0; i < 16; ++i) acc[a][b][i] = 0.f;
#pragma unroll
        for (int ks = 0; ks < 8; ++ks) if (ks < nks) {
            bf16x8 A[2];
#pragma unroll
            for (int db = 0; db < 2; ++db) A[db] = *(const LAS bf16x8*)(vnT + (h * 64 + 32 * db + r) * VPITCH + 16 * ks + 8 * hi);
#pragma unroll
            for (int db = 0; db < 2; ++db)
#pragma unroll
                for (int tb = 0; tb < 2; ++tb) acc[db][tb] = MFMA32(A[db], Bw[ks][tb], acc[db][tb]);
        }
        const bf16* U = (const bf16*)(ws + WS_U); bf16* MX = (bf16*)(ws + WS_MIX);
#pragma unroll
        for (int tb = 0; tb < 2; ++tb) {
            const int t = 64 * th + 32 * tb + r, row = row0 + t;
            const float bias = P->in[18][(l * 4 + h) * 128 + t];
#pragma unroll
            for (int db = 0; db < 2; ++db)
#pragma unroll
                for (int g4 = 0; g4 < 4; ++g4) { const int d = 32 * db + 8 * g4 + 4 * hi;
                    const u32x2 uu = *(const u32x2*)(U + (size_t)row * 256 + h * 64 + d);
                    const float u0 = __builtin_bit_cast(float, uu.x << 16), u1 = __builtin_bit_cast(float, uu.x & 0xffff0000u), u2 = __builtin_bit_cast(float, uu.y << 16), u3 = __builtin_bit_cast(float, uu.y & 0xffff0000u);
                    u32x2 w; w.x = pk2((acc[db][tb][4 * g4] + bias) * u0, (acc[db][tb][4 * g4 + 1] + bias) * u1); w.y = pk2((acc[db][tb][4 * g4 + 2] + bias) * u2, (acc[db][tb][4 * g4 + 3] + bias) * u3);
                    *(u32x2*)(MX + (size_t)row * DM + 256 + h * 64 + d) = w; }
        }
    }
    __syncthreads();
}
constexpr int CW_OFF = 73728;
__device__ __forceinline__ void conv_units(CPP P, int l, int first, int stride, int wave, int lane, const LAS float* cwL) {
    unsigned char* ws = P->ws;
    const f32x4 cb = *(const f32x4*)(P->in[12] + l * 256 + 4 * lane), lg = *(const f32x4*)(P->in[13] + l * 256 + 4 * lane), lb = *(const f32x4*)(P->in[14] + l * 256 + 4 * lane);
    const bf16* GLU = (const bf16*)(ws + WS_GLU); bf16* MX = (bf16*)(ws + WS_MIX);
    const LAS f32x4* cw = (const LAS f32x4*)cwL + lane;
    for (int tile = first; tile < 528; tile += stride) {
        const int row0 = 64 * tile + 8 * wave;
        const int grow0 = (tile >= 512) ? (GLU_SROW0 + (tile - 512) * 94 + 8 * wave) : ((tile >> 7) * GLU_PB + (tile & 127) * 64 + 8 * wave);
        f32x4 acc[8];
#pragma unroll
        for (int tt = 0; tt < 8; ++tt) acc[tt] = cb;
        u32x2 xr[38];
#pragma unroll
        for (int j = 0; j < 38; ++j) xr[j] = *(const u32x2*)(GLU + (size_t)(grow0 + j) * 256 + 4 * lane);
        __builtin_amdgcn_sched_barrier(0);
        f32x4 wv[31];
#pragma unroll
        for (int j = 0; j < 38; ++j) {
            const u32x2 w = xr[j];
            const f32x4 x = (f32x4){__builtin_bit_cast(float, w.x << 16), __builtin_bit_cast(float, w.x & 0xffff0000u), __builtin_bit_cast(float, w.y << 16), __builtin_bit_cast(float, w.y & 0xffff0000u)};
            if (j <= 30) wv[j] = cw[j * 64];
#pragma unroll
            for (int tt = 0; tt < 8; ++tt) { const int tap = j - tt; if (tap >= 0 && tap <= 30) acc[tt] += wv[tap] * x; }
            __builtin_amdgcn_sched_barrier(0);
        }
        float sm[8], sq[8];
#pragma unroll
        for (int tt = 0; tt < 8; ++tt) sm[tt] = (acc[tt][0] + acc[tt][1]) + (acc[tt][2] + acc[tt][3]);
#pragma unroll
        for (int o = 1; o < 64; o <<= 1)
#pragma unroll
            for (int tt = 0; tt < 8; ++tt) sm[tt] += __shfl_xor(sm[tt], o);
#pragma unroll
        for (int tt = 0; tt < 8; ++tt) { acc[tt] = acc[tt] - sm[tt] * (1.f / 256.f); sq[tt] = (acc[tt][0] * acc[tt][0] + acc[tt][1] * acc[tt][1]) + (acc[tt][2] * acc[tt][2] + acc[tt][3] * acc[tt][3]); }
#pragma unroll
        for (int o = 1; o < 64; o <<= 1)
#pragma unroll
            for (int tt = 0; tt < 8; ++tt) sq[tt] += __shfl_xor(sq[tt], o);
#pragma unroll
        for (int tt = 0; tt < 8; ++tt) {
            const float rstd = __builtin_amdgcn_rsqf(sq[tt] * (1.f / 256.f) + EPS);
            const f32x4 y = acc[tt] * rstd * lg + lb;
            u32x2 w; w.x = pk2(siluf_(y[0]), siluf_(y[1])); w.y = pk2(siluf_(y[2]), siluf_(y[3]));
            *(u32x2*)(MX + (size_t)(row0 + tt) * DM + 4 * lane) = w;
        }
    }
}

__global__ void __launch_bounds__(NWAVES * 64, 2) mega_fwd(Params Pk) {
    extern __shared__ __attribute__((aligned(16))) unsigned char lds_raw[];
    LAS unsigned char* lds = (LAS unsigned char*)lds_raw;
    cg::grid_group grid = cg::this_grid();
    const int tid = threadIdx.x, lane = tid & 63, wave = __builtin_amdgcn_readfirstlane(tid >> 6);
    constexpr int G = GRID_WG; const int bx = blockIdx.x;
    const int vb = (G % 8 == 0) ? (bx % 8) * (G / 8) + bx / 8 : bx;
    unsigned char* ws = kparams()->ws;
    float* ssq = (float*)(ws + WS_SSQ); LAS float* rsbuf = (LAS float*)(lds + RS_OFF);
    bf16* XB = (bf16*)(ws + WS_XB); bf16* AH = (bf16*)(ws + WS_A); bf16* MX = (bf16*)(ws + WS_MIX);

    if (tid < 4) ((LAS unsigned*)(lds + XB_OFF))[tid] = 0u;
    __syncthreads();
    const XcdBarrier xbar = xcd_barrier_post((unsigned*)(ws + WS_BAR), (volatile LAS unsigned*)(lds + XB_OFF));
#ifndef DIS_PRO
    for (int rep = 0; rep < REP_PRO; ++rep) { prologue(kparams(), lds, vb, G, wave, lane); __syncthreads(); }
#endif
    if (ws == nullptr) grid.sync();
    xcd_barrier(xbar);

#pragma unroll 1
    for (int l = 0; l < NL; ++l) {
        unsigned char* wl = ws + WS_W + (size_t)l * W_LAYER;
#pragma unroll 1
        for (int k = 0; k < 10; ++k) { const int st = (k < 6) ? k : (k == 6 ? 9 : k - 1);
            CPP P = kparams();
            int bxl = blockIdx.x; asm volatile("" : "+s"(bxl));
            unsigned* cnt = (unsigned*)(ws + WS_CNT) + 64 * (2 * l + ((st >= 5 && st != 9) ? 1 : 0));
            unsigned* cntO = (unsigned*)(ws + WS_CNT) + 64 * (4 + l);
            if (st == 0 || st == 6) {
                pg8::Gemm g{XB, (const bf16*)(wl + (st ? W_GU2 : W_GU1)), MROWS, 2 * DFF, DM};
                GuOrder S; S.init(MROWS, 2 * DFF, G, bxl); S.ssq = ssq; S.rsbuf = rsbuf; S.cnt = cnt; S.wait_cnt = st ? cntO : nullptr; S.samp_i = st ? 2 : 0;
                EpiSwiGLU E{AH, rsbuf};
                { int t_ = threadIdx.x; asm volatile("" : "+v"(t_)); rs_fill(S, ssq, rsbuf, t_); }
#ifndef DIS_GU
                pg8::gemm_phase<EpiSwiGLU, GuOrder, true, true>(lds, g, S, E);
#endif
            } else if (st == 1 || st == 2 || st == 5 || st == 7 || st == 8 || st == 9) {
                const bool first = (l == 0 && st <= 2), samp = (st == 1 || st == 7), isout = (st == 5 || st == 9);
                if (samp && bxl >= 240) {
                    if (threadIdx.x == 0) { unsigned sp = 0; while (__hip_atomic_load(cnt, __ATOMIC_RELAXED, __HIP_MEMORY_SCOPE_AGENT) < 88u && ++sp < (1u << 24)) __builtin_amdgcn_s_sleep(2);
                        __builtin_amdgcn_fence(__ATOMIC_ACQUIRE, "agent"); asm volatile("s_waitcnt vmcnt(0)" ::: "memory"); }
                    __syncthreads();
                }
                pg8::Gemm g{isout ? MX : AH, (const bf16*)(wl + (isout ? W_OUT : (st < 5 ? W_D1 : W_D2))), MROWS, DM, isout ? DM : DFF};
                RangeOrder S;
                S.pub = nullptr;
                if (samp) { S.init(NS, DM, 16, bxl - 240); S.pm0 = NP / 256; } else if (st == 9) { S.init(NS, DM, 16, (bxl >= 224 && bxl < 240) ? bxl - 224 : -1); S.pm0 = NP / 256; S.pub = cntO; } else { S.init(NP, DM, G, bxl); S.pm0 = 0; }
                const bool lastg = (l == NL - 1 && (st == 7 || st == 8));
                EpiResid E{first ? P->in[0] : nullptr, first ? P->in[1] : nullptr, lastg ? P->out : nullptr, XB, lastg ? nullptr : XB, ssq, isout ? 1.f : 0.5f};
#ifndef DIS_RES
                pg8::gemm_phase<EpiResid, RangeOrder, true, true>(lds, g, S, E);
#endif
            } else if (st == 3) {
                pg8::Gemm g{XB, (const bf16*)(wl + W_IN), MROWS, DIN, DM};
                { int t_ = threadIdx.x; asm volatile("" : "+v"(t_));
                  bf16* GLU = (bf16*)(ws + WS_GLU);
                  for (int i = bxl * (NWAVES * 64) + t_; i < 20 * 30 * 64; i += G * (NWAVES * 64)) {
                      const int c4 = i & 63, p = (i >> 6) % 30, sb = i / (64 * 30);
                      u32x2 w; w.x = 0u; w.y = 0u; int grow;
                      if (sb < 4) grow = sb * GLU_PB + p;
                      else { grow = GLU_SROW0 + (sb - 4) * 94 + p; const f32x4 c = *(const f32x4*)(P->in[2] + ((size_t)((l * 16 + (sb - 4)) * 30 + p)) * 256 + 4 * c4); w.x = pk2(c[0], c[1]); w.y = pk2(c[2], c[3]); }
                      *(u32x2*)(GLU + (size_t)grow * 256 + 4 * c4) = w; } }
                RsOrder S; S.init(MROWS, DIN, G, bxl); S.ssq = ssq; S.rsbuf = rsbuf;
                EpiMix E{rsbuf, P->in[19] + l * 64, P->in[20] + l * 64, ws, P->out, l, lds + VSCR_OFF};
                { int t_ = threadIdx.x; asm volatile("" : "+v"(t_)); rs_fill(S, ssq, rsbuf, t_); }
#ifndef DIS_IN
                pg8::gemm_phase<EpiMix, RsOrder, true, true>(lds, g, S, E);
#endif
                if (l == 0 && bxl >= 40) { int t_ = threadIdx.x; asm volatile("" : "+v"(t_)); convert_items(P, lds, PER_LAYER, 2 * PER_LAYER, bxl - 40, G - 40, __builtin_amdgcn_readfirstlane(t_ >> 6), t_ & 63);
                    convert_caches(P, 1, (bxl - 40) * (NWAVES * 64) + t_, (G - 40) * (NWAVES * 64)); }
            } else {
                for (int rep = 0; rep < REP_MIX; ++rep) {
                int tid_ = threadIdx.x; asm volatile("" : "+v"(tid_)); const int lane_ = tid_ & 63;
                LAS float* tblR = (LAS float*)(lds + BIAS_OFF) + wave * 260;
                for (int j = lane_; j < 256; j += 64) { const int rel = 191 - j; const int idx = (j == 255 || rel > 128) ? 256 : rel + 128; tblR[j] = (P->in[21][(size_t)(l * 8 + wave) * 257 + idx] - P->in[21][(size_t)(l * 8 + wave) * 257 + 256]) * LOG2E; }
                { LAS float* cwL0 = (LAS float*)(lds + CW_OFF);
                  for (int i = tid_; i < 31 * 256; i += NWAVES * 64) cwL0[i] = P->in[11][(size_t)l * 31 * 256 + i]; }
                asm volatile("s_waitcnt lgkmcnt(0)" ::: "memory");
                __syncthreads();
#ifndef DIS_ATTN
                const int vbm = (bxl % 8) * (G / 8) + bxl / 8;
                if (wave >= 4) __builtin_amdgcn_s_sleep(24);
                for (int sl = vbm; sl < 512; sl += G) {
                    int u0, u1 = 0, nu = 1;
                    if (sl < 480) u0 = (sl / 120) * 128 + 8 + (sl % 120);
                    else if (sl < 496) u0 = 512 + (sl - 480);
                    else { const int q = sl - 496, ub = (q >> 2) * 128, c1 = q & 3; u0 = ub + c1; u1 = ub + 7 - c1; nu = 2; }
#pragma unroll 1
                    for (int k = 0; k < nu; ++k) attn_unit(P, l, k ? u1 : u0, wave, lane_, tblR);
                }
#endif
                const int R = G, jr = bxl;
#ifndef DIS_GMLP
                if (jr >= 0) for (int k = jr; k < 272; k += R) gmlp_unit(P, l, k, wave, lane_, (LAS bf16*)lds);
#endif
#ifndef DIS_CONV
                { LAS float* cwL = (LAS float*)(lds + CW_OFF);
                  if (jr >= 0) conv_units(P, l, R - 1 - jr, R, wave, lane_, cwL); }
#endif
                __syncthreads(); }
            }
            if (!(l == NL - 1 && st == 8) && st != 0 && st != 6 && st != 9) for (int rep = 0; rep < REP_SYNC; ++rep) xcd_barrier(xbar);
        }
    }
}

extern "C" void kernel_launch(void* const* d_in, const int* in_sizes, int n_in, void* d_out, int out_size, void* d_ws, size_t ws_size, hipStream_t stream) {
    static int grid = 0;
    if (grid == 0) {
        if (n_in != 27 || (size_t)out_size != O_END || ws_size < WS_END) { fprintf(stderr, "kernel_launch: unexpected shapes n_in %d out %d ws %zu\n", n_in, out_size, ws_size); grid = -1; return; }
        int dev = 0, cus = 0, per_cu = 0;
        (void)hipGetDevice(&dev); (void)hipDeviceGetAttribute(&cus, hipDeviceAttributeMultiprocessorCount, dev);
        if (hipFuncSetAttribute((const void*)mega_fwd, hipFuncAttributeMaxDynamicSharedMemorySize, LDS_BYTES) != hipSuccess) { fprintf(stderr, "kernel_launch: hipFuncSetAttribute failed\n"); grid = -1; return; }
        if (hipOccupancyMaxActiveBlocksPerMultiprocessor(&per_cu, (const void*)mega_fwd, NWAVES * 64, LDS_BYTES) != hipSuccess || per_cu < 1) { fprintf(stderr, "kernel_launch: occupancy query gave %d\n", per_cu); per_cu = 1; }
        (void)hipGetLastError();
        grid = cus * per_cu;
        if (grid != GRID_WG) { fprintf(stderr, "kernel_launch: this build is for a co-resident grid of %d workgroups, the device offers %d; nothing launched\n", GRID_WG, grid); grid = -1; return; }
        fprintf(stderr, "kernel_launch: grid %d (cus %d x %d)\n", grid, cus, per_cu);
    }
    if (grid < 0) return;
    if (hipMemsetAsync((char*)d_ws + WS_BAR, 0, 16384 + 4096, stream) != hipSuccess) { fprintf(stderr, "kernel_launch: memset failed\n"); return; }
    Params p{};
    for (int i = 0; i < 27; ++i) p.in[i] = (const float*)d_in[i];
    p.out = (float*)d_out; p.ws = (unsigned char*)d_ws;
    void* args[] = {&p};
    hipError_t e = hipLaunchCooperativeKernel((const void*)mega_fwd, dim3(grid), dim3(NWAVES * 64), args, LDS_BYTES, stream);
    if (e != hipSuccess) fprintf(stderr, "kernel_launch: cooperative launch failed: %s (grid %d)\n", hipGetErrorString(e), grid);
}
```
